# Optimizing an MI355X kernel written in HIP

```python
import jax
import jax.numpy as jnp
from jax import lax
import numpy as np

D_MODEL = 1024
BATCH = 8
SEQ = 8192
DEPTH = 1

NORM_EPS = 1e-6
D_FF = 2816

ATTN_HEAD_DIM = 64
ATTN_HEADS_PER_GROUP = 4
ATTN_GROUPS = ((128, 1), (512, 4), (2048, 16))
N_ATTN_GROUPS = 3
ATTN_WIDTH = N_ATTN_GROUPS * ATTN_HEADS_PER_GROUP * ATTN_HEAD_DIM
ATTN_OUT_WIDTH = ATTN_HEADS_PER_GROUP * ATTN_HEAD_DIM
ROPE_THETA = 500000.0
ROPE_DIM = ATTN_HEAD_DIM // 4

RWKV_HEAD_DIM = 64
RWKV_WIDTH = D_MODEL
RWKV_HEADS = RWKV_WIDTH // RWKV_HEAD_DIM
DECAY_LORA = 64
ICLR_LORA = 64
GATE_LORA = 160
RWKV_GN_EPS = 64e-5
RWKV_STREAM = 3 * RWKV_WIDTH + DECAY_LORA + ICLR_LORA + GATE_LORA

IN_COLS = 3 * ATTN_WIDTH + RWKV_STREAM + 2 * D_MODEL

kernel_name = 'hybrid_dilated_attn_rwkv7_macaron'


def rms_norm(x, gain):
    xf = x.astype(jnp.float32)
    y = xf * lax.rsqrt(jnp.mean(xf * xf, axis=-1, keepdims=True) + NORM_EPS)
    return (y * gain.astype(jnp.float32)).astype(x.dtype)


def swiglu(h, w_gate, w_up, w_down):
    return (jax.nn.silu(h @ w_gate) * (h @ w_up)) @ w_down


def partial_rope(x, positions):
    half = ROPE_DIM // 2
    inv_freq = jnp.power(ROPE_THETA, -jnp.arange(half, dtype=jnp.float32) * (2.0 / ROPE_DIM))
    ang = positions.astype(jnp.float32)[:, None] * inv_freq[None, :]
    cos = jnp.cos(ang)[None, :, None, :]
    sin = jnp.sin(ang)[None, :, None, :]
    xr = x[..., :ROPE_DIM].astype(jnp.float32)
    x1, x2 = xr[..., :half], xr[..., half:]
    rot = jnp.concatenate([x1 * cos - x2 * sin, x2 * cos + x1 * sin], axis=-1).astype(x.dtype)
    return jnp.concatenate([rot, x[..., ROPE_DIM:]], axis=-1)


def dilated_group(q, k, v, window, dilation):
    B, S, H, Dh = q.shape
    n = window // dilation
    L = S // dilation
    nb = -(-L // n)
    Lp = nb * n

    def to_sub(t):
        t = t.reshape(B, L, dilation, H, Dh).transpose(0, 2, 3, 1, 4)
        t = jnp.pad(t, ((0, 0), (0, 0), (0, 0), (0, Lp - L), (0, 0)))
        return t.reshape(B, dilation, H, nb, n, Dh)

    def with_prev(t):
        prev = jnp.pad(t, ((0, 0), (0, 0), (0, 0), (1, 0), (0, 0), (0, 0)))[:, :, :, :-1]
        return jnp.concatenate([prev, t], axis=4)

    def from_sub(t):
        t = t.reshape(B, dilation, H, Lp, t.shape[-1])[:, :, :, :L]
        return t.transpose(0, 3, 1, 2, 4).reshape(B, S, H, t.shape[-1])

    qb = to_sub(q)
    kw = with_prev(to_sub(k))
    vw = with_prev(to_sub(v))
    s = jnp.einsum('brhiqd,brhikd->brhiqk', qb, kw, preferred_element_type=jnp.float32)
    qi = jnp.arange(n)[:, None]
    ki = jnp.arange(2 * n)[None, :]
    rel = qi + n - ki
    band = (rel >= 0) & (rel <= n)
    blk = jnp.arange(nb)[:, None, None]
    valid = band[None] & ((blk > 0) | (ki[None] >= n))
    s = jnp.where(valid, s, -jnp.inf)
    m = jnp.max(s, axis=-1)
    p = jnp.exp(s - m[..., None])
    l = jnp.sum(p, axis=-1)
    acc = jnp.einsum('brhiqk,brhikd->brhiqd', p, vw.astype(jnp.float32))
    return from_sub(acc), from_sub(m[..., None])[..., 0], from_sub(l[..., None])[..., 0]


def dilated_attention(qkv, positions):
    B, S, _ = qkv.shape
    G, Hg, Dh = N_ATTN_GROUPS, ATTN_HEADS_PER_GROUP, ATTN_HEAD_DIM
    q, k, v = jnp.split(qkv, 3, axis=-1)
    q = partial_rope(q.reshape(B, S, G * Hg, Dh), positions) * (Dh ** -0.5)
    k = partial_rope(k.reshape(B, S, G * Hg, Dh), positions)
    v = v.reshape(B, S, G * Hg, Dh)
    accs, ms, ls = [], [], []
    for g, (window, dilation) in enumerate(ATTN_GROUPS):
        sl = slice(g * Hg, (g + 1) * Hg)
        acc, m, l = dilated_group(q[:, :, sl], k[:, :, sl], v[:, :, sl], window, dilation)
        accs.append(acc)
        ms.append(m)
        ls.append(l)
    m_all = jnp.stack(ms)
    c = jnp.exp(m_all - jnp.max(m_all, axis=0))
    num = jnp.sum(c[..., None] * jnp.stack(accs), axis=0)
    den = jnp.sum(c * jnp.stack(ls), axis=0)
    out = (num / den[..., None]).astype(qkv.dtype)
    return out.reshape(B, S, Hg * Dh)


def token_shift(z, mu):
    prev = jnp.pad(z, ((0, 0), (1, 0), (0, 0)))[:, :-1]
    return z + (prev - z) * mu


def wkv7_scan(r, w, k, v, a, b):
    B, S, H, N = r.shape

    def step(state, inp):
        r_t, w_t, k_t, v_t, a_t, b_t = inp
        sa = jnp.einsum('bhvk,bhk->bhv', state, a_t)
        state = (state * w_t[:, :, None, :] + sa[..., None] * b_t[:, :, None, :]
                 + v_t[..., None] * k_t[:, :, None, :])
        return state, jnp.einsum('bhvk,bhk->bhv', state, r_t)

    xs = tuple(jnp.moveaxis(t.astype(jnp.float32), 1, 0) for t in (r, w, k, v, a, b))
    _, ys = lax.scan(step, jnp.zeros((B, H, N, N), jnp.float32), xs)
    return jnp.moveaxis(ys, 0, 1)


def rwkv7_time_mix(z, w0, w2, a0, a2, g2, k_k, k_a, r_k, ln_w, ln_b, w_out):
    B, S, _ = z.shape
    RW, H, N = RWKV_WIDTH, RWKV_HEADS, RWKV_HEAD_DIM
    o1, o2, o3 = RW, 2 * RW, 3 * RW
    o4, o5 = o3 + DECAY_LORA, o3 + DECAY_LORA + ICLR_LORA
    r, k, v = z[..., :o1], z[..., o1:o2], z[..., o2:o3]
    zw, za, zg = z[..., o3:o4], z[..., o4:o5], z[..., o5:]
    logw = -jax.nn.softplus(-(w0 + jnp.tanh(zw) @ w2)) - 0.5
    decay = jnp.exp(-jnp.exp(logw.astype(jnp.float32)))
    a = jax.nn.sigmoid(a0 + za @ a2)
    g = jax.nn.sigmoid(zg) @ g2
    kk = (k * k_k).astype(jnp.float32).reshape(B, S, H, N)
    kk = kk / jnp.maximum(jnp.sqrt(jnp.sum(kk * kk, axis=-1, keepdims=True)), 1e-12)
    k = k * (1.0 + (a - 1.0) * k_a)
    rh = r.reshape(B, S, H, N).astype(jnp.float32)
    kh = k.reshape(B, S, H, N).astype(jnp.float32)
    vh = v.reshape(B, S, H, N).astype(jnp.float32)
    ah = a.reshape(B, S, H, N).astype(jnp.float32)
    y = wkv7_scan(rh, decay.reshape(B, S, H, N), kh, vh, -kk, kk * ah)
    mu = jnp.mean(y, axis=-1, keepdims=True)
    var = jnp.mean(jnp.square(y - mu), axis=-1, keepdims=True)
    yn = ((y - mu) * lax.rsqrt(var + RWKV_GN_EPS)).reshape(B, S, RW)
    yn = yn * ln_w.astype(jnp.float32) + ln_b.astype(jnp.float32)
    bonus = (jnp.sum(rh * kh * r_k.astype(jnp.float32), axis=-1, keepdims=True) * vh).reshape(B, S, RW)
    return ((yn + bonus) * g.astype(jnp.float32)).astype(z.dtype) @ w_out


def hybrid_mixer(h, positions, w_in, gate_bias, attn_w_up, rwkv_mu, rwkv_w0, rwkv_w2, rwkv_a0,
                 rwkv_a2, rwkv_g2, rwkv_k_k, rwkv_k_a, rwkv_r_k, rwkv_ln_w, rwkv_ln_b,
                 rwkv_w_out, w_o):
    proj = h @ w_in
    aw, rs = 3 * ATTN_WIDTH, RWKV_STREAM
    gates = jax.nn.sigmoid(proj[..., aw + rs:] + gate_bias)
    y_attn = dilated_attention(proj[..., :aw], positions) @ attn_w_up
    y_rwkv = rwkv7_time_mix(token_shift(proj[..., aw:aw + rs], rwkv_mu), rwkv_w0, rwkv_w2,
                            rwkv_a0, rwkv_a2, rwkv_g2, rwkv_k_k, rwkv_k_a, rwkv_r_k,
                            rwkv_ln_w, rwkv_ln_b, rwkv_w_out)
    merged = gates[..., :D_MODEL] * y_attn + gates[..., D_MODEL:] * y_rwkv
    return merged @ w_o


def setup_inputs(seed: int = 0) -> dict:
    key = jax.random.key(seed)
    ks = iter(jax.random.split(key, 40))
    f32 = jnp.float32

    def nrm(shape, scale):
        return jax.random.normal(next(ks), shape, f32) * scale

    def gain(shape):
        return 1.0 + 0.05 * jax.random.normal(next(ks), shape, f32)

    L, D, F = DEPTH, D_MODEL, D_FF
    RW, H, N = RWKV_WIDTH, RWKV_HEADS, RWKV_HEAD_DIM
    return {
        'x': nrm((BATCH, SEQ, D), 1.0),
        'ffn1_norm': gain((L, D)),
        'ffn1_w_gate': nrm((L, D, F), D ** -0.5),
        'ffn1_w_up': nrm((L, D, F), D ** -0.5),
        'ffn1_w_down': nrm((L, F, D), F ** -0.5),
        'mix_norm': gain((L, D)),
        'w_in': nrm((L, D, IN_COLS), D ** -0.5),
        'gate_bias': nrm((L, 2 * D), 0.1),
        'attn_w_up': nrm((L, ATTN_OUT_WIDTH, D), ATTN_OUT_WIDTH ** -0.5),
        'rwkv_mu': jax.random.uniform(next(ks), (L, RWKV_STREAM), f32),
        'rwkv_w0': jax.random.uniform(next(ks), (L, RW), f32, -6.0, -1.0),
        'rwkv_w2': nrm((L, DECAY_LORA, RW), 0.1 * DECAY_LORA ** -0.5),
        'rwkv_a0': nrm((L, RW), 0.1),
        'rwkv_a2': nrm((L, ICLR_LORA, RW), 0.1 * ICLR_LORA ** -0.5),
        'rwkv_g2': nrm((L, GATE_LORA, RW), GATE_LORA ** -0.5),
        'rwkv_k_k': 0.85 + 0.05 * jax.random.normal(next(ks), (L, RW), f32),
        'rwkv_k_a': gain((L, RW)),
        'rwkv_r_k': nrm((L, H, N), 0.1),
        'rwkv_ln_w': gain((L, RW)),
        'rwkv_ln_b': nrm((L, RW), 0.02),
        'rwkv_w_out': nrm((L, RW, D), RW ** -0.5),
        'w_o': nrm((L, D, D), D ** -0.5),
        'ffn2_norm': gain((L, D)),
        'ffn2_w_gate': nrm((L, D, F), D ** -0.5),
        'ffn2_w_up': nrm((L, D, F), D ** -0.5),
        'ffn2_w_down': nrm((L, F, D), F ** -0.5),
        'final_norm': gain((D,)),
    }


def reference(x, ffn1_norm, ffn1_w_gate, ffn1_w_up, ffn1_w_down, mix_norm, w_in, gate_bias,
              attn_w_up, rwkv_mu, rwkv_w0, rwkv_w2, rwkv_a0, rwkv_a2, rwkv_g2, rwkv_k_k,
              rwkv_k_a, rwkv_r_k, rwkv_ln_w, rwkv_ln_b, rwkv_w_out, w_o, ffn2_norm,
              ffn2_w_gate, ffn2_w_up, ffn2_w_down, final_norm):
    positions = jnp.arange(x.shape[1], dtype=jnp.int32)
    for layer in range(DEPTH):
        x = x + 0.5 * swiglu(rms_norm(x, ffn1_norm[layer]), ffn1_w_gate[layer],
                             ffn1_w_up[layer], ffn1_w_down[layer])
        x = x + hybrid_mixer(rms_norm(x, mix_norm[layer]), positions, w_in[layer],
                             gate_bias[layer], attn_w_up[layer], rwkv_mu[layer],
                             rwkv_w0[layer], rwkv_w2[layer], rwkv_a0[layer], rwkv_a2[layer],
                             rwkv_g2[layer], rwkv_k_k[layer], rwkv_k_a[layer],
                             rwkv_r_k[layer], rwkv_ln_w[layer], rwkv_ln_b[layer],
                             rwkv_w_out[layer], w_o[layer])
        x = x + 0.5 * swiglu(rms_norm(x, ffn2_norm[layer]), ffn2_w_gate[layer],
                             ffn2_w_up[layer], ffn2_w_down[layer])
    return rms_norm(x, final_norm)
```

```cpp
#include <hip/hip_runtime.h>
#include <hip/hip_cooperative_groups.h>
#include <cstdio>
#include <cstdint>
namespace cg = cooperative_groups;

#ifndef MK_MULTI
#define MK_MULTI 0
#endif

namespace pg8 {
#define PG8_LAS __attribute__((address_space(3)))
typedef unsigned short bf16_t;
typedef short bf16x8 __attribute__((ext_vector_type(8)));
typedef float f32x4 __attribute__((ext_vector_type(4)));
typedef unsigned u32x4 __attribute__((ext_vector_type(4)));
constexpr int BM = 256, BK = 64, HALF = 128, HTB = HALF * BK * 2, STAGE_BYTES = 8 * HTB, NXCD = 8, WGM = 8;

__host__ __device__ __forceinline__ int lds_byte(int r, int c) { const int st = (r >> 4) * 2 + (c >> 5), rr = r & 15, cc = c & 31, ob = rr * 64 + cc * 2; return st * 1024 + (ob ^ (((ob >> 9) & 1) << 5)); }
__host__ __device__ __forceinline__ void stage_rc(int b, int& R, int& C) { const int st = b / 1024, sb = b % 1024, swz = sb ^ (((sb >> 9) & 1) << 5); R = (st >> 1) * 16 + swz / 64; C = (st & 1) * 32 + (swz % 64) / 2; }
__host__ __device__ __forceinline__ int perm32(int rho) { const int n = rho >> 4, i = rho & 15; return 8 * (i >> 2) + 4 * n + (i & 3); }

struct Unit { int pm, pn; };
struct Gemm { const bf16_t* A; const bf16_t* Bt; int M, N, K, lda, ldb; };

struct StaticOrder {
    int nM, nN, nwg, G, c;
    __host__ __device__ void init(int M, int N, int G_, int c_) { nM = M / BM; nN = N / BM; nwg = nM * nN; G = G_; c = c_; }
    __host__ __device__ bool next(int i, Unit& u) const {
        const long L = (long)i * G + c; if (L >= nwg) return false;
        int wgid = (int)L; { const int q = nwg / NXCD, r = nwg % NXCD, xcd = wgid % NXCD, off = wgid / NXCD; wgid = (xcd < r ? xcd * (q + 1) : r * (q + 1) + (xcd - r) * q) + off; }
        const int nig = WGM * nN, gid = wgid / nig, fm = gid * WGM, gsz = (nM - fm) < WGM ? (nM - fm) : WGM;
        u.pm = fm + ((wgid % nig) % gsz); u.pn = (wgid % nig) / gsz; return true;
    }
};

__device__ __forceinline__ unsigned cvt_pk_bf16(float lo, float hi) { unsigned r; asm volatile("v_cvt_pk_bf16_f32 %0, %1, %2" : "=v"(r) : "v"(lo), "v"(hi)); return r; }

template <class Op> struct EpiOp {
    Op op;
    __device__ __forceinline__ void operator()(const f32x4 (&acc)[2][2][4][2], const Unit& u, int wr, int wc, int fr, int fq) const {
#pragma unroll
        for (int ai = 0; ai < 2; ++ai)
#pragma unroll
            for (int m = 0; m < 4; ++m) {
                const int row = u.pm * BM + ai * HALF + wr * 64 + m * 16 + fr;
                op(acc[ai][0][m][0], acc[ai][0][m][1], acc[ai][1][m][0], acc[ai][1][m][1], row, u.pn, wc, fq);
            }
    }
};

template <class Epi, class Sched>
__device__ __forceinline__ void gemm_phase(PG8_LAS unsigned char* lds, const Gemm g, const Sched& S, const Epi& E) {
    int tid_ = threadIdx.x; asm volatile("" : "+v"(tid_));
    const int tid = tid_, wid = __builtin_amdgcn_readfirstlane(tid >> 6), lane = tid & 63, wr = wid >> 2, wc = wid & 3, fr = lane & 15, fq = lane >> 4;
    const int K = g.K, nt = K / BK;
    unsigned voffA[2], voffB[2];
#pragma unroll
    for (int i = 0; i < 2; ++i) { int R, C; stage_rc(tid * 16 + i * 8192, R, C); const int Rb = (R & ~31) + perm32(R & 31);
        voffA[i] = (unsigned)(R * g.lda + C) * 2u; voffB[i] = (unsigned)(Rb * g.ldb + C) * 2u; }
    const size_t kstep = (size_t)(BK * 2);
    const size_t hstepA = (size_t)HALF * g.lda * 2, hstepB = (size_t)HALF * g.ldb * 2;
    const size_t tstepA = 2 * hstepA, tstepB = 2 * hstepB;
    const unsigned ldsw = (unsigned)wid * 1024u;
    const int aoff = lds_byte(wr * 64 + fr, fq * 8), boff = lds_byte(wc * 32 + fr, fq * 8);
#define PG8_SA(b, h) (((b) * 2 + (h)) * HTB)
#define PG8_SB(b, h) ((4 + (b) * 2 + (h)) * HTB)
#define PG8_STAGE(bufoff, gbase, voff) do { _Pragma("unroll") for (int _i = 0; _i < 2; ++_i) \
        __builtin_amdgcn_global_load_lds((const unsigned*)((const char*)(gbase) + (voff)[_i]), (PG8_LAS unsigned*)(lds + (bufoff) + ldsw + _i * 8192), 16, 0, 0); } while (0)
#define PG8_LDA(dst, b, h) do { _Pragma("unroll") for (int m = 0; m < 4; ++m) _Pragma("unroll") for (int k = 0; k < 2; ++k) dst[m][k] = *(const PG8_LAS bf16x8*)(lds + PG8_SA(b, h) + aoff + m * 2048 + k * 1024); } while (0)
#define PG8_LDB(dst, b, h) do { _Pragma("unroll") for (int n = 0; n < 2; ++n) _Pragma("unroll") for (int k = 0; k < 2; ++k) dst[n][k] = *(const PG8_LAS bf16x8*)(lds + PG8_SB(b, h) + boff + n * 2048 + k * 1024); } while (0)
#define PG8_MMA(ai, bj, At, Bt) do { __builtin_amdgcn_s_setprio(1); _Pragma("unroll") for (int m = 0; m < 4; ++m) _Pragma("unroll") for (int n = 0; n < 2; ++n) _Pragma("unroll") for (int k = 0; k < 2; ++k) \
        acc[ai][bj][m][n] = __builtin_amdgcn_mfma_f32_16x16x32_bf16(Bt[n][k], At[m][k], acc[ai][bj][m][n], 0, 0, 0); __builtin_amdgcn_s_setprio(0); } while (0)
#define PG8_WAIT_V(n) asm volatile("s_waitcnt vmcnt(" #n ")" ::: "memory")
#define PG8_WAIT_L(n) asm volatile("s_waitcnt lgkmcnt(" #n ")" ::: "memory")
#define PG8_BAR __builtin_amdgcn_s_barrier()
#define PG8_SCHED __builtin_amdgcn_sched_barrier(0)
    Unit cur, nxt; int ui = 0;
    if (!S.next(0, cur)) return;
    f32x4 acc[2][2][4][2];
#pragma unroll
    for (int a = 0; a < 2; ++a)
#pragma unroll
        for (int b = 0; b < 2; ++b)
#pragma unroll
            for (int m = 0; m < 4; ++m)
#pragma unroll
                for (int n = 0; n < 2; ++n) acc[a][b][m][n] = (f32x4){0.f, 0.f, 0.f, 0.f};
    bf16x8 At[4][2], B0[2][2], B1[2][2];
    const char* cA = (const char*)g.A + (size_t)cur.pm * tstepA; const char* cB = (const char*)g.Bt + (size_t)cur.pn * tstepB;
    PG8_STAGE(PG8_SB(0, 0), cB, voffB); PG8_STAGE(PG8_SB(0, 1), cB + hstepB, voffB); PG8_STAGE(PG8_SA(0, 0), cA, voffA); PG8_STAGE(PG8_SA(0, 1), cA + hstepA, voffA);
    if (wr == 1) PG8_BAR;
    PG8_WAIT_V(2); PG8_BAR;
    PG8_STAGE(PG8_SB(1, 0), cB + kstep, voffB); PG8_STAGE(PG8_SA(1, 0), cA + kstep, voffA); PG8_STAGE(PG8_SB(1, 1), cB + hstepB + kstep, voffB);
    PG8_WAIT_V(6); PG8_BAR;
    for (;;) {
        const bool has_next = S.next(ui + 1, nxt);
        const char* nA = has_next ? (const char*)g.A + (size_t)nxt.pm * tstepA : cA; const char* nB = has_next ? (const char*)g.Bt + (size_t)nxt.pn * tstepB : cB;
        for (int t = 0; t < nt; t += 2) {
            const bool last = (t == nt - 2);
            const char* a1 = cA + (size_t)(t + 1) * kstep;
            const char* a2 = last ? nA : cA + (size_t)(t + 2) * kstep; const char* b2 = last ? nB : cB + (size_t)(t + 2) * kstep;
            const char* a3 = a2 + kstep; const char* b3 = b2 + kstep;
            PG8_LDB(B0, 0, 0); PG8_LDB(B1, 0, 1); PG8_SCHED; PG8_LDA(At, 0, 0); PG8_STAGE(PG8_SA(1, 1), a1 + hstepA, voffA);
            PG8_WAIT_V(8); PG8_WAIT_L(0); PG8_BAR; PG8_MMA(0, 0, At, B0); PG8_MMA(0, 1, At, B1); PG8_BAR; PG8_SCHED;
            PG8_LDA(At, 0, 1); PG8_STAGE(PG8_SB(0, 0), b2, voffB); PG8_STAGE(PG8_SB(0, 1), b2 + hstepB, voffB); PG8_STAGE(PG8_SA(0, 0), a2, voffA);
            PG8_WAIT_V(8); PG8_WAIT_L(0); PG8_BAR; PG8_MMA(1, 0, At, B0); PG8_MMA(1, 1, At, B1); PG8_BAR; PG8_SCHED;
            PG8_LDB(B0, 1, 0); PG8_LDB(B1, 1, 1); PG8_SCHED; PG8_LDA(At, 1, 0); PG8_STAGE(PG8_SA(0, 1), a2 + hstepA, voffA);
            PG8_WAIT_V(8); PG8_WAIT_L(0); PG8_BAR; PG8_MMA(0, 0, At, B0); PG8_MMA(0, 1, At, B1); PG8_BAR; PG8_SCHED;
            PG8_LDA(At, 1, 1); PG8_STAGE(PG8_SB(1, 0), b3, voffB); PG8_STAGE(PG8_SB(1, 1), b3 + hstepB, voffB); PG8_STAGE(PG8_SA(1, 0), a3, voffA);
            PG8_WAIT_V(8); PG8_WAIT_L(0); PG8_BAR; PG8_MMA(1, 0, At, B0); PG8_MMA(1, 1, At, B1); PG8_BAR; PG8_SCHED;
        }
        if (wr == 0) PG8_BAR;
        E(acc, cur, wr, wc, fr, fq);
        if (!has_next) break;
#pragma unroll
        for (int a = 0; a < 2; ++a)
#pragma unroll
            for (int b = 0; b < 2; ++b)
#pragma unroll
                for (int m = 0; m < 4; ++m)
#pragma unroll
                    for (int n = 0; n < 2; ++n) acc[a][b][m][n] = (f32x4){0.f, 0.f, 0.f, 0.f};
        cur = nxt; cA = nA; cB = nB; ++ui;
        if (wr == 1) PG8_BAR;
    }
    PG8_WAIT_V(0);
    PG8_BAR;
#undef PG8_SA
#undef PG8_SB
#undef PG8_STAGE
#undef PG8_LDA
#undef PG8_LDB
#undef PG8_MMA
#undef PG8_WAIT_V
#undef PG8_WAIT_L
#undef PG8_BAR
#undef PG8_SCHED
}
}

using pg8::bf16_t; using pg8::f32x4; using pg8::u32x4; using pg8::bf16x8;
typedef unsigned u32x2 __attribute__((ext_vector_type(2)));
#define LAS __attribute__((address_space(3)))

constexpr int BATCH = 8, SEQ = 8192, D = 1024, FF = 2816, M = BATCH * SEQ;
constexpr int AW = 768, RS = 3360, INC = 7712;
constexpr int LAW = 384;
constexpr int NWAVES = 8, NT = 512;
constexpr float NORM_EPS = 1e-6f, GN_EPS = 64e-5f;

constexpr size_t MiB = 1u << 20;
constexpr size_t WS_WGU1 = 1 * MiB;
constexpr size_t WS_WD1 = WS_WGU1 + 11 * MiB;
constexpr size_t WS_WGU2 = WS_WD1 + 5 * MiB + MiB / 2;
constexpr size_t WS_WD2 = WS_WGU2 + 11 * MiB;
constexpr size_t WS_WIN = WS_WD2 + 5 * MiB + MiB / 2;
constexpr size_t WS_WUP = WS_WIN + 15 * MiB + MiB / 2;
constexpr size_t WS_WOUT = WS_WUP + MiB / 2;
constexpr size_t WS_WO = WS_WOUT + 2 * MiB;
constexpr size_t WS_LW = WS_WO + 2 * MiB;
constexpr size_t WS_LA2 = WS_LW + MiB / 4;
constexpr size_t WS_LG = WS_LA2 + MiB / 4;
constexpr size_t WS_ROPE = WS_LG + MiB / 2;
static_assert(WS_ROPE + MiB / 2 <= 56 * MiB, "weights region");
constexpr size_t WS_LA = 56 * MiB;
constexpr size_t WS_HALO = 104 * MiB;
constexpr size_t WS_HALOLA = 110 * MiB;
constexpr size_t WS_BC = 111 * MiB;
constexpr size_t WS_LSE = 115 * MiB;
constexpr size_t CH = 128 * MiB;
constexpr size_t WS_C0 = 128 * MiB;
#define WS_C(i) (WS_C0 + (size_t)(i) * CH)
constexpr size_t WS_END = 1024 * MiB;
constexpr int LDS_BYTES = 147456;

__device__ __forceinline__ float bf2f(unsigned short h) { return __uint_as_float(((unsigned)h) << 16); }
__device__ __forceinline__ float bflo(unsigned w) { return __uint_as_float(w << 16); }
__device__ __forceinline__ float bfhi(unsigned w) { return __uint_as_float(w & 0xffff0000u); }
__device__ __forceinline__ unsigned pk2(float lo, float hi) { return pg8::cvt_pk_bf16(lo, hi); }
__device__ __forceinline__ void unpack8(const u32x4 w, float (&f)[8]) { f[0] = bflo(w.x); f[1] = bfhi(w.x); f[2] = bflo(w.y); f[3] = bfhi(w.y); f[4] = bflo(w.z); f[5] = bfhi(w.z); f[6] = bflo(w.w); f[7] = bfhi(w.w); }
__device__ __forceinline__ u32x4 pack8(const float (&f)[8]) { u32x4 w; w.x = pk2(f[0], f[1]); w.y = pk2(f[2], f[3]); w.z = pk2(f[4], f[5]); w.w = pk2(f[6], f[7]); return w; }
__device__ __forceinline__ float sigm(float x) { return __builtin_amdgcn_rcpf(1.f + __expf(-x)); }
__device__ __forceinline__ float wave_sum(float v) {
#pragma unroll
    for (int o = 1; o < 64; o <<= 1) v += __shfl_xor(v, o);
    return v;
}

struct OpGateUp {
    bf16_t* H;
    __device__ __forceinline__ void operator()(const f32x4 g0, const f32x4 g1, const f32x4 u0, const f32x4 u1, int row, int pn, int wc, int fq) const {
        const int col = pn * 128 + wc * 32 + 8 * fq; float o[8];
#pragma unroll
        for (int i = 0; i < 4; ++i) { o[i] = g0[i] * sigm(g0[i]) * u0[i]; o[4 + i] = g1[i] * sigm(g1[i]) * u1[i]; }
        *(u32x4*)(H + (size_t)row * FF + col) = pack8(o);
    }
};
struct OpStoreBf16 {
    bf16_t* O; int ld; float scale;
    __device__ __forceinline__ void operator()(const f32x4 a0, const f32x4 a1, const f32x4 b0, const f32x4 b1, int row, int pn, int wc, int fq) const {
        const int col = pn * 256 + wc * 32 + 8 * fq; float o[8];
#pragma unroll
        for (int i = 0; i < 4; ++i) { o[i] = a0[i] * scale; o[4 + i] = a1[i] * scale; }
        *(u32x4*)(O + (size_t)row * ld + col) = pack8(o);
#pragma unroll
        for (int i = 0; i < 4; ++i) { o[i] = b0[i] * scale; o[4 + i] = b1[i] * scale; }
        *(u32x4*)(O + (size_t)row * ld + col + 128) = pack8(o);
    }
};
struct OpRes {
    const float* base; const bf16_t* dlt; float* out; float scale;
    __device__ __forceinline__ void half(const f32x4 a0, const f32x4 a1, size_t off) const {
        f32x4 r0 = a0 * scale, r1 = a1 * scale;
        if (base) { r0 += *(const f32x4*)(base + off); r1 += *(const f32x4*)(base + off + 4); }
        if (dlt) { float d[8]; unpack8(*(const u32x4*)(dlt + off), d); r0 += (f32x4){d[0], d[1], d[2], d[3]}; r1 += (f32x4){d[4], d[5], d[6], d[7]}; }
        *(f32x4*)(out + off) = r0; *(f32x4*)(out + off + 4) = r1;
    }
    __device__ __forceinline__ void operator()(const f32x4 a0, const f32x4 a1, const f32x4 b0, const f32x4 b1, int row, int pn, int wc, int fq) const {
        const size_t off = (size_t)row * D + pn * 256 + wc * 32 + 8 * fq;
        half(a0, a1, off); half(b0, b1, off + 128);
    }
};
struct OpAttnQKV {
    bf16_t* q; bf16_t* k; bf16_t* v; const float* rope;
    __device__ __forceinline__ void half(const f32x4 a0, const f32x4 a1, bf16_t* dst, int row, int wc, int fq, int which) const {
        float o[8];
#pragma unroll
        for (int i = 0; i < 4; ++i) { o[i] = a0[i]; o[4 + i] = a1[i]; }
        if (which < 2 && (wc & 1) == 0) {
            float p[8];
#pragma unroll
            for (int i = 0; i < 8; ++i) p[i] = __shfl_xor(o[i], 16);
            if (fq < 2) {
                const float* cs = rope + (size_t)(row & (SEQ - 1)) * 16;
                const f32x4 c0 = *(const f32x4*)(cs), c1 = *(const f32x4*)(cs + 4), s0 = *(const f32x4*)(cs + 8), s1 = *(const f32x4*)(cs + 12);
                const float sg = fq == 0 ? -1.f : 1.f;
#pragma unroll
                for (int i = 0; i < 4; ++i) { o[i] = o[i] * c0[i] + sg * p[i] * s0[i]; o[4 + i] = o[4 + i] * c1[i] + sg * p[4 + i] * s1[i]; }
            }
        }
        if (which == 0) {
#pragma unroll
            for (int i = 0; i < 8; ++i) o[i] *= 0.125f;
        }
        *(u32x4*)dst = pack8(o);
    }
    __device__ __forceinline__ void operator()(const f32x4 a0, const f32x4 a1, const f32x4 b0, const f32x4 b1, int row, int pn, int wc, int fq) const {
        const int which = pn / 3, col = (pn - which * 3) * 256 + wc * 32 + 8 * fq;
        bf16_t* base = q + (size_t)which * (CH / 2) + (size_t)row * AW + col;
        half(a0, a1, base, row, wc, fq, which); half(b0, b1, base + 128, row, wc, fq, which);
    }
};
struct OpRwkvZ {
    bf16_t* r; bf16_t* k; bf16_t* v; bf16_t* la; bf16_t* halo; bf16_t* halola;
    __device__ __forceinline__ void operator()(const f32x4 a0, const f32x4 a1, const f32x4 b0, const f32x4 b1, int row, int pn, int wc, int fq) const {
        float o0[8], o1[8];
#pragma unroll
        for (int i = 0; i < 4; ++i) { o0[i] = a0[i]; o0[4 + i] = a1[i]; o1[i] = b0[i]; o1[4 + i] = b1[i]; }
        const u32x4 w0 = pack8(o0), w1 = pack8(o1);
        const bool hrow = (row & 63) == 63;
        if (pn < 12) {
            const int s = pn >> 2, col = (pn & 3) * 256 + wc * 32 + 8 * fq;
            bf16_t* dst = r + (size_t)s * (CH / 2) + (size_t)row * D + col;
            *(u32x4*)dst = w0; *(u32x4*)(dst + 128) = w1;
            if (hrow) { bf16_t* h = halo + (size_t)(row >> 6) * 3072 + s * 1024 + col; *(u32x4*)h = w0; *(u32x4*)(h + 128) = w1; }
        } else {
            const int col = (pn - 12) * 256 + wc * 32 + 8 * fq;
            if (col < 288) { *(u32x4*)(la + (size_t)row * LAW + col) = w0; if (hrow) *(u32x4*)(halola + (size_t)(row >> 6) * LAW + col) = w0; }
            if (col + 128 < 288) { *(u32x4*)(la + (size_t)row * LAW + col + 128) = w1; if (hrow) *(u32x4*)(halola + (size_t)(row >> 6) * LAW + col + 128) = w1; }
        }
    }
};
struct OpGates {
    bf16_t* ga; bf16_t* gr; const float* bias;
    __device__ __forceinline__ void operator()(const f32x4 a0, const f32x4 a1, const f32x4 b0, const f32x4 b1, int row, int pn, int wc, int fq) const {
        const int s = pn >> 2, col = (pn & 3) * 256 + wc * 32 + 8 * fq; const float* bp = bias + s * 1024 + col;
        bf16_t* dst = ga + (size_t)s * (CH / 2) + (size_t)row * D + col; float o[8];
        { const f32x4 c0 = *(const f32x4*)bp, c1 = *(const f32x4*)(bp + 4);
#pragma unroll
          for (int i = 0; i < 4; ++i) { o[i] = sigm(a0[i] + c0[i]); o[4 + i] = sigm(a1[i] + c1[i]); }
          *(u32x4*)dst = pack8(o); }
        { const f32x4 c0 = *(const f32x4*)(bp + 128), c1 = *(const f32x4*)(bp + 132);
#pragma unroll
          for (int i = 0; i < 4; ++i) { o[i] = sigm(b0[i] + c0[i]); o[4 + i] = sigm(b1[i] + c1[i]); }
          *(u32x4*)(dst + 128) = pack8(o); }
    }
};
template <int MODE> struct OpLora {
    bf16_t* O; const float* p0;
    __device__ __forceinline__ float f(float x) const { const float s = sigm(x); return MODE == 0 ? 1.f - __expf(-0.60653065971f * s) : s; }
    __device__ __forceinline__ void operator()(const f32x4 a0, const f32x4 a1, const f32x4 b0, const f32x4 b1, int row, int pn, int wc, int fq) const {
        const int col = pn * 256 + wc * 32 + 8 * fq; const float* bp = p0 + col; bf16_t* dst = O + (size_t)row * D + col; float o[8];
        { const f32x4 c0 = *(const f32x4*)bp, c1 = *(const f32x4*)(bp + 4);
#pragma unroll
          for (int i = 0; i < 4; ++i) { o[i] = f(a0[i] + c0[i]); o[4 + i] = f(a1[i] + c1[i]); }
          *(u32x4*)dst = pack8(o); }
        { const f32x4 c0 = *(const f32x4*)(bp + 128), c1 = *(const f32x4*)(bp + 132);
#pragma unroll
          for (int i = 0; i < 4; ++i) { o[i] = f(b0[i] + c0[i]); o[4 + i] = f(b1[i] + c1[i]); }
          *(u32x4*)(dst + 128) = pack8(o); }
    }
};
struct OpMerge {
    const bf16_t* ga; const bf16_t* ya; const bf16_t* gr; bf16_t* out;
    __device__ __forceinline__ void half(const f32x4 a0, const f32x4 a1, size_t off) const {
        float A[8], Y[8], R[8], o[8]; unpack8(*(const u32x4*)(ga + off), A); unpack8(*(const u32x4*)(ya + off), Y); unpack8(*(const u32x4*)(gr + off), R);
#pragma unroll
        for (int i = 0; i < 4; ++i) { o[i] = A[i] * Y[i] + R[i] * a0[i]; o[4 + i] = A[4 + i] * Y[4 + i] + R[4 + i] * a1[i]; }
        *(u32x4*)(out + off) = pack8(o);
    }
    __device__ __forceinline__ void operator()(const f32x4 a0, const f32x4 a1, const f32x4 b0, const f32x4 b1, int row, int pn, int wc, int fq) const {
        const size_t off = (size_t)row * D + pn * 256 + wc * 32 + 8 * fq;
        half(a0, a1, off); half(b0, b1, off + 128);
    }
};

struct Args {
    const float* in[27]; float* out; unsigned char* ws; int ph_lo, ph_hi;
};
enum { I_X = 0, I_F1N, I_F1G, I_F1U, I_F1D, I_MN, I_WIN, I_GB, I_AUP, I_MU, I_W0, I_W2, I_A0, I_A2, I_G2, I_KK, I_KA, I_RK, I_LNW, I_LNB, I_WOUT, I_WO, I_F2N, I_F2G, I_F2U, I_F2D, I_FN };

__device__ __forceinline__ void tr_job(const float* W0, const float* W1, int ldw, int Ksrc, bf16_t* WT, int ldt, int nrows, int mode, int coff, int climit,
                                       float* scr, int gw, int NGW, int lane) {
    const int nblk = nrows / 32, nitems = (ldt / 64) * nblk;
    for (int it = gw; it < nitems; it += NGW) {
        const int kb = it / nblk, nb = it % nblk, k0 = 64 * kb;
        const float* W = W0; int col0; bool valid = true;
        if (mode == 0) { col0 = coff + 32 * nb; valid = col0 < climit; }
        else { const int tile = nb >> 3, j0 = (nb & 7) * 32; W = j0 < 128 ? W0 : W1; col0 = tile * 128 + (j0 & 127); }
#pragma unroll 8
        for (int i = 0; i < 32; ++i) { const int kk = 2 * i + (lane >> 5), k = k0 + kk;
            scr[kk * 33 + (lane & 31)] = (valid && k < Ksrc) ? W[(size_t)k * ldw + col0 + (lane & 31)] : 0.f; }
        __builtin_amdgcn_s_waitcnt(0); asm volatile("" ::: "memory");
        const int c = lane & 7;
#pragma unroll
        for (int j = 0; j < 4; ++j) { const int n = (lane >> 3) + 8 * j; const float* s = scr + (8 * c) * 33 + n;
            u32x4 o; o.x = pk2(s[0 * 33], s[1 * 33]); o.y = pk2(s[2 * 33], s[3 * 33]); o.z = pk2(s[4 * 33], s[5 * 33]); o.w = pk2(s[6 * 33], s[7 * 33]);
            *(u32x4*)(WT + (size_t)(32 * nb + n) * ldt + k0 + 8 * c) = o; }
        __builtin_amdgcn_s_waitcnt(0); asm volatile("" ::: "memory");
    }
}
__device__ __forceinline__ void norm_row(const float* xrow, const bf16_t* drow, const float* gain, bf16_t* orow, float* frow, int lane) {
    f32x4 v[4]; float s = 0.f;
#pragma unroll
    for (int j = 0; j < 4; ++j) {
        v[j] = *((const f32x4*)xrow + lane + 64 * j);
        if (drow) { const u32x2 w = *((const u32x2*)drow + lane + 64 * j); v[j] += (f32x4){bflo(w.x), bfhi(w.x), bflo(w.y), bfhi(w.y)}; }
        s += (v[j].x * v[j].x + v[j].y * v[j].y) + (v[j].z * v[j].z + v[j].w * v[j].w);
    }
    const float inv = rsqrtf(wave_sum(s) * (1.f / D) + NORM_EPS);
#pragma unroll
    for (int j = 0; j < 4; ++j) {
        const f32x4 gn = *((const f32x4*)gain + lane + 64 * j); const f32x4 o = v[j] * inv * gn;
        if (orow) { u32x2 w; w.x = pk2(o.x, o.y); w.y = pk2(o.z, o.w); *((u32x2*)orow + lane + 64 * j) = w; }
        else *((f32x4*)frow + lane + 64 * j) = o;
    }
}

__device__ __forceinline__ void attn_phase(unsigned char* lds, const bf16_t* Q, const bf16_t* K, const bf16_t* V, bf16_t* Og, float* lse, int G, int bid) {
    bf16_t* Ks = (bf16_t*)lds;
    bf16_t* Vt = (bf16_t*)(lds + 36864);
    int tid_ = threadIdx.x; asm volatile("" : "+v"(tid_));
    const int tid = tid_, w = tid >> 6, lane = tid & 63, fr = lane & 15, fq = lane >> 4;
    for (int u = bid; u < BATCH * 12 * 64; u += G) {
        const int rb = u & 63, bh = u >> 6, h = bh % 12, b = bh / 12, g = h >> 2, hg = h & 3;
        const int dsh = 2 * g, d = 1 << dsh, nb = 64 >> dsh, r = rb / nb, i = rb % nb;
        const size_t brow = (size_t)b * SEQ;
        __syncthreads();
#pragma unroll
        for (int c = 0; c < 4; ++c) {
            const int p = tid + 512 * c, key = p >> 3, seg = p & 7; const int l = 128 * (i - 1) + key;
            u32x4 val = (u32x4){0u, 0u, 0u, 0u};
            if (l >= 0) val = *(const u32x4*)(K + (brow + (size_t)l * d + r) * AW + h * 64 + seg * 8);
            *(u32x4*)(Ks + key * 72 + seg * 8) = val;
        }
#pragma unroll
        for (int c = 0; c < 4; ++c) {
            const int p = tid + 512 * c, seg = p >> 8, key = p & 255; const int l = 128 * (i - 1) + key;
            u32x4 val = (u32x4){0u, 0u, 0u, 0u};
            if (l >= 0) val = *(const u32x4*)(V + (brow + (size_t)l * d + r) * AW + h * 64 + seg * 8);
            bf16_t* vp = Vt + (seg * 8) * 264 + key;
            vp[0 * 264] = (bf16_t)(val.x & 0xffffu); vp[1 * 264] = (bf16_t)(val.x >> 16); vp[2 * 264] = (bf16_t)(val.y & 0xffffu); vp[3 * 264] = (bf16_t)(val.y >> 16);
            vp[4 * 264] = (bf16_t)(val.z & 0xffffu); vp[5 * 264] = (bf16_t)(val.z >> 16); vp[6 * 264] = (bf16_t)(val.w & 0xffffu); vp[7 * 264] = (bf16_t)(val.w >> 16);
        }
        const size_t rowq = brow + (size_t)(128 * i + 16 * w + fr) * d + r;
        bf16x8 qf[2];
#pragma unroll
        for (int ks = 0; ks < 2; ++ks) qf[ks] = *(const bf16x8*)(Q + rowq * AW + h * 64 + ks * 32 + fq * 8);
        __syncthreads();
        f32x4 s[10];
#pragma unroll
        for (int tt = 0; tt < 10; ++tt) {
            const int T = w + tt, Tc = T < 16 ? T : 15;
            const bf16x8 k0 = *(const bf16x8*)(Ks + (16 * Tc + fr) * 72 + fq * 8), k1 = *(const bf16x8*)(Ks + (16 * Tc + fr) * 72 + 32 + fq * 8);
            f32x4 a = (f32x4){0.f, 0.f, 0.f, 0.f};
            a = __builtin_amdgcn_mfma_f32_16x16x32_bf16(k0, qf[0], a, 0, 0, 0);
            a = __builtin_amdgcn_mfma_f32_16x16x32_bf16(k1, qf[1], a, 0, 0, 0);
            s[tt] = a;
        }
        const int qi = 16 * w + fr; float mx = -INFINITY;
#pragma unroll
        for (int tt = 0; tt < 10; ++tt)
#pragma unroll
            for (int e = 0; e < 4; ++e) {
                const int ki = 16 * (w + tt) + 4 * fq + e;
                const bool valid = (ki >= qi) && (ki <= qi + 128) && (ki < 256) && (i > 0 || ki >= 128);
                s[tt][e] = valid ? s[tt][e] : -INFINITY; mx = fmaxf(mx, s[tt][e]);
            }
        mx = fmaxf(mx, __shfl_xor(mx, 16)); mx = fmaxf(mx, __shfl_xor(mx, 32));
        float l = 0.f;
#pragma unroll
        for (int tt = 0; tt < 10; ++tt)
#pragma unroll
            for (int e = 0; e < 4; ++e) { const float p = __expf(s[tt][e] - mx); s[tt][e] = p; l += p; }
        l += __shfl_xor(l, 16); l += __shfl_xor(l, 32);
        f32x4 o[4];
#pragma unroll
        for (int dt = 0; dt < 4; ++dt) o[dt] = (f32x4){0.f, 0.f, 0.f, 0.f};
#pragma unroll
        for (int s2 = 0; s2 < 5; ++s2) {
            const int T0 = w + 2 * s2, T1 = T0 + 1, T0c = T0 < 16 ? T0 : 15, T1c = T1 < 16 ? T1 : 15;
            union { bf16x8 v; unsigned u[4]; } pf;
            pf.u[0] = pk2(s[2 * s2][0], s[2 * s2][1]); pf.u[1] = pk2(s[2 * s2][2], s[2 * s2][3]);
            pf.u[2] = pk2(s[2 * s2 + 1][0], s[2 * s2 + 1][1]); pf.u[3] = pk2(s[2 * s2 + 1][2], s[2 * s2 + 1][3]);
#pragma unroll
            for (int dt = 0; dt < 4; ++dt) {
                union { bf16x8 v; u32x2 h[2]; } vf;
                vf.h[0] = *(const u32x2*)(Vt + (16 * dt + fr) * 264 + 16 * T0c + 4 * fq);
                vf.h[1] = *(const u32x2*)(Vt + (16 * dt + fr) * 264 + 16 * T1c + 4 * fq);
                o[dt] = __builtin_amdgcn_mfma_f32_16x16x32_bf16(vf.v, pf.v, o[dt], 0, 0, 0);
            }
        }
        const float il = 1.f / l;
        bf16_t* op = Og + ((size_t)g * M + rowq) * 256 + hg * 64 + 4 * fq;
#pragma unroll
        for (int dt = 0; dt < 4; ++dt) { u32x2 wv; wv.x = pk2(o[dt][0] * il, o[dt][1] * il); wv.y = pk2(o[dt][2] * il, o[dt][3] * il); *(u32x2*)(op + 16 * dt) = wv; }
        if (fq == 0) lse[((size_t)g * M + rowq) * 4 + hg] = mx + __logf(l);
    }
    __syncthreads();
}

template <int CTRL> __device__ __forceinline__ float dpp_f(float x) { return __builtin_bit_cast(float, __builtin_amdgcn_update_dpp(0, __builtin_bit_cast(int, x), CTRL, 0xf, 0xf, true)); }
__device__ __forceinline__ float row16_sum(float x) { x += dpp_f<0x128>(x); x += dpp_f<0x124>(x); x += dpp_f<0x122>(x); x += dpp_f<0x121>(x); return x; }
constexpr int TC = 32;
constexpr int SC_BUF = TC * 5 * 64 * 4;
constexpr int SC_V = TC * 32 * 4;
__device__ __forceinline__ void scan_phase(unsigned char* lds, const bf16_t* Rr, const bf16_t* Wm, const bf16_t* Kp, const bf16_t* Vv, const bf16_t* Kk, const bf16_t* Bb, bf16_t* Y, int G, int bid) {
    int tid_ = threadIdx.x; asm volatile("" : "+v"(tid_));
    const int tid = tid_, w = tid >> 6, lane = tid & 63, kq = lane & 15, rw = lane >> 4;
    float* const kb0 = (float*)lds; float* const vb0 = (float*)(lds + 2 * SC_BUF); float* const yb0 = (float*)(lds + 2 * SC_BUF + 2 * SC_V);
#define KB(bi) (kb0 + (bi) * (SC_BUF / 4))
#define VB(bi) (vb0 + (bi) * (SC_V / 4))
#define YB(bi) (yb0 + (bi) * (SC_V / 4))
    for (int u = bid; u < BATCH * 16 * 2; u += G) {
        const int half = u & 1, h = (u >> 1) & 15, b = u >> 5;
        const size_t row0 = (size_t)b * SEQ;
        const int rowi = w * 4 + rw;
        const bf16_t* sp0; const bf16_t* sp1; const bf16_t* sp2 = nullptr; int lo0, lo1, lo2 = 0; bool neg1, isv2 = false;
        {
            const int p0 = tid, s0 = p0 >> 8, st0 = (p0 & 255) >> 3, sg0 = p0 & 7;
            sp0 = (s0 == 0 ? Rr : Wm) + (row0 + st0) * D + h * 64 + sg0 * 8; lo0 = (st0 * 5 + s0) * 64 + sg0 * 8;
            const int p1 = tid + 512, s1 = p1 >> 8, st1 = (p1 & 255) >> 3, sg1 = p1 & 7;
            sp1 = (s1 == 2 ? Kp : Kk) + (row0 + st1) * D + h * 64 + sg1 * 8; lo1 = (st1 * 5 + s1) * 64 + sg1 * 8; neg1 = (s1 == 3);
            if (tid < 256) { const int p2 = tid + 1024, st2 = (p2 & 255) >> 3, sg2 = p2 & 7; sp2 = Bb + (row0 + st2) * D + h * 64 + sg2 * 8; lo2 = (st2 * 5 + 4) * 64 + sg2 * 8; }
            else if (tid < 384) { const int pv = tid - 256, st2 = pv >> 2, sg2 = pv & 3; sp2 = Vv + (row0 + st2) * D + h * 64 + half * 32 + sg2 * 8; lo2 = st2 * 32 + sg2 * 8; isv2 = true; }
        }
        u32x4 g0, g1, g2 = (u32x4){0u, 0u, 0u, 0u};
#define SC_ISSUE(c) do { const size_t o_ = (size_t)(c) * TC * D; g0 = *(const u32x4*)(sp0 + o_); g1 = *(const u32x4*)(sp1 + o_); if (sp2) g2 = *(const u32x4*)(sp2 + o_); } while (0)
#define SC_COMMIT(bi) do { float f_[8]; \
            unpack8(g0, f_); *(f32x4*)(KB(bi) + lo0) = (f32x4){f_[0], f_[1], f_[2], f_[3]}; *(f32x4*)(KB(bi) + lo0 + 4) = (f32x4){f_[4], f_[5], f_[6], f_[7]}; \
            unpack8(g1, f_); { const float sg_ = neg1 ? -1.f : 1.f; *(f32x4*)(KB(bi) + lo1) = (f32x4){f_[0], f_[1], f_[2], f_[3]} * sg_; *(f32x4*)(KB(bi) + lo1 + 4) = (f32x4){f_[4], f_[5], f_[6], f_[7]} * sg_; } \
            if (sp2) { unpack8(g2, f_); float* dst_ = (isv2 ? VB(bi) : KB(bi)) + lo2; \
                *(f32x4*)dst_ = (f32x4){f_[0], f_[1], f_[2], f_[3]}; *(f32x4*)(dst_ + 4) = (f32x4){f_[4], f_[5], f_[6], f_[7]}; } } while (0)
        __syncthreads();
        SC_ISSUE(0); SC_COMMIT(0);
        __syncthreads();
        f32x4 S = (f32x4){0.f, 0.f, 0.f, 0.f};
        constexpr int NCH = SEQ / TC;
        for (int c = 0; c < NCH; ++c) {
            const int bi = c & 1;
            if (c + 1 < NCH) SC_ISSUE(c + 1);
            const float* kbp = KB(bi) + kq * 4; const float* vbp = VB(bi) + rowi; float* ybp = YB(bi) + rowi;
#pragma unroll 8
            for (int t = 0; t < TC; ++t) {
                const f32x4 r4 = *(const f32x4*)(kbp + t * 320), w4 = *(const f32x4*)(kbp + t * 320 + 64), k4 = *(const f32x4*)(kbp + t * 320 + 128),
                            a4 = *(const f32x4*)(kbp + t * 320 + 192), b4 = *(const f32x4*)(kbp + t * 320 + 256);
                const float vv = vbp[t * 32];
                float sa = (S.x * a4.x + S.y * a4.y) + (S.z * a4.z + S.w * a4.w);
                sa = row16_sum(sa);
                S = S - S * w4 + b4 * sa + k4 * vv;
                float y = (S.x * r4.x + S.y * r4.y) + (S.z * r4.z + S.w * r4.w);
                y = row16_sum(y);
                if (kq == 0) ybp[t * 32] = y;
            }
            if (c + 1 < NCH) SC_COMMIT(bi ^ 1);
            __syncthreads();
            if (tid < 128) {
                const int st = tid >> 2, sg = tid & 3; const float* yp = YB(bi) + st * 32 + sg * 8;
                const f32x4 y0 = *(const f32x4*)yp, y1 = *(const f32x4*)(yp + 4);
                u32x4 o; o.x = pk2(y0.x, y0.y); o.y = pk2(y0.z, y0.w); o.z = pk2(y1.x, y1.y); o.w = pk2(y1.z, y1.w);
                *(u32x4*)(Y + (row0 + (size_t)c * TC + st) * D + h * 64 + half * 32 + sg * 8) = o;
            }
        }
    }
    __syncthreads();
}

__global__ void __launch_bounds__(NT, 2) mk_fwd(Args args) {
    extern __shared__ __attribute__((aligned(16))) unsigned char lds[];
    const int G = gridDim.x, bid = blockIdx.x, NGW = G * NWAVES;
    PG8_LAS unsigned char* glds = (PG8_LAS unsigned char*)lds;
    typedef const __attribute__((address_space(4))) Args* ArgP;
#define PH_ARGS() ArgP ap = (ArgP)__builtin_amdgcn_kernarg_segment_ptr(); asm volatile("" : "+s"(ap)); unsigned char* const ws = ap->ws; (void)ws; \
    int tid = threadIdx.x; asm volatile("" : "+v"(tid)); const int lane = tid & 63, wave = __builtin_amdgcn_readfirstlane(tid >> 6), gw = bid * NWAVES + wave; (void)lane; (void)gw
#define INP(i) (ap->in[i])
#define WB(off) ((bf16_t*)(ws + (off)))
#define CB(i) ((bf16_t*)(ws + WS_C(i)))
#define D1P ((bf16_t*)ap->out)
#define YSP ((bf16_t*)((unsigned char*)ap->out + CH))
#define X2P ((float*)(ws + WS_C(2)))
#define ATTOP (CB(0) + (size_t)3 * M * 256)
#if MK_MULTI
    const int lo = args.ph_lo, hi = args.ph_hi; int ph = 0;
#define SEAM() do { ++ph; } while (0)
#define IN() (lo <= ph && ph < hi)
#else
    cg::grid_group grid = cg::this_grid();
#define SEAM() do { grid.sync(); } while (0)
#define IN() true
#endif

    if (IN()) {
        PH_ARGS();
        float* scr = (float*)(lds + wave * 16384);
        tr_job(INP(I_F1G), INP(I_F1U), FF, D, WB(WS_WGU1), D, 2 * FF, 1, 0, 0, scr, gw, NGW, lane);
        tr_job(INP(I_F1D), nullptr, D, FF, WB(WS_WD1), FF, D, 0, 0, D, scr, gw, NGW, lane);
        tr_job(INP(I_F2G), INP(I_F2U), FF, D, WB(WS_WGU2), D, 2 * FF, 1, 0, 0, scr, gw, NGW, lane);
        tr_job(INP(I_F2D), nullptr, D, FF, WB(WS_WD2), FF, D, 0, 0, D, scr, gw, NGW, lane);
        tr_job(INP(I_WIN), nullptr, INC, D, WB(WS_WIN), D, 5888, 0, 0, 5664, scr, gw, NGW, lane);
        tr_job(INP(I_WIN), nullptr, INC, D, WB(WS_WIN) + (size_t)5888 * D, D, 2048, 0, 5664, INC, scr, gw, NGW, lane);
        tr_job(INP(I_AUP), nullptr, D, 256, WB(WS_WUP), 256, D, 0, 0, D, scr, gw, NGW, lane);
        tr_job(INP(I_WOUT), nullptr, D, D, WB(WS_WOUT), D, D, 0, 0, D, scr, gw, NGW, lane);
        tr_job(INP(I_WO), nullptr, D, D, WB(WS_WO), D, D, 0, 0, D, scr, gw, NGW, lane);
        tr_job(INP(I_W2), nullptr, D, 64, WB(WS_LW), 128, D, 0, 0, D, scr, gw, NGW, lane);
        tr_job(INP(I_A2), nullptr, D, 64, WB(WS_LA2), 128, D, 0, 0, D, scr, gw, NGW, lane);
        tr_job(INP(I_G2), nullptr, D, 160, WB(WS_LG), 256, D, 0, 0, D, scr, gw, NGW, lane);
        for (int i = bid * NT + tid; i < SEQ * 8; i += G * NT) {
            const int pos = i >> 3, j = i & 7;
            const float invf = powf(500000.0f, -(float)j * 0.125f);
            const float ang = (float)pos * invf;
            double rev = (double)ang * 0.15915494309189535; rev -= rint(rev);
            const float rf = (float)rev;
            ((float*)(ws + WS_ROPE))[pos * 16 + j] = __builtin_amdgcn_cosf(rf); ((float*)(ws + WS_ROPE))[pos * 16 + 8 + j] = __builtin_amdgcn_sinf(rf);
        }
        for (int m = gw; m < M; m += NGW) norm_row(INP(I_X) + (size_t)m * D, nullptr, INP(I_F1N), CB(0) + (size_t)m * D, nullptr, lane);
    }
    SEAM();
    if (IN()) {
        PH_ARGS();
        pg8::Gemm g{CB(0), WB(WS_WGU1), M, 2 * FF, D, D, D}; pg8::StaticOrder S; S.init(M, 2 * FF, G, bid);
        pg8::EpiOp<OpGateUp> E{{CB(1)}};
        pg8::gemm_phase(glds, g, S, E);
    }
    SEAM();
    if (IN()) {
        PH_ARGS();
        pg8::Gemm g{CB(1), WB(WS_WD1), M, D, FF, FF, FF}; pg8::StaticOrder S; S.init(M, D, G, bid);
        pg8::EpiOp<OpStoreBf16> E{{D1P, D, 0.5f}};
        pg8::gemm_phase(glds, g, S, E);
    }
    SEAM();
    if (IN()) {
        PH_ARGS();
        for (int m = gw; m < M; m += NGW) norm_row(INP(I_X) + (size_t)m * D, D1P + (size_t)m * D, INP(I_MN), CB(0) + (size_t)m * D, nullptr, lane);
    }
    SEAM();
    if (IN()) {
        PH_ARGS();
        { pg8::Gemm g{CB(0), WB(WS_WIN), M, 2304, D, D, D}; pg8::StaticOrder S; S.init(M, 2304, G, bid);
          pg8::EpiOp<OpAttnQKV> E{{CB(1), CB(2), CB(3), ((float*)(ws + WS_ROPE))}};
          pg8::gemm_phase(glds, g, S, E); }
        { pg8::Gemm g{CB(0), WB(WS_WIN) + (size_t)2304 * D, M, 3584, D, D, D}; pg8::StaticOrder S; S.init(M, 3584, G, bid);
          pg8::EpiOp<OpRwkvZ> E{{CB(4), CB(5), CB(6), WB(WS_LA), WB(WS_HALO), WB(WS_HALOLA)}};
          pg8::gemm_phase(glds, g, S, E); }
    }
    SEAM();
    if (IN()) { PH_ARGS(); attn_phase(lds, CB(1), CB(2), CB(3), CB(0), (float*)(ws + WS_LSE), G, bid); }
    SEAM();
    if (IN()) {
        PH_ARGS();
        const float* mu = INP(I_MU) + 3072;
        for (int grp = gw; grp < M / 64; grp += NGW) {
            if (lane < 48) {
                const int c0 = lane * 8; bf16_t* base = WB(WS_LA) + (size_t)grp * 64 * LAW + c0;
                if (lane >= 36) { for (int rr = 0; rr < 64; ++rr) *(u32x4*)(base + (size_t)rr * LAW) = (u32x4){0u, 0u, 0u, 0u}; }
                else {
                    float mv[8];
#pragma unroll
                    for (int i = 0; i < 8; ++i) mv[i] = mu[c0 + i];
                    float prev[8];
                    if ((grp & 127) == 0) {
#pragma unroll
                        for (int i = 0; i < 8; ++i) prev[i] = 0.f; }
                    else unpack8(*(const u32x4*)(WB(WS_HALOLA) + (size_t)(grp - 1) * LAW + c0), prev);
                    for (int r8 = 0; r8 < 64; r8 += 8) {
                        u32x4 raw[8];
#pragma unroll
                        for (int j = 0; j < 8; ++j) raw[j] = *(const u32x4*)(base + (size_t)(r8 + j) * LAW);
#pragma unroll
                        for (int j = 0; j < 8; ++j) {
                            float cur[8], o[8]; unpack8(raw[j], cur);
#pragma unroll
                            for (int i = 0; i < 8; ++i) { const float z = cur[i] + (prev[i] - cur[i]) * mv[i];
                                o[i] = c0 < 64 ? (1.f - 2.f * __builtin_amdgcn_rcpf(1.f + __expf(2.f * z))) : (c0 < 128 ? z : sigm(z)); prev[i] = cur[i]; }
                            *(u32x4*)(base + (size_t)(r8 + j) * LAW) = pack8(o);
                        }
                    }
                }
            }
        }
        for (int it = gw; it < M / 2; it += NGW) {
            const int row = it * 2 + (lane >> 5), pc = lane & 31, hg = pc >> 3;
            const float l0 = ((float*)(ws + WS_LSE))[((size_t)0 * M + row) * 4 + hg], l1 = ((float*)(ws + WS_LSE))[((size_t)1 * M + row) * 4 + hg], l2 = ((float*)(ws + WS_LSE))[((size_t)2 * M + row) * 4 + hg];
            const float mx = fmaxf(l0, fmaxf(l1, l2)); float w0 = __expf(l0 - mx), w1 = __expf(l1 - mx), w2 = __expf(l2 - mx);
            const float iw = 1.f / (w0 + w1 + w2); w0 *= iw; w1 *= iw; w2 *= iw;
            float a[8], bb[8], c[8], o[8];
            unpack8(*(const u32x4*)(CB(0) + ((size_t)0 * M + row) * 256 + pc * 8), a); unpack8(*(const u32x4*)(CB(0) + ((size_t)1 * M + row) * 256 + pc * 8), bb);
            unpack8(*(const u32x4*)(CB(0) + ((size_t)2 * M + row) * 256 + pc * 8), c);
#pragma unroll
            for (int i = 0; i < 8; ++i) o[i] = w0 * a[i] + w1 * bb[i] + w2 * c[i];
            *(u32x4*)(ATTOP + (size_t)row * 256 + pc * 8) = pack8(o);
        }
    }
    SEAM();
    if (IN()) {
        PH_ARGS();
        { pg8::Gemm g{WB(WS_LA), WB(WS_LW), M, D, 128, LAW, 128}; pg8::StaticOrder S; S.init(M, D, G, bid);
          pg8::EpiOp<OpLora<0>> E{{CB(1), INP(I_W0)}};
          pg8::gemm_phase(glds, g, S, E); }
        { pg8::Gemm g{WB(WS_LA) + 64, WB(WS_LA2), M, D, 128, LAW, 128}; pg8::StaticOrder S; S.init(M, D, G, bid);
          pg8::EpiOp<OpLora<1>> E{{CB(3), INP(I_A0)}};
          pg8::gemm_phase(glds, g, S, E); }
    }
    SEAM();
    if (IN()) {
        PH_ARGS();
        const float* mu = INP(I_MU);
        const int r8 = lane >> 3, seg = lane & 7;
        for (int it = gw; it < (M / 64) * 16; it += NGW) {
            const int grp = it >> 4, h = it & 15, c0 = h * 64 + seg * 8;
            float mur[8], muk[8], muv[8], kkp[8], kap[8], rkp[8];
#pragma unroll
            for (int i = 0; i < 8; ++i) { mur[i] = mu[c0 + i]; muk[i] = mu[1024 + c0 + i]; muv[i] = mu[2048 + c0 + i];
                kkp[i] = INP(I_KK)[c0 + i]; kap[i] = INP(I_KA)[c0 + i]; rkp[i] = INP(I_RK)[c0 + i]; }
            u32x4 cr = (u32x4){0u, 0u, 0u, 0u}, ck = cr, cv = cr;
            if ((grp & 127) != 0) { const bf16_t* hp = WB(WS_HALO) + (size_t)(grp - 1) * 3072 + c0; cr = *(const u32x4*)hp; ck = *(const u32x4*)(hp + 1024); cv = *(const u32x4*)(hp + 2048); }
            for (int ps = 0; ps < 8; ++ps) {
                const size_t row = (size_t)grp * 64 + ps * 8 + r8, off = row * D + c0;
                const u32x4 Rw = *(const u32x4*)(CB(4) + off), Kw = *(const u32x4*)(CB(5) + off), Vw = *(const u32x4*)(CB(6) + off), Aw = *(const u32x4*)(CB(3) + off);
                u32x4 Rp, Kq, Vp;
                Rp.x = __shfl_up(Rw.x, 8); Rp.y = __shfl_up(Rw.y, 8); Rp.z = __shfl_up(Rw.z, 8); Rp.w = __shfl_up(Rw.w, 8);
                Kq.x = __shfl_up(Kw.x, 8); Kq.y = __shfl_up(Kw.y, 8); Kq.z = __shfl_up(Kw.z, 8); Kq.w = __shfl_up(Kw.w, 8);
                Vp.x = __shfl_up(Vw.x, 8); Vp.y = __shfl_up(Vw.y, 8); Vp.z = __shfl_up(Vw.z, 8); Vp.w = __shfl_up(Vw.w, 8);
                if (r8 == 0) { Rp = cr; Kq = ck; Vp = cv; }
                cr.x = __shfl(Rw.x, 56 + seg); cr.y = __shfl(Rw.y, 56 + seg); cr.z = __shfl(Rw.z, 56 + seg); cr.w = __shfl(Rw.w, 56 + seg);
                ck.x = __shfl(Kw.x, 56 + seg); ck.y = __shfl(Kw.y, 56 + seg); ck.z = __shfl(Kw.z, 56 + seg); ck.w = __shfl(Kw.w, 56 + seg);
                cv.x = __shfl(Vw.x, 56 + seg); cv.y = __shfl(Vw.y, 56 + seg); cv.z = __shfl(Vw.z, 56 + seg); cv.w = __shfl(Vw.w, 56 + seg);
                float rc[8], rp[8], kc[8], kp[8], vc[8], vp[8], av[8];
                unpack8(Rw, rc); unpack8(Rp, rp); unpack8(Kw, kc); unpack8(Kq, kp); unpack8(Vw, vc); unpack8(Vp, vp); unpack8(Aw, av);
                float ro[8], ko[8], vo[8], kko[8], bo[8]; float ss = 0.f, bs = 0.f;
#pragma unroll
                for (int i = 0; i < 8; ++i) {
                    ro[i] = rc[i] + (rp[i] - rc[i]) * mur[i]; const float kz = kc[i] + (kp[i] - kc[i]) * muk[i]; vo[i] = vc[i] + (vp[i] - vc[i]) * muv[i];
                    kko[i] = kz * kkp[i]; ss += kko[i] * kko[i];
                    ko[i] = kz * (1.f + (av[i] - 1.f) * kap[i]); bs += ro[i] * ko[i] * rkp[i];
                }
                ss += __shfl_xor(ss, 1); ss += __shfl_xor(ss, 2); ss += __shfl_xor(ss, 4);
                bs += __shfl_xor(bs, 1); bs += __shfl_xor(bs, 2); bs += __shfl_xor(bs, 4);
                const float inv = 1.f / fmaxf(sqrtf(ss), 1e-12f);
#pragma unroll
                for (int i = 0; i < 8; ++i) { kko[i] *= inv; bo[i] = kko[i] * av[i]; }
                *(u32x4*)(CB(4) + off) = pack8(ro); *(u32x4*)(CB(5) + off) = pack8(ko); *(u32x4*)(CB(6) + off) = pack8(vo);
                *(u32x4*)(CB(2) + off) = pack8(kko); *(u32x4*)(CB(3) + off) = pack8(bo);
                if (seg == 0) ((float*)(ws + WS_BC))[row * 16 + h] = bs;
            }
        }
    }
    SEAM();
    if (IN()) { PH_ARGS(); scan_phase(lds, CB(4), CB(1), CB(5), CB(6), CB(2), CB(3), YSP, G, bid); }
    SEAM();
    if (IN()) {
        PH_ARGS();
        { pg8::Gemm g{WB(WS_LA) + 128, WB(WS_LG), M, D, 256, LAW, 256}; pg8::StaticOrder S; S.init(M, D, G, bid);
          pg8::EpiOp<OpStoreBf16> E{{CB(1), D, 1.0f}};
          pg8::gemm_phase(glds, g, S, E); }
        for (int m = gw; m < M; m += NGW) norm_row(INP(I_X) + (size_t)m * D, D1P + (size_t)m * D, INP(I_MN), CB(2) + (size_t)m * D, nullptr, lane);
    }
    SEAM();
    if (IN()) {
        PH_ARGS();
        const int r8 = lane >> 3, seg = lane & 7;
        for (int it = gw; it < (M / 8) * 16; it += NGW) {
            const int h = it & 15; const size_t row = (size_t)(it >> 4) * 8 + r8; const int c0 = h * 64 + seg * 8; const size_t off = row * D + c0;
            float yv[8], vv[8], gv[8], o[8];
            unpack8(*(const u32x4*)(YSP + off), yv); unpack8(*(const u32x4*)(CB(6) + off), vv); unpack8(*(const u32x4*)(CB(1) + off), gv);
            const float bc = ((float*)(ws + WS_BC))[row * 16 + h];
            float s = 0.f;
#pragma unroll
            for (int i = 0; i < 8; ++i) s += yv[i];
            s += __shfl_xor(s, 1); s += __shfl_xor(s, 2); s += __shfl_xor(s, 4);
            const float mean = s * (1.f / 64.f); float q = 0.f;
#pragma unroll
            for (int i = 0; i < 8; ++i) { yv[i] -= mean; q += yv[i] * yv[i]; }
            q += __shfl_xor(q, 1); q += __shfl_xor(q, 2); q += __shfl_xor(q, 4);
            const float rstd = rsqrtf(q * (1.f / 64.f) + GN_EPS);
#pragma unroll
            for (int i = 0; i < 8; ++i) o[i] = (yv[i] * rstd * INP(I_LNW)[c0 + i] + INP(I_LNB)[c0 + i] + bc * vv[i]) * gv[i];
            *(u32x4*)(CB(3) + off) = pack8(o);
        }
    }
    SEAM();
    if (IN()) {
        PH_ARGS();
        { pg8::Gemm g{CB(2), WB(WS_WIN) + (size_t)5888 * D, M, 2048, D, D, D}; pg8::StaticOrder S; S.init(M, 2048, G, bid);
          pg8::EpiOp<OpGates> E{{CB(4), CB(5), INP(I_GB)}};
          pg8::gemm_phase(glds, g, S, E); }
        { pg8::Gemm g{ATTOP, WB(WS_WUP), M, D, 256, 256, 256}; pg8::StaticOrder S; S.init(M, D, G, bid);
          pg8::EpiOp<OpStoreBf16> E{{CB(6), D, 1.0f}};
          pg8::gemm_phase(glds, g, S, E); }
    }
    SEAM();
    if (IN()) {
        PH_ARGS();
        pg8::Gemm g{CB(3), WB(WS_WOUT), M, D, D, D, D}; pg8::StaticOrder S; S.init(M, D, G, bid);
        pg8::EpiOp<OpMerge> E{{CB(4), CB(6), CB(5), CB(1)}};
        pg8::gemm_phase(glds, g, S, E);
    }
    SEAM();
    if (IN()) {
        PH_ARGS();
        pg8::Gemm g{CB(1), WB(WS_WO), M, D, D, D, D}; pg8::StaticOrder S; S.init(M, D, G, bid);
        pg8::EpiOp<OpRes> E{{INP(I_X), D1P, X2P, 1.0f}};
        pg8::gemm_phase(glds, g, S, E);
    }
    SEAM();
    if (IN()) {
        PH_ARGS();
        for (int m = gw; m < M; m += NGW) norm_row(X2P + (size_t)m * D, nullptr, INP(I_F2N), CB(0) + (size_t)m * D, nullptr, lane);
    }
    SEAM();
    if (IN()) {
        PH_ARGS();
        pg8::Gemm g{CB(0), WB(WS_WGU2), M, 2 * FF, D, D, D}; pg8::StaticOrder S; S.init(M, 2 * FF, G, bid);
        pg8::EpiOp<OpGateUp> E{{CB(4)}};
        pg8::gemm_phase(glds, g, S, E);
    }
    SEAM();
    if (IN()) {
        PH_ARGS();
        pg8::Gemm g{CB(4), WB(WS_WD2), M, D, FF, FF, FF}; pg8::StaticOrder S; S.init(M, D, G, bid);
        pg8::EpiOp<OpRes> E{{X2P, nullptr, ap->out, 0.5f}};
        pg8::gemm_phase(glds, g, S, E);
    }
    SEAM();
    if (IN()) {
        PH_ARGS();
        for (int m = gw; m < M; m += NGW) norm_row(ap->out + (size_t)m * D, nullptr, INP(I_FN), nullptr, ap->out + (size_t)m * D, lane);
    }
}
constexpr int N_PHASES = 19;

extern "C" void kernel_launch(void* const* d_in, const int* in_sizes, int n_in, void* d_out, int out_size, void* d_ws, size_t ws_size, hipStream_t stream) {
    static int grid = 0;
    if (grid == 0) {
        if (n_in != 27 || in_sizes[0] != M * D || out_size != M * D || ws_size < WS_END) { fprintf(stderr, "kernel_launch: unexpected shapes (n_in %d, in0 %d, out %d, ws %zu)\n", n_in, n_in > 0 ? in_sizes[0] : -1, out_size, ws_size); grid = -1; return; }
        int dev = 0, cus = 0, per_cu = 0;
        hipGetDevice(&dev); hipDeviceGetAttribute(&cus, hipDeviceAttributeMultiprocessorCount, dev);
        if (hipFuncSetAttribute((const void*)mk_fwd, hipFuncAttributeMaxDynamicSharedMemorySize, LDS_BYTES) != hipSuccess) { fprintf(stderr, "kernel_launch: hipFuncSetAttribute failed\n"); grid = -1; return; }
        if (hipOccupancyMaxActiveBlocksPerMultiprocessor(&per_cu, (const void*)mk_fwd, NT, LDS_BYTES) != hipSuccess || per_cu < 1) { fprintf(stderr, "kernel_launch: occupancy query says %d\n", per_cu); per_cu = 1; }
        (void)hipGetLastError();
        grid = cus;
    }
    if (grid < 0) return;
    Args a{};
    for (int i = 0; i < 27; ++i) a.in[i] = (const float*)d_in[i];
    a.out = (float*)d_out; a.ws = (unsigned char*)d_ws;
#if MK_MULTI
    for (int p = 0; p < N_PHASES; ++p) { a.ph_lo = p; a.ph_hi = p + 1; hipLaunchKernelGGL(mk_fwd, dim3(grid), dim3(NT), LDS_BYTES, stream, a); }
#else
    a.ph_lo = 0; a.ph_hi = N_PHASES;
    void* kargs[] = {&a};
    hipError_t e = hipLaunchCooperativeKernel((const void*)mk_fwd, dim3(grid), dim3(NT), kargs, LDS_BYTES, stream);
    if (e != hipSuccess) fprintf(stderr, "kernel_launch: cooperative launch failed: %s (grid %d)\n", hipGetErrorString(e), grid);
#endif
}
```

```cpp
#include <hip/hip_runtime.h>
#include <hip/hip_cooperative_groups.h>
#include <cstdio>
#include <cstdint>
namespace cg = cooperative_groups;

#ifndef MK_MULTI
#define MK_MULTI 0
#endif
#ifndef ATT_REP
#define ATT_REP 1
#endif
#ifndef PROBE_MASK
#define PROBE_MASK 0u
#endif

namespace pg8 {
#define PG8_LAS __attribute__((address_space(3)))
typedef unsigned short bf16_t;
typedef short bf16x8 __attribute__((ext_vector_type(8)));
typedef float f32x4 __attribute__((ext_vector_type(4)));
typedef unsigned u32x4 __attribute__((ext_vector_type(4)));
constexpr int BM = 256, BK = 64, HALF = 128, HTB = HALF * BK * 2, STAGE_BYTES = 8 * HTB, NXCD = 8, WGM = 8;

__host__ __device__ __forceinline__ int lds_byte(int r, int c) { const int st = (r >> 4) * 2 + (c >> 5), rr = r & 15, cc = c & 31, ob = rr * 64 + cc * 2; return st * 1024 + (ob ^ (((ob >> 9) & 1) << 5)); }
__host__ __device__ __forceinline__ void stage_rc(int b, int& R, int& C) { const int st = b / 1024, sb = b % 1024, swz = sb ^ (((sb >> 9) & 1) << 5); R = (st >> 1) * 16 + swz / 64; C = (st & 1) * 32 + (swz % 64) / 2; }
__host__ __device__ __forceinline__ int perm32(int rho) { const int n = rho >> 4, i = rho & 15; return 8 * (i >> 2) + 4 * n + (i & 3); }

struct Unit { int pm, pn; };
struct Gemm { const bf16_t* A; const bf16_t* Bt; int M, N, K, lda, ldb; };

struct StaticOrder {
    int nM, nN, nwg, G, c;
    __host__ __device__ void init(int M, int N, int G_, int c_) { nM = M / BM; nN = N / BM; nwg = nM * nN; G = G_; c = c_; }
    __host__ __device__ bool next(int i, Unit& u) const {
        const long L = (long)i * G + c; if (L >= nwg) return false;
        int wgid = (int)L; { const int q = nwg / NXCD, r = nwg % NXCD, xcd = wgid % NXCD, off = wgid / NXCD; wgid = (xcd < r ? xcd * (q + 1) : r * (q + 1) + (xcd - r) * q) + off; }
        const int nig = WGM * nN, gid = wgid / nig, fm = gid * WGM, gsz = (nM - fm) < WGM ? (nM - fm) : WGM;
        u.pm = fm + ((wgid % nig) % gsz); u.pn = (wgid % nig) / gsz; return true;
    }
};

__device__ __forceinline__ unsigned cvt_pk_bf16(float lo, float hi) { unsigned r; asm volatile("v_cvt_pk_bf16_f32 %0, %1, %2" : "=v"(r) : "v"(lo), "v"(hi)); return r; }

template <class Op> struct EpiOp {
    Op op;
    __device__ __forceinline__ void operator()(const f32x4 (&acc)[2][2][4][2], const Unit& u, int wr, int wc, int fr, int fq) const {
#pragma unroll
        for (int ai = 0; ai < 2; ++ai)
#pragma unroll
            for (int m = 0; m < 4; ++m) {
                const int row = u.pm * BM + ai * HALF + wr * 64 + m * 16 + fr;
                op(acc[ai][0][m][0], acc[ai][0][m][1], acc[ai][1][m][0], acc[ai][1][m][1], row, u.pn, wc, fq);
            }
    }
};

template <class Epi, class Sched>
__device__ __forceinline__ void gemm_phase(PG8_LAS unsigned char* lds, const Gemm g, const Sched& S, const Epi& E) {
    int tid_ = threadIdx.x; asm volatile("" : "+v"(tid_));
    const int tid = tid_, wid = __builtin_amdgcn_readfirstlane(tid >> 6), lane = tid & 63, wr = wid >> 2, wc = wid & 3, fr = lane & 15, fq = lane >> 4;
    const int K = g.K, nt = K / BK;
    unsigned voffA[2], voffB[2];
#pragma unroll
    for (int i = 0; i < 2; ++i) { int R, C; stage_rc(tid * 16 + i * 8192, R, C); const int Rb = (R & ~31) + perm32(R & 31);
        voffA[i] = (unsigned)(R * g.lda + C) * 2u; voffB[i] = (unsigned)(Rb * g.ldb + C) * 2u; }
    const size_t kstep = (size_t)(BK * 2);
    const size_t hstepA = (size_t)HALF * g.lda * 2, hstepB = (size_t)HALF * g.ldb * 2;
    const size_t tstepA = 2 * hstepA, tstepB = 2 * hstepB;
    const unsigned ldsw = (unsigned)wid * 1024u;
    const int aoff = lds_byte(wr * 64 + fr, fq * 8), boff = lds_byte(wc * 32 + fr, fq * 8);
#define PG8_SA(b, h) (((b) * 2 + (h)) * HTB)
#define PG8_SB(b, h) ((4 + (b) * 2 + (h)) * HTB)
#define PG8_STAGE(bufoff, gbase, voff) do { _Pragma("unroll") for (int _i = 0; _i < 2; ++_i) \
        __builtin_amdgcn_global_load_lds((const unsigned*)((const char*)(gbase) + (voff)[_i]), (PG8_LAS unsigned*)(lds + (bufoff) + ldsw + _i * 8192), 16, 0, 0); } while (0)
#define PG8_LDA(dst, b, h) do { _Pragma("unroll") for (int m = 0; m < 4; ++m) _Pragma("unroll") for (int k = 0; k < 2; ++k) dst[m][k] = *(const PG8_LAS bf16x8*)(lds + PG8_SA(b, h) + aoff + m * 2048 + k * 1024); } while (0)
#define PG8_LDB(dst, b, h) do { _Pragma("unroll") for (int n = 0; n < 2; ++n) _Pragma("unroll") for (int k = 0; k < 2; ++k) dst[n][k] = *(const PG8_LAS bf16x8*)(lds + PG8_SB(b, h) + boff + n * 2048 + k * 1024); } while (0)
#define PG8_MMA(ai, bj, At, Bt) do { __builtin_amdgcn_s_setprio(1); _Pragma("unroll") for (int m = 0; m < 4; ++m) _Pragma("unroll") for (int n = 0; n < 2; ++n) _Pragma("unroll") for (int k = 0; k < 2; ++k) \
        acc[ai][bj][m][n] = __builtin_amdgcn_mfma_f32_16x16x32_bf16(Bt[n][k], At[m][k], acc[ai][bj][m][n], 0, 0, 0); __builtin_amdgcn_s_setprio(0); } while (0)
#define PG8_WAIT_V(n) asm volatile("s_waitcnt vmcnt(" #n ")" ::: "memory")
#define PG8_WAIT_L(n) asm volatile("s_waitcnt lgkmcnt(" #n ")" ::: "memory")
#define PG8_BAR __builtin_amdgcn_s_barrier()
#define PG8_SCHED __builtin_amdgcn_sched_barrier(0)
    Unit cur, nxt; int ui = 0;
    if (!S.next(0, cur)) return;
    f32x4 acc[2][2][4][2];
#pragma unroll
    for (int a = 0; a < 2; ++a)
#pragma unroll
        for (int b = 0; b < 2; ++b)
#pragma unroll
            for (int m = 0; m < 4; ++m)
#pragma unroll
                for (int n = 0; n < 2; ++n) acc[a][b][m][n] = (f32x4){0.f, 0.f, 0.f, 0.f};
    bf16x8 At[4][2], B0[2][2], B1[2][2];
    const char* cA = (const char*)g.A + (size_t)cur.pm * tstepA; const char* cB = (const char*)g.Bt + (size_t)cur.pn * tstepB;
    PG8_STAGE(PG8_SB(0, 0), cB, voffB); PG8_STAGE(PG8_SB(0, 1), cB + hstepB, voffB); PG8_STAGE(PG8_SA(0, 0), cA, voffA); PG8_STAGE(PG8_SA(0, 1), cA + hstepA, voffA);
    if (wr == 1) PG8_BAR;
    PG8_WAIT_V(2); PG8_BAR;
    PG8_STAGE(PG8_SB(1, 0), cB + kstep, voffB); PG8_STAGE(PG8_SA(1, 0), cA + kstep, voffA); PG8_STAGE(PG8_SB(1, 1), cB + hstepB + kstep, voffB);
    PG8_WAIT_V(6); PG8_BAR;
    for (;;) {
        const bool has_next = S.next(ui + 1, nxt);
        const char* nA = has_next ? (const char*)g.A + (size_t)nxt.pm * tstepA : cA; const char* nB = has_next ? (const char*)g.Bt + (size_t)nxt.pn * tstepB : cB;
        for (int t = 0; t < nt; t += 2) {
            const bool last = (t == nt - 2);
            const char* a1 = cA + (size_t)(t + 1) * kstep;
            const char* a2 = last ? nA : cA + (size_t)(t + 2) * kstep; const char* b2 = last ? nB : cB + (size_t)(t + 2) * kstep;
            const char* a3 = a2 + kstep; const char* b3 = b2 + kstep;
            PG8_LDB(B0, 0, 0); PG8_LDB(B1, 0, 1); PG8_SCHED; PG8_LDA(At, 0, 0); PG8_STAGE(PG8_SA(1, 1), a1 + hstepA, voffA);
            PG8_WAIT_V(8); PG8_WAIT_L(0); PG8_BAR; PG8_MMA(0, 0, At, B0); PG8_MMA(0, 1, At, B1); PG8_BAR; PG8_SCHED;
            PG8_LDA(At, 0, 1); PG8_STAGE(PG8_SB(0, 0), b2, voffB); PG8_STAGE(PG8_SB(0, 1), b2 + hstepB, voffB); PG8_STAGE(PG8_SA(0, 0), a2, voffA);
            PG8_WAIT_V(8); PG8_WAIT_L(0); PG8_BAR; PG8_MMA(1, 0, At, B0); PG8_MMA(1, 1, At, B1); PG8_BAR; PG8_SCHED;
            PG8_LDB(B0, 1, 0); PG8_LDB(B1, 1, 1); PG8_SCHED; PG8_LDA(At, 1, 0); PG8_STAGE(PG8_SA(0, 1), a2 + hstepA, voffA);
            PG8_WAIT_V(8); PG8_WAIT_L(0); PG8_BAR; PG8_MMA(0, 0, At, B0); PG8_MMA(0, 1, At, B1); PG8_BAR; PG8_SCHED;
            PG8_LDA(At, 1, 1); PG8_STAGE(PG8_SB(1, 0), b3, voffB); PG8_STAGE(PG8_SB(1, 1), b3 + hstepB, voffB); PG8_STAGE(PG8_SA(1, 0), a3, voffA);
            PG8_WAIT_V(8); PG8_WAIT_L(0); PG8_BAR; PG8_MMA(1, 0, At, B0); PG8_MMA(1, 1, At, B1); PG8_BAR; PG8_SCHED;
        }
        if (wr == 0) PG8_BAR;
        E(acc, cur, wr, wc, fr, fq);
        if (!has_next) break;
#pragma unroll
        for (int a = 0; a < 2; ++a)
#pragma unroll
            for (int b = 0; b < 2; ++b)
#pragma unroll
                for (int m = 0; m < 4; ++m)
#pragma unroll
                    for (int n = 0; n < 2; ++n) acc[a][b][m][n] = (f32x4){0.f, 0.f, 0.f, 0.f};
        cur = nxt; cA = nA; cB = nB; ++ui;
        if (wr == 1) PG8_BAR;
    }
    PG8_WAIT_V(0);
    PG8_BAR;
#undef PG8_SA
#undef PG8_SB
#undef PG8_STAGE
#undef PG8_LDA
#undef PG8_LDB
#undef PG8_MMA
#undef PG8_WAIT_V
#undef PG8_WAIT_L
#undef PG8_BAR
#undef PG8_SCHED
}
}

using pg8::bf16_t; using pg8::f32x4; using pg8::u32x4; using pg8::bf16x8;
typedef unsigned u32x2 __attribute__((ext_vector_type(2)));
#define LAS __attribute__((address_space(3)))

constexpr int BATCH = 8, SEQ = 8192, D = 1024, FF = 2816, M = BATCH * SEQ;
constexpr int AW = 768, RS = 3360, INC = 7712;
constexpr int LAW = 384;
constexpr int NWAVES = 8, NT = 512;
constexpr float NORM_EPS = 1e-6f, GN_EPS = 64e-5f;

constexpr size_t MiB = 1u << 20;
constexpr size_t WS_WGU1 = 1 * MiB;
constexpr size_t WS_WD1 = WS_WGU1 + 11 * MiB;
constexpr size_t WS_WGU2 = WS_WD1 + 5 * MiB + MiB / 2;
constexpr size_t WS_WD2 = WS_WGU2 + 11 * MiB;
constexpr size_t WS_WIN = WS_WD2 + 5 * MiB + MiB / 2;
constexpr size_t WS_WUP = WS_WIN + 15 * MiB + MiB / 2;
constexpr size_t WS_WOUT = WS_WUP + MiB / 2;
constexpr size_t WS_WO = WS_WOUT + 2 * MiB;
constexpr size_t WS_LW = WS_WO + 2 * MiB;
constexpr size_t WS_LA2 = WS_LW + MiB / 4;
constexpr size_t WS_LG = WS_LA2 + MiB / 4;
constexpr size_t WS_ROPE = WS_LG + MiB / 2;
static_assert(WS_ROPE + MiB / 2 <= 56 * MiB, "weights region");
constexpr size_t WS_LA = 56 * MiB;
constexpr size_t WS_HALO = 104 * MiB;
constexpr size_t WS_HALOLA = 110 * MiB;
constexpr size_t WS_BC = 111 * MiB;
constexpr size_t WS_LSE = 115 * MiB;
constexpr size_t WS_BRKR = 118 * MiB;
constexpr size_t CH = 128 * MiB;
constexpr size_t WS_C0 = 128 * MiB;
#define WS_C(i) (WS_C0 + (size_t)(i) * CH)
constexpr size_t WS_END = 1024 * MiB;
constexpr int LDS_BYTES = 147456;

__device__ __forceinline__ float bf2f(unsigned short h) { return __uint_as_float(((unsigned)h) << 16); }
__device__ __forceinline__ float bflo(unsigned w) { return __uint_as_float(w << 16); }
__device__ __forceinline__ float bfhi(unsigned w) { return __uint_as_float(w & 0xffff0000u); }
__device__ __forceinline__ unsigned pk2(float lo, float hi) { return pg8::cvt_pk_bf16(lo, hi); }
__device__ __forceinline__ void unpack8(const u32x4 w, float (&f)[8]) { f[0] = bflo(w.x); f[1] = bfhi(w.x); f[2] = bflo(w.y); f[3] = bfhi(w.y); f[4] = bflo(w.z); f[5] = bfhi(w.z); f[6] = bflo(w.w); f[7] = bfhi(w.w); }
__device__ __forceinline__ u32x4 pack8(const float (&f)[8]) { u32x4 w; w.x = pk2(f[0], f[1]); w.y = pk2(f[2], f[3]); w.z = pk2(f[4], f[5]); w.w = pk2(f[6], f[7]); return w; }
__device__ __forceinline__ float sigm(float x) { return __builtin_amdgcn_rcpf(1.f + __expf(-x)); }
__device__ __forceinline__ float wave_sum(float v) {
#pragma unroll
    for (int o = 1; o < 64; o <<= 1) v += __shfl_xor(v, o);
    return v;
}

struct OpGateUp {
    bf16_t* H;
    __device__ __forceinline__ void operator()(const f32x4 g0, const f32x4 g1, const f32x4 u0, const f32x4 u1, int row, int pn, int wc, int fq) const {
        const int col = pn * 128 + wc * 32 + 8 * fq; float o[8];
#pragma unroll
        for (int i = 0; i < 4; ++i) { o[i] = g0[i] * sigm(g0[i]) * u0[i]; o[4 + i] = g1[i] * sigm(g1[i]) * u1[i]; }
        *(u32x4*)(H + (size_t)row * FF + col) = pack8(o);
    }
};
struct OpStoreBf16 {
    bf16_t* O; int ld; float scale;
    __device__ __forceinline__ void operator()(const f32x4 a0, const f32x4 a1, const f32x4 b0, const f32x4 b1, int row, int pn, int wc, int fq) const {
        const int col = pn * 256 + wc * 32 + 8 * fq; float o[8];
#pragma unroll
        for (int i = 0; i < 4; ++i) { o[i] = a0[i] * scale; o[4 + i] = a1[i] * scale; }
        *(u32x4*)(O + (size_t)row * ld + col) = pack8(o);
#pragma unroll
        for (int i = 0; i < 4; ++i) { o[i] = b0[i] * scale; o[4 + i] = b1[i] * scale; }
        *(u32x4*)(O + (size_t)row * ld + col + 128) = pack8(o);
    }
};
struct OpRes {
    const float* base; const bf16_t* dlt; float* out; float scale;
    __device__ __forceinline__ void half(const f32x4 a0, const f32x4 a1, size_t off) const {
        f32x4 r0 = a0 * scale, r1 = a1 * scale;
        if (base) { r0 += *(const f32x4*)(base + off); r1 += *(const f32x4*)(base + off + 4); }
        if (dlt) { float d[8]; unpack8(*(const u32x4*)(dlt + off), d); r0 += (f32x4){d[0], d[1], d[2], d[3]}; r1 += (f32x4){d[4], d[5], d[6], d[7]}; }
        *(f32x4*)(out + off) = r0; *(f32x4*)(out + off + 4) = r1;
    }
    __device__ __forceinline__ void operator()(const f32x4 a0, const f32x4 a1, const f32x4 b0, const f32x4 b1, int row, int pn, int wc, int fq) const {
        const size_t off = (size_t)row * D + pn * 256 + wc * 32 + 8 * fq;
        half(a0, a1, off); half(b0, b1, off + 128);
    }
};
struct OpAttnQKV {
    bf16_t* q; bf16_t* k; bf16_t* v; const float* rope;
    __device__ __forceinline__ void half(const f32x4 a0, const f32x4 a1, bf16_t* dst, int row, int wc, int fq, int which) const {
        float o[8];
#pragma unroll
        for (int i = 0; i < 4; ++i) { o[i] = a0[i]; o[4 + i] = a1[i]; }
        if (which < 2 && (wc & 1) == 0) {
            float p[8];
#pragma unroll
            for (int i = 0; i < 8; ++i) p[i] = __shfl_xor(o[i], 16);
            if (fq < 2) {
                const float* cs = rope + (size_t)(row & (SEQ - 1)) * 16;
                const f32x4 c0 = *(const f32x4*)(cs), c1 = *(const f32x4*)(cs + 4), s0 = *(const f32x4*)(cs + 8), s1 = *(const f32x4*)(cs + 12);
                const float sg = fq == 0 ? -1.f : 1.f;
#pragma unroll
                for (int i = 0; i < 4; ++i) { o[i] = o[i] * c0[i] + sg * p[i] * s0[i]; o[4 + i] = o[4 + i] * c1[i] + sg * p[4 + i] * s1[i]; }
            }
        }
        if (which == 0) {
#pragma unroll
            for (int i = 0; i < 8; ++i) o[i] *= 0.125f;
        }
        *(u32x4*)dst = pack8(o);
    }
    __device__ __forceinline__ void operator()(const f32x4 a0, const f32x4 a1, const f32x4 b0, const f32x4 b1, int row, int pn, int wc, int fq) const {
        const int which = pn / 3, col = (pn - which * 3) * 256 + wc * 32 + 8 * fq;
        bf16_t* base = q + (size_t)which * (CH / 2) + (size_t)row * AW + col;
        half(a0, a1, base, row, wc, fq, which); half(b0, b1, base + 128, row, wc, fq, which);
    }
};
struct OpRwkvZ {
    bf16_t* r; bf16_t* k; bf16_t* v; bf16_t* la; bf16_t* halo; bf16_t* halola;
    __device__ __forceinline__ void operator()(const f32x4 a0, const f32x4 a1, const f32x4 b0, const f32x4 b1, int row, int pn, int wc, int fq) const {
        float o0[8], o1[8];
#pragma unroll
        for (int i = 0; i < 4; ++i) { o0[i] = a0[i]; o0[4 + i] = a1[i]; o1[i] = b0[i]; o1[4 + i] = b1[i]; }
        const u32x4 w0 = pack8(o0), w1 = pack8(o1);
        const bool hrow = (row & 63) == 63;
        if (pn < 12) {
            const int s = pn >> 2, col = (pn & 3) * 256 + wc * 32 + 8 * fq;
            bf16_t* dst = r + (size_t)s * (CH / 2) + (size_t)row * D + col;
            *(u32x4*)dst = w0; *(u32x4*)(dst + 128) = w1;
            if (hrow) { bf16_t* h = halo + (size_t)(row >> 6) * 3072 + s * 1024 + col; *(u32x4*)h = w0; *(u32x4*)(h + 128) = w1; }
        } else {
            const int col = (pn - 12) * 256 + wc * 32 + 8 * fq;
            if (col < 288) { *(u32x4*)(la + (size_t)row * LAW + col) = w0; if (hrow) *(u32x4*)(halola + (size_t)(row >> 6) * LAW + col) = w0; }
            if (col + 128 < 288) { *(u32x4*)(la + (size_t)row * LAW + col + 128) = w1; if (hrow) *(u32x4*)(halola + (size_t)(row >> 6) * LAW + col + 128) = w1; }
        }
    }
};
struct OpGates {
    bf16_t* ga; bf16_t* gr; const float* bias;
    __device__ __forceinline__ void operator()(const f32x4 a0, const f32x4 a1, const f32x4 b0, const f32x4 b1, int row, int pn, int wc, int fq) const {
        const int s = pn >> 2, col = (pn & 3) * 256 + wc * 32 + 8 * fq; const float* bp = bias + s * 1024 + col;
        bf16_t* dst = ga + (size_t)s * (CH / 2) + (size_t)row * D + col; float o[8];
        { const f32x4 c0 = *(const f32x4*)bp, c1 = *(const f32x4*)(bp + 4);
#pragma unroll
          for (int i = 0; i < 4; ++i) { o[i] = sigm(a0[i] + c0[i]); o[4 + i] = sigm(a1[i] + c1[i]); }
          *(u32x4*)dst = pack8(o); }
        { const f32x4 c0 = *(const f32x4*)(bp + 128), c1 = *(const f32x4*)(bp + 132);
#pragma unroll
          for (int i = 0; i < 4; ++i) { o[i] = sigm(b0[i] + c0[i]); o[4 + i] = sigm(b1[i] + c1[i]); }
          *(u32x4*)(dst + 128) = pack8(o); }
    }
};
template <int MODE> struct OpLora {
    bf16_t* O; const float* p0;
    __device__ __forceinline__ float f(float x) const { const float s = sigm(x); return MODE == 0 ? 1.f - __expf(-0.60653065971f * s) : s; }
    __device__ __forceinline__ void operator()(const f32x4 a0, const f32x4 a1, const f32x4 b0, const f32x4 b1, int row, int pn, int wc, int fq) const {
        const int col = pn * 256 + wc * 32 + 8 * fq; const float* bp = p0 + col; bf16_t* dst = O + (size_t)row * D + col; float o[8];
        { const f32x4 c0 = *(const f32x4*)bp, c1 = *(const f32x4*)(bp + 4);
#pragma unroll
          for (int i = 0; i < 4; ++i) { o[i] = f(a0[i] + c0[i]); o[4 + i] = f(a1[i] + c1[i]); }
          *(u32x4*)dst = pack8(o); }
        { const f32x4 c0 = *(const f32x4*)(bp + 128), c1 = *(const f32x4*)(bp + 132);
#pragma unroll
          for (int i = 0; i < 4; ++i) { o[i] = f(b0[i] + c0[i]); o[4 + i] = f(b1[i] + c1[i]); }
          *(u32x4*)(dst + 128) = pack8(o); }
    }
};
struct OpMerge {
    const bf16_t* ga; const bf16_t* ya; const bf16_t* gr; bf16_t* out;
    __device__ __forceinline__ void half(const f32x4 a0, const f32x4 a1, size_t off) const {
        float A[8], Y[8], R[8], o[8]; unpack8(*(const u32x4*)(ga + off), A); unpack8(*(const u32x4*)(ya + off), Y); unpack8(*(const u32x4*)(gr + off), R);
#pragma unroll
        for (int i = 0; i < 4; ++i) { o[i] = A[i] * Y[i] + R[i] * a0[i]; o[4 + i] = A[4 + i] * Y[4 + i] + R[4 + i] * a1[i]; }
        *(u32x4*)(out + off) = pack8(o);
    }
    __device__ __forceinline__ void operator()(const f32x4 a0, const f32x4 a1, const f32x4 b0, const f32x4 b1, int row, int pn, int wc, int fq) const {
        const size_t off = (size_t)row * D + pn * 256 + wc * 32 + 8 * fq;
        half(a0, a1, off); half(b0, b1, off + 128);
    }
};

struct Args {
    const float* in[27]; float* out; unsigned char* ws; int ph_lo, ph_hi;
};
enum { I_X = 0, I_F1N, I_F1G, I_F1U, I_F1D, I_MN, I_WIN, I_GB, I_AUP, I_MU, I_W0, I_W2, I_A0, I_A2, I_G2, I_KK, I_KA, I_RK, I_LNW, I_LNB, I_WOUT, I_WO, I_F2N, I_F2G, I_F2U, I_F2D, I_FN };

__device__ __forceinline__ void tr_job(const float* W0, const float* W1, int ldw, int Ksrc, bf16_t* WT, int ldt, int nrows, int mode, int coff, int climit,
                                       float* scr, int gw, int NGW, int lane) {
    const int nblk = nrows / 32, nitems = (ldt / 64) * nblk;
    for (int it = gw; it < nitems; it += NGW) {
        const int kb = it / nblk, nb = it % nblk, k0 = 64 * kb;
        const float* W = W0; int col0; bool valid = true;
        if (mode == 0) { col0 = coff + 32 * nb; valid = col0 < climit; }
        else { const int tile = nb >> 3, j0 = (nb & 7) * 32; W = j0 < 128 ? W0 : W1; col0 = tile * 128 + (j0 & 127); }
#pragma unroll 8
        for (int i = 0; i < 32; ++i) { const int kk = 2 * i + (lane >> 5), k = k0 + kk;
            scr[kk * 33 + (lane & 31)] = (valid && k < Ksrc) ? W[(size_t)k * ldw + col0 + (lane & 31)] : 0.f; }
        __builtin_amdgcn_s_waitcnt(0); asm volatile("" ::: "memory");
        const int c = lane & 7;
#pragma unroll
        for (int j = 0; j < 4; ++j) { const int n = (lane >> 3) + 8 * j; const float* s = scr + (8 * c) * 33 + n;
            u32x4 o; o.x = pk2(s[0 * 33], s[1 * 33]); o.y = pk2(s[2 * 33], s[3 * 33]); o.z = pk2(s[4 * 33], s[5 * 33]); o.w = pk2(s[6 * 33], s[7 * 33]);
            *(u32x4*)(WT + (size_t)(32 * nb + n) * ldt + k0 + 8 * c) = o; }
        __builtin_amdgcn_s_waitcnt(0); asm volatile("" ::: "memory");
    }
}
__device__ __forceinline__ void norm_row(const float* xrow, const bf16_t* drow, const float* gain, bf16_t* orow, float* frow, int lane) {
    f32x4 v[4]; float s = 0.f;
#pragma unroll
    for (int j = 0; j < 4; ++j) {
        v[j] = *((const f32x4*)xrow + lane + 64 * j);
        if (drow) { const u32x2 w = *((const u32x2*)drow + lane + 64 * j); v[j] += (f32x4){bflo(w.x), bfhi(w.x), bflo(w.y), bfhi(w.y)}; }
        s += (v[j].x * v[j].x + v[j].y * v[j].y) + (v[j].z * v[j].z + v[j].w * v[j].w);
    }
    const float inv = rsqrtf(wave_sum(s) * (1.f / D) + NORM_EPS);
#pragma unroll
    for (int j = 0; j < 4; ++j) {
        const f32x4 gn = *((const f32x4*)gain + lane + 64 * j); const f32x4 o = v[j] * inv * gn;
        if (orow) { u32x2 w; w.x = pk2(o.x, o.y); w.y = pk2(o.z, o.w); *((u32x2*)orow + lane + 64 * j) = w; }
        else *((f32x4*)frow + lane + 64 * j) = o;
    }
}

__device__ __forceinline__ void attn_phase(unsigned char* lds, const bf16_t* Q, const bf16_t* K, const bf16_t* V, bf16_t* Og, float* lse, int G, int bid) {
    bf16_t* Ks = (bf16_t*)lds;
    bf16_t* Vt = (bf16_t*)(lds + 36864);
    int tid_ = threadIdx.x; asm volatile("" : "+v"(tid_));
    const int tid = tid_, w = tid >> 6, lane = tid & 63, fr = lane & 15, fq = lane >> 4;
    for (int u_ = bid; u_ < ATT_REP * BATCH * 12 * 64; u_ += G) {
        const int u = u_ % (BATCH * 12 * 64); const int rb = u & 63, bh = u >> 6, h = bh % 12, b = bh / 12, g = h >> 2, hg = h & 3;
        const int dsh = 2 * g, d = 1 << dsh, nb = 64 >> dsh, r = rb / nb, i = rb % nb;
        const size_t brow = (size_t)b * SEQ;
        __syncthreads();
#pragma unroll
        for (int c = 0; c < 4; ++c) {
            const int p = tid + 512 * c, key = p >> 3, seg = p & 7; const int l = 128 * (i - 1) + key;
            u32x4 val = (u32x4){0u, 0u, 0u, 0u};
            if (l >= 0) val = *(const u32x4*)(K + (brow + (size_t)l * d + r) * AW + h * 64 + seg * 8);
            *(u32x4*)(Ks + key * 72 + seg * 8) = val;
        }
#pragma unroll
        for (int c = 0; c < 4; ++c) {
            const int p = tid + 512 * c, seg = p >> 8, key = p & 255; const int l = 128 * (i - 1) + key;
            u32x4 val = (u32x4){0u, 0u, 0u, 0u};
            if (l >= 0) val = *(const u32x4*)(V + (brow + (size_t)l * d + r) * AW + h * 64 + seg * 8);
            bf16_t* vp = Vt + (seg * 8) * 264 + key;
            vp[0 * 264] = (bf16_t)(val.x & 0xffffu); vp[1 * 264] = (bf16_t)(val.x >> 16); vp[2 * 264] = (bf16_t)(val.y & 0xffffu); vp[3 * 264] = (bf16_t)(val.y >> 16);
            vp[4 * 264] = (bf16_t)(val.z & 0xffffu); vp[5 * 264] = (bf16_t)(val.z >> 16); vp[6 * 264] = (bf16_t)(val.w & 0xffffu); vp[7 * 264] = (bf16_t)(val.w >> 16);
        }
        const size_t rowq = brow + (size_t)(128 * i + 16 * w + fr) * d + r;
        bf16x8 qf[2];
#pragma unroll
        for (int ks = 0; ks < 2; ++ks) qf[ks] = *(const bf16x8*)(Q + rowq * AW + h * 64 + ks * 32 + fq * 8);
        __syncthreads();
        f32x4 s[10];
#pragma unroll
        for (int tt = 0; tt < 10; ++tt) {
            const int T = w + tt, Tc = T < 16 ? T : 15;
            const bf16x8 k0 = *(const bf16x8*)(Ks + (16 * Tc + fr) * 72 + fq * 8), k1 = *(const bf16x8*)(Ks + (16 * Tc + fr) * 72 + 32 + fq * 8);
            f32x4 a = (f32x4){0.f, 0.f, 0.f, 0.f};
            a = __builtin_amdgcn_mfma_f32_16x16x32_bf16(k0, qf[0], a, 0, 0, 0);
            a = __builtin_amdgcn_mfma_f32_16x16x32_bf16(k1, qf[1], a, 0, 0, 0);
            s[tt] = a;
        }
        const int qi = 16 * w + fr; float mx = -INFINITY;
#pragma unroll
        for (int tt = 0; tt < 10; ++tt)
#pragma unroll
            for (int e = 0; e < 4; ++e) {
                const int ki = 16 * (w + tt) + 4 * fq + e;
                const bool valid = (ki >= qi) && (ki <= qi + 128) && (ki < 256) && (i > 0 || ki >= 128);
                s[tt][e] = valid ? s[tt][e] : -INFINITY; mx = fmaxf(mx, s[tt][e]);
            }
        mx = fmaxf(mx, __shfl_xor(mx, 16)); mx = fmaxf(mx, __shfl_xor(mx, 32));
        float l = 0.f;
#pragma unroll
        for (int tt = 0; tt < 10; ++tt)
#pragma unroll
            for (int e = 0; e < 4; ++e) { const float p = __expf(s[tt][e] - mx); s[tt][e] = p; l += p; }
        l += __shfl_xor(l, 16); l += __shfl_xor(l, 32);
        f32x4 o[4];
#pragma unroll
        for (int dt = 0; dt < 4; ++dt) o[dt] = (f32x4){0.f, 0.f, 0.f, 0.f};
#pragma unroll
        for (int s2 = 0; s2 < 5; ++s2) {
            const int T0 = w + 2 * s2, T1 = T0 + 1, T0c = T0 < 16 ? T0 : 15, T1c = T1 < 16 ? T1 : 15;
            union { bf16x8 v; unsigned u[4]; } pf;
            pf.u[0] = pk2(s[2 * s2][0], s[2 * s2][1]); pf.u[1] = pk2(s[2 * s2][2], s[2 * s2][3]);
            pf.u[2] = pk2(s[2 * s2 + 1][0], s[2 * s2 + 1][1]); pf.u[3] = pk2(s[2 * s2 + 1][2], s[2 * s2 + 1][3]);
#pragma unroll
            for (int dt = 0; dt < 4; ++dt) {
                union { bf16x8 v; u32x2 h[2]; } vf;
                vf.h[0] = *(const u32x2*)(Vt + (16 * dt + fr) * 264 + 16 * T0c + 4 * fq);
                vf.h[1] = *(const u32x2*)(Vt + (16 * dt + fr) * 264 + 16 * T1c + 4 * fq);
                o[dt] = __builtin_amdgcn_mfma_f32_16x16x32_bf16(vf.v, pf.v, o[dt], 0, 0, 0);
            }
        }
        const float il = 1.f / l;
        bf16_t* op = Og + ((size_t)g * M + rowq) * 256 + hg * 64 + 4 * fq;
#pragma unroll
        for (int dt = 0; dt < 4; ++dt) { u32x2 wv; wv.x = pk2(o[dt][0] * il, o[dt][1] * il); wv.y = pk2(o[dt][2] * il, o[dt][3] * il); *(u32x2*)(op + 16 * dt) = wv; }
        if (fq == 0) lse[((size_t)g * M + rowq) * 4 + hg] = mx + __logf(l);
    }
    __syncthreads();
}

template <int CTRL> __device__ __forceinline__ float dpp_f(float x) { return __builtin_bit_cast(float, __builtin_amdgcn_update_dpp(0, __builtin_bit_cast(int, x), CTRL, 0xf, 0xf, true)); }
__device__ __forceinline__ float row16_sum(float x) { x += dpp_f<0x128>(x); x += dpp_f<0x124>(x); x += dpp_f<0x122>(x); x += dpp_f<0x121>(x); return x; }
constexpr int TC = 32;
constexpr int SC_BUF = TC * 5 * 64 * 4;
constexpr int SC_V = TC * 32 * 4;
typedef float f32x2 __attribute__((ext_vector_type(2)));
struct ScanOps { f32x4 a, wr, w, b, k; f32x2 bk; float va, vb; };
__device__ __forceinline__ void scan_phase(unsigned char* lds, const bf16_t* Rr, const bf16_t* Wm, const bf16_t* Kp, const bf16_t* Vv, const bf16_t* Kk, const bf16_t* Bb, const float* BRKR, bf16_t* Y, int G, int bid) {
    int tid_ = threadIdx.x; asm volatile("" : "+v"(tid_));
    const int tid = tid_, w = __builtin_amdgcn_readfirstlane(tid >> 6), lane = tid & 63, kq = lane & 15, rw = lane >> 4;
    float* const kb0 = (float*)lds; float* const vb0 = (float*)(lds + 2 * SC_BUF); float* const yb0 = (float*)(lds + 2 * SC_BUF + 2 * SC_V);
    float* const bb0 = (float*)(lds + 2 * SC_BUF + 4 * SC_V);
#define KB(bi) (kb0 + (bi) * (SC_BUF / 4))
#define VB(bi) (vb0 + (bi) * (SC_V / 4))
#define YB(bi) (yb0 + (bi) * (SC_V / 4))
#define BB(bi) (bb0 + (bi) * (TC * 2))
    constexpr int NCH = SEQ / TC;
    for (int u = bid; u < BATCH * 16 * 2; u += G) {
        const int half = u & 1, h = (u >> 1) & 15, b = u >> 5;
        const size_t row0 = (size_t)b * SEQ;
        __syncthreads();
        if (w >= 4) {
            const int ht = tid - 256, st = ht >> 3, sg = ht & 7;
            const size_t goff = (row0 + st) * D + h * 64 + sg * 8;
            const int lo = st * 320 + sg * 8;
            const bool hv = ht < 128, hb = ht >= 128 && ht < 160;
            const bf16_t* pv = Vv + (row0 + (ht >> 2)) * D + h * 64 + half * 32 + (ht & 3) * 8; const int lov = (ht >> 2) * 32 + (ht & 3) * 8;
            const float* pb = BRKR + ((row0 + (ht & 31)) * 16 + h) * 2; const int lob = (ht & 31) * 2;
            bf16_t* yo = Y + (row0 + (ht >> 2)) * D + h * 64 + half * 32 + (ht & 3) * 8;
            struct HReg { u32x4 g0, g1, g2, g3, g4, g5; u32x2 g6; };
            HReg P, Q; P.g5 = (u32x4){0u, 0u, 0u, 0u}; P.g6 = (u32x2){0u, 0u}; Q.g5 = P.g5; Q.g6 = P.g6;
#define SC_ISSUE(X, c) do { const size_t o_ = (size_t)(c) * TC * D; X.g0 = *(const u32x4*)(Rr + goff + o_); X.g1 = *(const u32x4*)(Wm + goff + o_); X.g2 = *(const u32x4*)(Bb + goff + o_); \
                X.g3 = *(const u32x4*)(Kp + goff + o_); X.g4 = *(const u32x4*)(Kk + goff + o_); if (hv) X.g5 = *(const u32x4*)(pv + o_); if (hb) X.g6 = *(const u32x2*)(pb + (size_t)(c) * TC * 32); } while (0)
#define SC_ST8(dst, f) do { *(f32x4*)(dst) = (f32x4){f[0], f[1], f[2], f[3]}; *(f32x4*)((dst) + 4) = (f32x4){f[4], f[5], f[6], f[7]}; } while (0)
#define SC_COMMIT(X, bi) do { float fa_[8], fb_[8]; float* kb_ = KB(bi) + lo; \
                unpack8(X.g0, fa_); unpack8(X.g1, fb_); _Pragma("unroll") for (int i_ = 0; i_ < 8; ++i_) { fb_[i_] = 1.f - fb_[i_]; fa_[i_] *= fb_[i_]; } SC_ST8(kb_ + 64, fa_); SC_ST8(kb_ + 128, fb_); \
                unpack8(X.g2, fa_); SC_ST8(kb_ + 192, fa_); unpack8(X.g3, fa_); SC_ST8(kb_ + 256, fa_); \
                unpack8(X.g4, fa_); _Pragma("unroll") for (int i_ = 0; i_ < 8; ++i_) fa_[i_] = -fa_[i_]; SC_ST8(kb_, fa_); \
                if (hv) { unpack8(X.g5, fa_); float* d_ = VB(bi) + lov; SC_ST8(d_, fa_); } \
                if (hb) { *(f32x2*)(BB(bi) + lob) = (f32x2){__uint_as_float(X.g6.x), __uint_as_float(X.g6.y)}; } } while (0)
#define SC_YOUT(c) do { if (hv) { const float* yp_ = YB((c) & 1) + lov; const f32x4 y0_ = *(const f32x4*)yp_, y1_ = *(const f32x4*)(yp_ + 4); \
                u32x4 o_; o_.x = pk2(y0_.x, y0_.y); o_.y = pk2(y0_.z, y0_.w); o_.z = pk2(y1_.x, y1_.y); o_.w = pk2(y1_.z, y1_.w); *(u32x4*)(yo + (size_t)(c) * TC * D) = o_; } } while (0)
            SC_ISSUE(P, 0); SC_ISSUE(Q, 1); SC_COMMIT(P, 0);
            __syncthreads();
            for (int c = 0; c < NCH; c += 2) {
                if (c + 2 < NCH) SC_ISSUE(P, c + 2);
                if (c > 0) SC_YOUT(c - 1);
                SC_COMMIT(Q, 1);
                __syncthreads();
                if (c + 3 < NCH) SC_ISSUE(Q, c + 3);
                SC_YOUT(c);
                if (c + 2 < NCH) SC_COMMIT(P, 0);
                __syncthreads();
            }
            SC_YOUT(NCH - 1);
        } else {
            const int rowA = w * 8 + rw;
            __syncthreads();
            f32x2 A0 = (f32x2){0.f, 0.f}, A1 = A0, B0 = A0, B1 = A0;
            for (int c = 0; c < NCH; ++c) {
                const int bi = c & 1;
                const float* kbp = KB(bi) + kq * 4; const float* vbp = VB(bi) + rowA; const float* bbp = BB(bi); float* ybp = YB(bi) + rowA;
#define SC_LOAD(dst, t) do { const float* q_ = kbp + (t) * 320; dst.a = *(const f32x4*)q_; dst.wr = *(const f32x4*)(q_ + 64); dst.w = *(const f32x4*)(q_ + 128); dst.b = *(const f32x4*)(q_ + 192); dst.k = *(const f32x4*)(q_ + 256); \
                dst.va = vbp[(t) * 32]; dst.vb = vbp[(t) * 32 + 4]; dst.bk = *(const f32x2*)(bbp + (t) * 2); } while (0)
                ScanOps cur, nxt; SC_LOAD(cur, 0);
                float yrA = 0.f, yrB = 0.f;
#pragma unroll
                for (int t = 0; t < TC; ++t) {
                    if (t + 1 < TC) SC_LOAD(nxt, t + 1);
                    const f32x2 a0 = (f32x2){cur.a.x, cur.a.y}, a1 = (f32x2){cur.a.z, cur.a.w}, q0 = (f32x2){cur.wr.x, cur.wr.y}, q1 = (f32x2){cur.wr.z, cur.wr.w};
                    f32x2 paA = A0 * a0, paB = B0 * a0, pyA = A0 * q0, pyB = B0 * q0;
                    paA = __builtin_elementwise_fma(A1, a1, paA); paB = __builtin_elementwise_fma(B1, a1, paB);
                    pyA = __builtin_elementwise_fma(A1, q1, pyA); pyB = __builtin_elementwise_fma(B1, q1, pyB);
                    float saA = paA.x + paA.y, saB = paB.x + paB.y, ysA = pyA.x + pyA.y, ysB = pyB.x + pyB.y;
                    saA += dpp_f<0x128>(saA); saB += dpp_f<0x128>(saB); ysA += dpp_f<0x128>(ysA); ysB += dpp_f<0x128>(ysB);
                    saA += dpp_f<0x124>(saA); saB += dpp_f<0x124>(saB); ysA += dpp_f<0x124>(ysA); ysB += dpp_f<0x124>(ysB);
                    saA += dpp_f<0x122>(saA); saB += dpp_f<0x122>(saB); ysA += dpp_f<0x122>(ysA); ysB += dpp_f<0x122>(ysB);
                    saA += dpp_f<0x121>(saA); saB += dpp_f<0x121>(saB); ysA += dpp_f<0x121>(ysA); ysB += dpp_f<0x121>(ysB);
                    const f32x2 k0 = (f32x2){cur.k.x, cur.k.y}, k1 = (f32x2){cur.k.z, cur.k.w}, b0 = (f32x2){cur.b.x, cur.b.y}, b1 = (f32x2){cur.b.z, cur.b.w};
                    const f32x2 w0 = (f32x2){cur.w.x, cur.w.y}, w1 = (f32x2){cur.w.z, cur.w.w};
                    const f32x2 sA2 = (f32x2){saA, saA}, sB2 = (f32x2){saB, saB}, vA2 = (f32x2){cur.va, cur.va}, vB2 = (f32x2){cur.vb, cur.vb};
                    f32x2 tA0 = k0 * vA2, tA1 = k1 * vA2, tB0 = k0 * vB2, tB1 = k1 * vB2;
                    tA0 = __builtin_elementwise_fma(b0, sA2, tA0); tA1 = __builtin_elementwise_fma(b1, sA2, tA1);
                    tB0 = __builtin_elementwise_fma(b0, sB2, tB0); tB1 = __builtin_elementwise_fma(b1, sB2, tB1);
                    A0 = __builtin_elementwise_fma(A0, w0, tA0); A1 = __builtin_elementwise_fma(A1, w1, tA1);
                    B0 = __builtin_elementwise_fma(B0, w0, tB0); B1 = __builtin_elementwise_fma(B1, w1, tB1);
                    const float yA = ysA + saA * cur.bk.x + cur.va * cur.bk.y, yB = ysB + saB * cur.bk.x + cur.vb * cur.bk.y;
                    yrA = (kq == (t & 15)) ? yA : yrA; yrB = (kq == (t & 15)) ? yB : yrB;
                    if ((t & 15) == 15) { ybp[(t - 15 + kq) * 32] = yrA; ybp[(t - 15 + kq) * 32 + 4] = yrB; }
                    cur = nxt;
                }
                __syncthreads();
            }
        }
    }
    __syncthreads();
}

#define RLX_AGENT __ATOMIC_RELAXED, __HIP_MEMORY_SCOPE_AGENT
#define XB_TMO      128
#define XB_XCNT(j)  (256  + 64 * (j))
#define XB_XSUB(j)  (1280 + 64 * (j))
#define XB_XGEN(j)  (2304 + 64 * (j))
#define XB_TOP      3328
#define XB_TOPGEN   3392
#define XCD_BAR_WORDS 3456
#define XB_SPIN_CAP (1u << 18)

__device__ __forceinline__ unsigned xb_ld(unsigned* p)              { return __hip_atomic_load(p, __ATOMIC_RELAXED, __HIP_MEMORY_SCOPE_AGENT); }
__device__ __forceinline__ unsigned xb_add(unsigned* p, unsigned v) { return __hip_atomic_fetch_add(p, v, __ATOMIC_RELAXED, __HIP_MEMORY_SCOPE_AGENT); }
__device__ __forceinline__ unsigned xb_xcc_id() { return (unsigned)__builtin_amdgcn_s_getreg((3 << 11) | 20) & 0xFu; }
#define XB_SPIN(cond, bar) do { unsigned _sp = 0; while (cond) { __builtin_amdgcn_s_sleep(1); \
    if ((++_sp & 255u) == 0u) { if (xb_ld(&(bar)[XB_TMO])) break; if (_sp > XB_SPIN_CAP) { atomicAdd(&(bar)[XB_TMO], 1u); break; } } } } while (0)

struct XcdBarrier {
    unsigned* bar; unsigned x;
    volatile LAS unsigned* st;
};

__device__ __forceinline__ XcdBarrier xcd_barrier_post(unsigned* bar, volatile LAS unsigned* st) {
    XcdBarrier b; b.bar = bar; b.x = xb_xcc_id(); b.st = st;
    if (threadIdx.x == 0) (void)xb_add(&bar[XB_XCNT(b.x)], 1u);
    return b;
}
__device__ __forceinline__ void xcd_barrier_complete(unsigned* bar, unsigned x, unsigned& nloc, unsigned& nx) {
    const unsigned G = gridDim.x * gridDim.y * gridDim.z;
    unsigned sum, cnt, mine, sp = 0u;
    for (;;) {
        sum = 0u; cnt = 0u; mine = 0u;
#pragma unroll
        for (unsigned j = 0; j < 16; ++j) { const unsigned c = xb_ld(&bar[XB_XCNT(j)]); sum += c; cnt += (c > 0u) ? 1u : 0u; mine = (j == x) ? c : mine; }
        if (sum == G) break;
        __builtin_amdgcn_s_sleep(1);
        if ((++sp & 255u) == 0u) { if (xb_ld(&bar[XB_TMO])) break; if (sp > XB_SPIN_CAP) { atomicAdd(&bar[XB_TMO], 1u); break; } }
    }
    nloc = mine > 0u ? mine : 1u; nx = cnt > 0u ? cnt : 1u;
}

__device__ __forceinline__ void xcd_barrier(const XcdBarrier& b) {
    asm volatile("s_waitcnt vmcnt(0)" ::: "memory");
    __syncthreads();
    if (threadIdx.x == 0) {
        unsigned* bar = b.bar;
        __builtin_amdgcn_s_waitcnt(0);
        unsigned nloc = b.st[0], nx = b.st[1];
        if (nloc == 0u) { xcd_barrier_complete(bar, b.x, nloc, nx); b.st[0] = nloc; b.st[1] = nx; }
        const unsigned old = xb_add(&bar[XB_XSUB(b.x)], 1u);
        const unsigned gen = old / nloc;
        if (old + 1u == (gen + 1u) * nloc) {
            __builtin_amdgcn_fence(__ATOMIC_RELEASE, "agent");
            asm volatile("s_waitcnt vmcnt(0)" ::: "memory");
            const unsigned og = xb_add(&bar[XB_TOP], 1u);
            const unsigned tg = og / nx;
            if (og + 1u == (tg + 1u) * nx) xb_add(&bar[XB_TOPGEN], 1u);
            else XB_SPIN(xb_ld(&bar[XB_TOPGEN]) == tg, bar);
            __builtin_amdgcn_fence(__ATOMIC_ACQUIRE, "agent");
            xb_add(&bar[XB_XGEN(b.x)], 1u);
            asm volatile("s_waitcnt vmcnt(0)" ::: "memory");
        } else {
            XB_SPIN(xb_ld(&bar[XB_XGEN(b.x)]) == gen, bar);
            __builtin_amdgcn_fence(__ATOMIC_ACQUIRE, "agent");
            asm volatile("s_waitcnt vmcnt(0)" ::: "memory");
        }
    }
    __syncthreads();
}


__global__ void __launch_bounds__(NT, 2) mk_fwd(Args args) {
    extern __shared__ __attribute__((aligned(16))) unsigned char lds[];
    const int G = gridDim.x, bid = blockIdx.x, NGW = G * NWAVES;
    PG8_LAS unsigned char* glds = (PG8_LAS unsigned char*)lds;
    typedef const __attribute__((address_space(4))) Args* ArgP;
#define PH_ARGS() ArgP ap = (ArgP)__builtin_amdgcn_kernarg_segment_ptr(); asm volatile("" : "+s"(ap)); unsigned char* const ws = ap->ws; (void)ws; \
    int tid = threadIdx.x; asm volatile("" : "+v"(tid)); const int lane = tid & 63, wave = __builtin_amdgcn_readfirstlane(tid >> 6), gw = bid * NWAVES + wave; (void)lane; (void)gw
#define INP(i) (ap->in[i])
#define WB(off) ((bf16_t*)(ws + (off)))
#define CB(i) ((bf16_t*)(ws + WS_C(i)))
#define D1P ((bf16_t*)ap->out)
#define YSP ((bf16_t*)((unsigned char*)ap->out + CH))
#define X2P ((float*)(ws + WS_C(2)))
#define ATTOP (CB(0) + (size_t)3 * M * 256)
#if MK_MULTI
    const int lo = args.ph_lo, hi = args.ph_hi; int ph = 0;
#define SEAM() do { ++ph; } while (0)
#define SEAM0() SEAM()
#define IN() (lo <= ph && ph < hi)
#else
    cg::grid_group grid = cg::this_grid();
    unsigned* const barw = (unsigned*)args.ws;
    volatile LAS unsigned* const bst = (volatile LAS unsigned*)((LAS unsigned char*)lds + LDS_BYTES - 64);
    if (threadIdx.x < 2) bst[threadIdx.x] = 0u;
    if (bid == 0) for (int i = threadIdx.x; i < XCD_BAR_WORDS; i += NT) barw[i] = 0u;
    __syncthreads();
    XcdBarrier xbar; xbar.bar = barw; xbar.x = 0; xbar.st = bst;
#define SEAM0() do { __threadfence(); grid.sync(); xbar = xcd_barrier_post(barw, bst); } while (0)
#define SEAM() do { xcd_barrier(xbar); } while (0)
#define IN() true
#endif
#define PHASE(p) for (int rep_ = 0; IN() && rep_ < 1 + (int)((PROBE_MASK >> (p)) & 1u); ++rep_)

    PHASE(0) {
        PH_ARGS();
        float* scr = (float*)(lds + wave * 16384);
        tr_job(INP(I_F1G), INP(I_F1U), FF, D, WB(WS_WGU1), D, 2 * FF, 1, 0, 0, scr, gw, NGW, lane);
        tr_job(INP(I_F1D), nullptr, D, FF, WB(WS_WD1), FF, D, 0, 0, D, scr, gw, NGW, lane);
        tr_job(INP(I_F2G), INP(I_F2U), FF, D, WB(WS_WGU2), D, 2 * FF, 1, 0, 0, scr, gw, NGW, lane);
        tr_job(INP(I_F2D), nullptr, D, FF, WB(WS_WD2), FF, D, 0, 0, D, scr, gw, NGW, lane);
        tr_job(INP(I_WIN), nullptr, INC, D, WB(WS_WIN), D, 5888, 0, 0, 5664, scr, gw, NGW, lane);
        tr_job(INP(I_WIN), nullptr, INC, D, WB(WS_WIN) + (size_t)5888 * D, D, 2048, 0, 5664, INC, scr, gw, NGW, lane);
        tr_job(INP(I_AUP), nullptr, D, 256, WB(WS_WUP), 256, D, 0, 0, D, scr, gw, NGW, lane);
        tr_job(INP(I_WOUT), nullptr, D, D, WB(WS_WOUT), D, D, 0, 0, D, scr, gw, NGW, lane);
        tr_job(INP(I_WO), nullptr, D, D, WB(WS_WO), D, D, 0, 0, D, scr, gw, NGW, lane);
        tr_job(INP(I_W2), nullptr, D, 64, WB(WS_LW), 128, D, 0, 0, D, scr, gw, NGW, lane);
        tr_job(INP(I_A2), nullptr, D, 64, WB(WS_LA2), 128, D, 0, 0, D, scr, gw, NGW, lane);
        tr_job(INP(I_G2), nullptr, D, 160, WB(WS_LG), 256, D, 0, 0, D, scr, gw, NGW, lane);
        for (int i = bid * NT + tid; i < SEQ * 8; i += G * NT) {
            const int pos = i >> 3, j = i & 7;
            const float invf = powf(500000.0f, -(float)j * 0.125f);
            const float ang = (float)pos * invf;
            double rev = (double)ang * 0.15915494309189535; rev -= rint(rev);
            const float rf = (float)rev;
            ((float*)(ws + WS_ROPE))[pos * 16 + j] = __builtin_amdgcn_cosf(rf); ((float*)(ws + WS_ROPE))[pos * 16 + 8 + j] = __builtin_amdgcn_sinf(rf);
        }
        for (int m = gw; m < M; m += NGW) norm_row(INP(I_X) + (size_t)m * D, nullptr, INP(I_F1N), CB(0) + (size_t)m * D, nullptr, lane);
    }
    SEAM0();
    PHASE(1) {
        PH_ARGS();
        pg8::Gemm g{CB(0), WB(WS_WGU1), M, 2 * FF, D, D, D}; pg8::StaticOrder S; S.init(M, 2 * FF, G, bid);
        pg8::EpiOp<OpGateUp> E{{CB(1)}};
        pg8::gemm_phase(glds, g, S, E);
    }
    SEAM();
    PHASE(2) {
        PH_ARGS();
        pg8::Gemm g{CB(1), WB(WS_WD1), M, D, FF, FF, FF}; pg8::StaticOrder S; S.init(M, D, G, bid);
        pg8::EpiOp<OpStoreBf16> E{{D1P, D, 0.5f}};
        pg8::gemm_phase(glds, g, S, E);
    }
    SEAM();
    PHASE(3) {
        PH_ARGS();
        for (int m = gw; m < M; m += NGW) norm_row(INP(I_X) + (size_t)m * D, D1P + (size_t)m * D, INP(I_MN), CB(0) + (size_t)m * D, nullptr, lane);
    }
    SEAM();
    PHASE(4) {
        PH_ARGS();
        { pg8::Gemm g{CB(0), WB(WS_WIN), M, 2304, D, D, D}; pg8::StaticOrder S; S.init(M, 2304, G, bid);
          pg8::EpiOp<OpAttnQKV> E{{CB(1), CB(2), CB(3), ((float*)(ws + WS_ROPE))}};
          pg8::gemm_phase(glds, g, S, E); }
        { pg8::Gemm g{CB(0), WB(WS_WIN) + (size_t)2304 * D, M, 3584, D, D, D}; pg8::StaticOrder S; S.init(M, 3584, G, bid);
          pg8::EpiOp<OpRwkvZ> E{{CB(4), CB(5), CB(6), WB(WS_LA), WB(WS_HALO), WB(WS_HALOLA)}};
          pg8::gemm_phase(glds, g, S, E); }
    }
    SEAM();
    PHASE(5) { PH_ARGS(); attn_phase(lds, CB(1), CB(2), CB(3), CB(0), (float*)(ws + WS_LSE), G, bid); }
    SEAM();
    PHASE(6) {
        PH_ARGS();
        const float* mu = INP(I_MU) + 3072;
        for (int grp = gw; grp < M / 64; grp += NGW) {
            if (lane < 48) {
                const int c0 = lane * 8; bf16_t* base = WB(WS_LA) + (size_t)grp * 64 * LAW + c0;
                if (lane >= 36) { for (int rr = 0; rr < 64; ++rr) *(u32x4*)(base + (size_t)rr * LAW) = (u32x4){0u, 0u, 0u, 0u}; }
                else {
                    float mv[8];
#pragma unroll
                    for (int i = 0; i < 8; ++i) mv[i] = mu[c0 + i];
                    float prev[8];
                    if ((grp & 127) == 0) {
#pragma unroll
                        for (int i = 0; i < 8; ++i) prev[i] = 0.f; }
                    else unpack8(*(const u32x4*)(WB(WS_HALOLA) + (size_t)(grp - 1) * LAW + c0), prev);
                    for (int r8 = 0; r8 < 64; r8 += 8) {
                        u32x4 raw[8];
#pragma unroll
                        for (int j = 0; j < 8; ++j) raw[j] = *(const u32x4*)(base + (size_t)(r8 + j) * LAW);
#pragma unroll
                        for (int j = 0; j < 8; ++j) {
                            float cur[8], o[8]; unpack8(raw[j], cur);
#pragma unroll
                            for (int i = 0; i < 8; ++i) { const float z = cur[i] + (prev[i] - cur[i]) * mv[i];
                                o[i] = c0 < 64 ? (1.f - 2.f * __builtin_amdgcn_rcpf(1.f + __expf(2.f * z))) : (c0 < 128 ? z : sigm(z)); prev[i] = cur[i]; }
                            *(u32x4*)(base + (size_t)(r8 + j) * LAW) = pack8(o);
                        }
                    }
                }
            }
        }
        for (int it = gw; it < M / 2; it += NGW) {
            const int row = it * 2 + (lane >> 5), pc = lane & 31, hg = pc >> 3;
            const float l0 = ((float*)(ws + WS_LSE))[((size_t)0 * M + row) * 4 + hg], l1 = ((float*)(ws + WS_LSE))[((size_t)1 * M + row) * 4 + hg], l2 = ((float*)(ws + WS_LSE))[((size_t)2 * M + row) * 4 + hg];
            const float mx = fmaxf(l0, fmaxf(l1, l2)); float w0 = __expf(l0 - mx), w1 = __expf(l1 - mx), w2 = __expf(l2 - mx);
            const float iw = 1.f / (w0 + w1 + w2); w0 *= iw; w1 *= iw; w2 *= iw;
            float a[8], bb[8], c[8], o[8];
            unpack8(*(const u32x4*)(CB(0) + ((size_t)0 * M + row) * 256 + pc * 8), a); unpack8(*(const u32x4*)(CB(0) + ((size_t)1 * M + row) * 256 + pc * 8), bb);
            unpack8(*(const u32x4*)(CB(0) + ((size_t)2 * M + row) * 256 + pc * 8), c);
#pragma unroll
            for (int i = 0; i < 8; ++i) o[i] = w0 * a[i] + w1 * bb[i] + w2 * c[i];
            *(u32x4*)(ATTOP + (size_t)row * 256 + pc * 8) = pack8(o);
        }
    }
    SEAM();
    PHASE(7) {
        PH_ARGS();
        { pg8::Gemm g{WB(WS_LA), WB(WS_LW), M, D, 128, LAW, 128}; pg8::StaticOrder S; S.init(M, D, G, bid);
          pg8::EpiOp<OpLora<0>> E{{CB(1), INP(I_W0)}};
          pg8::gemm_phase(glds, g, S, E); }
        { pg8::Gemm g{WB(WS_LA) + 64, WB(WS_LA2), M, D, 128, LAW, 128}; pg8::StaticOrder S; S.init(M, D, G, bid);
          pg8::EpiOp<OpLora<1>> E{{CB(3), INP(I_A0)}};
          pg8::gemm_phase(glds, g, S, E); }
    }
    SEAM();
    PHASE(8) {
        PH_ARGS();
        const float* mu = INP(I_MU);
        const int r8 = lane >> 3, seg = lane & 7;
        for (int it = gw; it < (M / 64) * 16; it += NGW) {
            const int grp = it >> 4, h = it & 15, c0 = h * 64 + seg * 8;
            float mur[8], muk[8], muv[8], kkp[8], kap[8], rkp[8];
#pragma unroll
            for (int i = 0; i < 8; ++i) { mur[i] = mu[c0 + i]; muk[i] = mu[1024 + c0 + i]; muv[i] = mu[2048 + c0 + i];
                kkp[i] = INP(I_KK)[c0 + i]; kap[i] = INP(I_KA)[c0 + i]; rkp[i] = INP(I_RK)[c0 + i]; }
            u32x4 cr = (u32x4){0u, 0u, 0u, 0u}, ck = cr, cv = cr;
            if ((grp & 127) != 0) { const bf16_t* hp = WB(WS_HALO) + (size_t)(grp - 1) * 3072 + c0; cr = *(const u32x4*)hp; ck = *(const u32x4*)(hp + 1024); cv = *(const u32x4*)(hp + 2048); }
            for (int ps = 0; ps < 8; ++ps) {
                const size_t row = (size_t)grp * 64 + ps * 8 + r8, off = row * D + c0;
                const u32x4 Rw = *(const u32x4*)(CB(4) + off), Kw = *(const u32x4*)(CB(5) + off), Vw = *(const u32x4*)(CB(6) + off), Aw = *(const u32x4*)(CB(3) + off);
                u32x4 Rp, Kq, Vp;
                Rp.x = __shfl_up(Rw.x, 8); Rp.y = __shfl_up(Rw.y, 8); Rp.z = __shfl_up(Rw.z, 8); Rp.w = __shfl_up(Rw.w, 8);
                Kq.x = __shfl_up(Kw.x, 8); Kq.y = __shfl_up(Kw.y, 8); Kq.z = __shfl_up(Kw.z, 8); Kq.w = __shfl_up(Kw.w, 8);
                Vp.x = __shfl_up(Vw.x, 8); Vp.y = __shfl_up(Vw.y, 8); Vp.z = __shfl_up(Vw.z, 8); Vp.w = __shfl_up(Vw.w, 8);
                if (r8 == 0) { Rp = cr; Kq = ck; Vp = cv; }
                cr.x = __shfl(Rw.x, 56 + seg); cr.y = __shfl(Rw.y, 56 + seg); cr.z = __shfl(Rw.z, 56 + seg); cr.w = __shfl(Rw.w, 56 + seg);
                ck.x = __shfl(Kw.x, 56 + seg); ck.y = __shfl(Kw.y, 56 + seg); ck.z = __shfl(Kw.z, 56 + seg); ck.w = __shfl(Kw.w, 56 + seg);
                cv.x = __shfl(Vw.x, 56 + seg); cv.y = __shfl(Vw.y, 56 + seg); cv.z = __shfl(Vw.z, 56 + seg); cv.w = __shfl(Vw.w, 56 + seg);
                float rc[8], rp[8], kc[8], kp[8], vc[8], vp[8], av[8];
                unpack8(Rw, rc); unpack8(Rp, rp); unpack8(Kw, kc); unpack8(Kq, kp); unpack8(Vw, vc); unpack8(Vp, vp); unpack8(Aw, av);
                float ro[8], ko[8], vo[8], kko[8], bo[8]; float ss = 0.f, bs = 0.f;
#pragma unroll
                for (int i = 0; i < 8; ++i) {
                    ro[i] = rc[i] + (rp[i] - rc[i]) * mur[i]; const float kz = kc[i] + (kp[i] - kc[i]) * muk[i]; vo[i] = vc[i] + (vp[i] - vc[i]) * muv[i];
                    kko[i] = kz * kkp[i]; ss += kko[i] * kko[i];
                    ko[i] = kz * (1.f + (av[i] - 1.f) * kap[i]); bs += ro[i] * ko[i] * rkp[i];
                }
                ss += __shfl_xor(ss, 1); ss += __shfl_xor(ss, 2); ss += __shfl_xor(ss, 4);
                bs += __shfl_xor(bs, 1); bs += __shfl_xor(bs, 2); bs += __shfl_xor(bs, 4);
                const float inv = 1.f / fmaxf(sqrtf(ss), 1e-12f);
#pragma unroll
                for (int i = 0; i < 8; ++i) { kko[i] *= inv; bo[i] = kko[i] * av[i]; }
                const u32x4 rq = pack8(ro), kq8 = pack8(ko), bq = pack8(bo);
                *(u32x4*)(CB(4) + off) = rq; *(u32x4*)(CB(5) + off) = kq8; *(u32x4*)(CB(6) + off) = pack8(vo);
                *(u32x4*)(CB(2) + off) = pack8(kko); *(u32x4*)(CB(3) + off) = bq;
                float rr_[8], kr_[8], br_[8]; unpack8(rq, rr_); unpack8(kq8, kr_); unpack8(bq, br_);
                float sbr = 0.f, skr = 0.f;
#pragma unroll
                for (int i = 0; i < 8; ++i) { sbr += br_[i] * rr_[i]; skr += kr_[i] * rr_[i]; }
                sbr += __shfl_xor(sbr, 1); sbr += __shfl_xor(sbr, 2); sbr += __shfl_xor(sbr, 4);
                skr += __shfl_xor(skr, 1); skr += __shfl_xor(skr, 2); skr += __shfl_xor(skr, 4);
                if (seg == 0) { ((float*)(ws + WS_BC))[row * 16 + h] = bs; *(f32x2*)((float*)(ws + WS_BRKR) + (row * 16 + h) * 2) = (f32x2){sbr, skr}; }
            }
        }
    }
    SEAM();
    PHASE(9) { PH_ARGS(); scan_phase(lds, CB(4), CB(1), CB(5), CB(6), CB(2), CB(3), (const float*)(ws + WS_BRKR), YSP, G, bid); }
    SEAM();
    PHASE(10) {
        PH_ARGS();
        { pg8::Gemm g{WB(WS_LA) + 128, WB(WS_LG), M, D, 256, LAW, 256}; pg8::StaticOrder S; S.init(M, D, G, bid);
          pg8::EpiOp<OpStoreBf16> E{{CB(1), D, 1.0f}};
          pg8::gemm_phase(glds, g, S, E); }
        for (int m = gw; m < M; m += NGW) norm_row(INP(I_X) + (size_t)m * D, D1P + (size_t)m * D, INP(I_MN), CB(2) + (size_t)m * D, nullptr, lane);
    }
    SEAM();
    PHASE(11) {
        PH_ARGS();
        const int r8 = lane >> 3, seg = lane & 7;
        for (int it = gw; it < (M / 8) * 16; it += NGW) {
            const int h = it & 15; const size_t row = (size_t)(it >> 4) * 8 + r8; const int c0 = h * 64 + seg * 8; const size_t off = row * D + c0;
            float yv[8], vv[8], gv[8], o[8];
            unpack8(*(const u32x4*)(YSP + off), yv); unpack8(*(const u32x4*)(CB(6) + off), vv); unpack8(*(const u32x4*)(CB(1) + off), gv);
            const float bc = ((float*)(ws + WS_BC))[row * 16 + h];
            float s = 0.f;
#pragma unroll
            for (int i = 0; i < 8; ++i) s += yv[i];
            s += __shfl_xor(s, 1); s += __shfl_xor(s, 2); s += __shfl_xor(s, 4);
            const float mean = s * (1.f / 64.f); float q = 0.f;
#pragma unroll
            for (int i = 0; i < 8; ++i) { yv[i] -= mean; q += yv[i] * yv[i]; }
            q += __shfl_xor(q, 1); q += __shfl_xor(q, 2); q += __shfl_xor(q, 4);
            const float rstd = rsqrtf(q * (1.f / 64.f) + GN_EPS);
#pragma unroll
            for (int i = 0; i < 8; ++i) o[i] = (yv[i] * rstd * INP(I_LNW)[c0 + i] + INP(I_LNB)[c0 + i] + bc * vv[i]) * gv[i];
            *(u32x4*)(CB(3) + off) = pack8(o);
        }
    }
    SEAM();
    PHASE(12) {
        PH_ARGS();
        { pg8::Gemm g{CB(2), WB(WS_WIN) + (size_t)5888 * D, M, 2048, D, D, D}; pg8::StaticOrder S; S.init(M, 2048, G, bid);
          pg8::EpiOp<OpGates> E{{CB(4), CB(5), INP(I_GB)}};
          pg8::gemm_phase(glds, g, S, E); }
        { pg8::Gemm g{ATTOP, WB(WS_WUP), M, D, 256, 256, 256}; pg8::StaticOrder S; S.init(M, D, G, bid);
          pg8::EpiOp<OpStoreBf16> E{{CB(6), D, 1.0f}};
          pg8::gemm_phase(glds, g, S, E); }
    }
    SEAM();
    PHASE(13) {
        PH_ARGS();
        pg8::Gemm g{CB(3), WB(WS_WOUT), M, D, D, D, D}; pg8::StaticOrder S; S.init(M, D, G, bid);
        pg8::EpiOp<OpMerge> E{{CB(4), CB(6), CB(5), CB(1)}};
        pg8::gemm_phase(glds, g, S, E);
    }
    SEAM();
    PHASE(14) {
        PH_ARGS();
        pg8::Gemm g{CB(1), WB(WS_WO), M, D, D, D, D}; pg8::StaticOrder S; S.init(M, D, G, bid);
        pg8::EpiOp<OpRes> E{{INP(I_X), D1P, X2P, 1.0f}};
        pg8::gemm_phase(glds, g, S, E);
    }
    SEAM();
    PHASE(15) {
        PH_ARGS();
        for (int m = gw; m < M; m += NGW) norm_row(X2P + (size_t)m * D, nullptr, INP(I_F2N), CB(0) + (size_t)m * D, nullptr, lane);
    }
    SEAM();
    PHASE(16) {
        PH_ARGS();
        pg8::Gemm g{CB(0), WB(WS_WGU2), M, 2 * FF, D, D, D}; pg8::StaticOrder S; S.init(M, 2 * FF, G, bid);
        pg8::EpiOp<OpGateUp> E{{CB(4)}};
        pg8::gemm_phase(glds, g, S, E);
    }
    SEAM();
    PHASE(17) {
        PH_ARGS();
        pg8::Gemm g{CB(4), WB(WS_WD2), M, D, FF, FF, FF}; pg8::StaticOrder S; S.init(M, D, G, bid);
        pg8::EpiOp<OpRes> E{{X2P, nullptr, ap->out, 0.5f}};
        pg8::gemm_phase(glds, g, S, E);
    }
    SEAM();
    PHASE(18) {
        PH_ARGS();
        for (int m = gw; m < M; m += NGW) norm_row(ap->out + (size_t)m * D, nullptr, INP(I_FN), nullptr, ap->out + (size_t)m * D, lane);
    }
}
constexpr int N_PHASES = 19;

extern "C" void kernel_launch(void* const* d_in, const int* in_sizes, int n_in, void* d_out, int out_size, void* d_ws, size_t ws_size, hipStream_t stream) {
    static int grid = 0;
    if (grid == 0) {
        if (n_in != 27 || in_sizes[0] != M * D || out_size != M * D || ws_size < WS_END) { fprintf(stderr, "kernel_launch: unexpected shapes (n_in %d, in0 %d, out %d, ws %zu)\n", n_in, n_in > 0 ? in_sizes[0] : -1, out_size, ws_size); grid = -1; return; }
        int dev = 0, cus = 0, per_cu = 0;
        hipGetDevice(&dev); hipDeviceGetAttribute(&cus, hipDeviceAttributeMultiprocessorCount, dev);
        if (hipFuncSetAttribute((const void*)mk_fwd, hipFuncAttributeMaxDynamicSharedMemorySize, LDS_BYTES) != hipSuccess) { fprintf(stderr, "kernel_launch: hipFuncSetAttribute failed\n"); grid = -1; return; }
        if (hipOccupancyMaxActiveBlocksPerMultiprocessor(&per_cu, (const void*)mk_fwd, NT, LDS_BYTES) != hipSuccess || per_cu < 1) { fprintf(stderr, "kernel_launch: occupancy query says %d\n", per_cu); per_cu = 1; }
        (void)hipGetLastError();
        grid = cus;
    }
    if (grid < 0) return;
    Args a{};
    for (int i = 0; i < 27; ++i) a.in[i] = (const float*)d_in[i];
    a.out = (float*)d_out; a.ws = (unsigned char*)d_ws;
#if MK_MULTI
    for (int p = 0; p < N_PHASES; ++p) { a.ph_lo = p; a.ph_hi = p + 1; hipLaunchKernelGGL(mk_fwd, dim3(grid), dim3(NT), LDS_BYTES, stream, a); }
#else
    a.ph_lo = 0; a.ph_hi = N_PHASES;
    void* kargs[] = {&a};
    hipError_t e = hipLaunchCooperativeKernel((const void*)mk_fwd, dim3(grid), dim3(NT), kargs, LDS_BYTES, stream);
    if (e != hipSuccess) fprintf(stderr, "kernel_launch: cooperative launch failed: %s (grid %d)\n", hipGetErrorString(e), grid);
#endif
}
```

```cpp
#include <hip/hip_runtime.h>
#include <hip/hip_cooperative_groups.h>
#include <cstdio>
#include <cstdint>
namespace cg = cooperative_groups;

#ifndef MK_MULTI
#define MK_MULTI 0
#endif
#ifndef ATT_REP
#define ATT_REP 1
#endif
#ifndef PROBE_MASK
#define PROBE_MASK 0u
#endif

namespace pg8 {
#define PG8_LAS __attribute__((address_space(3)))
typedef unsigned short bf16_t;
typedef short bf16x8 __attribute__((ext_vector_type(8)));
typedef float f32x4 __attribute__((ext_vector_type(4)));
typedef unsigned u32x4 __attribute__((ext_vector_type(4)));
constexpr int BM = 256, BK = 64, HALF = 128, HTB = HALF * BK * 2, STAGE_BYTES = 8 * HTB, NXCD = 8, WGM = 8;

__host__ __device__ __forceinline__ int lds_byte(int r, int c) { const int st = (r >> 4) * 2 + (c >> 5), rr = r & 15, cc = c & 31, ob = rr * 64 + cc * 2; return st * 1024 + (ob ^ (((ob >> 9) & 1) << 5)); }
__host__ __device__ __forceinline__ void stage_rc(int b, int& R, int& C) { const int st = b / 1024, sb = b % 1024, swz = sb ^ (((sb >> 9) & 1) << 5); R = (st >> 1) * 16 + swz / 64; C = (st & 1) * 32 + (swz % 64) / 2; }
__host__ __device__ __forceinline__ int perm32(int rho) { const int n = rho >> 4, i = rho & 15; return 8 * (i >> 2) + 4 * n + (i & 3); }

struct Unit { int pm, pn; };
struct Gemm { const bf16_t* A; const bf16_t* Bt; int M, N, K, lda, ldb; };

struct StaticOrder {
    int nM, nN, nwg, G, c;
    __host__ __device__ void init(int M, int N, int G_, int c_) { nM = M / BM; nN = N / BM; nwg = nM * nN; G = G_; c = c_; }
    __host__ __device__ bool next(int i, Unit& u) const {
        const long L = (long)i * G + c; if (L >= nwg) return false;
        int wgid = (int)L; { const int q = nwg / NXCD, r = nwg % NXCD, xcd = wgid % NXCD, off = wgid / NXCD; wgid = (xcd < r ? xcd * (q + 1) : r * (q + 1) + (xcd - r) * q) + off; }
        const int nig = WGM * nN, gid = wgid / nig, fm = gid * WGM, gsz = (nM - fm) < WGM ? (nM - fm) : WGM;
        u.pm = fm + ((wgid % nig) % gsz); u.pn = (wgid % nig) / gsz; return true;
    }
};

__device__ __forceinline__ unsigned cvt_pk_bf16(float lo, float hi) { unsigned r; asm volatile("v_cvt_pk_bf16_f32 %0, %1, %2" : "=v"(r) : "v"(lo), "v"(hi)); return r; }

template <class Op> struct EpiOp {
    Op op;
    __device__ __forceinline__ void operator()(const f32x4 (&acc)[2][2][4][2], const Unit& u, int wr, int wc, int fr, int fq) const {
#pragma unroll
        for (int ai = 0; ai < 2; ++ai)
#pragma unroll
            for (int m = 0; m < 4; ++m) {
                const int row = u.pm * BM + ai * HALF + wr * 64 + m * 16 + fr;
                op(acc[ai][0][m][0], acc[ai][0][m][1], acc[ai][1][m][0], acc[ai][1][m][1], row, u.pn, wc, fq);
            }
    }
};

template <class Epi, class Sched>
__device__ __forceinline__ void gemm_phase(PG8_LAS unsigned char* lds, const Gemm g, const Sched& S, const Epi& E) {
    int tid_ = threadIdx.x; asm volatile("" : "+v"(tid_));
    const int tid = tid_, wid = __builtin_amdgcn_readfirstlane(tid >> 6), lane = tid & 63, wr = wid >> 2, wc = wid & 3, fr = lane & 15, fq = lane >> 4;
    const int K = g.K, nt = K / BK;
    unsigned voffA[2], voffB[2];
#pragma unroll
    for (int i = 0; i < 2; ++i) { int R, C; stage_rc(tid * 16 + i * 8192, R, C); const int Rb = (R & ~31) + perm32(R & 31);
        voffA[i] = (unsigned)(R * g.lda + C) * 2u; voffB[i] = (unsigned)(Rb * g.ldb + C) * 2u; }
    const size_t kstep = (size_t)(BK * 2);
    const size_t hstepA = (size_t)HALF * g.lda * 2, hstepB = (size_t)HALF * g.ldb * 2;
    const size_t tstepA = 2 * hstepA, tstepB = 2 * hstepB;
    const unsigned ldsw = (unsigned)wid * 1024u;
    const int aoff = lds_byte(wr * 64 + fr, fq * 8), boff = lds_byte(wc * 32 + fr, fq * 8);
#define PG8_SA(b, h) (((b) * 2 + (h)) * HTB)
#define PG8_SB(b, h) ((4 + (b) * 2 + (h)) * HTB)
#define PG8_STAGE(bufoff, gbase, voff) do { _Pragma("unroll") for (int _i = 0; _i < 2; ++_i) \
        __builtin_amdgcn_global_load_lds((const unsigned*)((const char*)(gbase) + (voff)[_i]), (PG8_LAS unsigned*)(lds + (bufoff) + ldsw + _i * 8192), 16, 0, 0); } while (0)
#define PG8_LDA(dst, b, h) do { _Pragma("unroll") for (int m = 0; m < 4; ++m) _Pragma("unroll") for (int k = 0; k < 2; ++k) dst[m][k] = *(const PG8_LAS bf16x8*)(lds + PG8_SA(b, h) + aoff + m * 2048 + k * 1024); } while (0)
#define PG8_LDB(dst, b, h) do { _Pragma("unroll") for (int n = 0; n < 2; ++n) _Pragma("unroll") for (int k = 0; k < 2; ++k) dst[n][k] = *(const PG8_LAS bf16x8*)(lds + PG8_SB(b, h) + boff + n * 2048 + k * 1024); } while (0)
#define PG8_MMA(ai, bj, At, Bt) do { __builtin_amdgcn_s_setprio(1); _Pragma("unroll") for (int m = 0; m < 4; ++m) _Pragma("unroll") for (int n = 0; n < 2; ++n) _Pragma("unroll") for (int k = 0; k < 2; ++k) \
        acc[ai][bj][m][n] = __builtin_amdgcn_mfma_f32_16x16x32_bf16(Bt[n][k], At[m][k], acc[ai][bj][m][n], 0, 0, 0); __builtin_amdgcn_s_setprio(0); } while (0)
#define PG8_WAIT_V(n) asm volatile("s_waitcnt vmcnt(" #n ")" ::: "memory")
#define PG8_WAIT_L(n) asm volatile("s_waitcnt lgkmcnt(" #n ")" ::: "memory")
#define PG8_BAR __builtin_amdgcn_s_barrier()
#define PG8_SCHED __builtin_amdgcn_sched_barrier(0)
    Unit cur, nxt; int ui = 0;
    if (!S.next(0, cur)) return;
    f32x4 acc[2][2][4][2];
#pragma unroll
    for (int a = 0; a < 2; ++a)
#pragma unroll
        for (int b = 0; b < 2; ++b)
#pragma unroll
            for (int m = 0; m < 4; ++m)
#pragma unroll
                for (int n = 0; n < 2; ++n) acc[a][b][m][n] = (f32x4){0.f, 0.f, 0.f, 0.f};
    bf16x8 At[4][2], B0[2][2], B1[2][2];
    const char* cA = (const char*)g.A + (size_t)cur.pm * tstepA; const char* cB = (const char*)g.Bt + (size_t)cur.pn * tstepB;
    PG8_STAGE(PG8_SB(0, 0), cB, voffB); PG8_STAGE(PG8_SB(0, 1), cB + hstepB, voffB); PG8_STAGE(PG8_SA(0, 0), cA, voffA); PG8_STAGE(PG8_SA(0, 1), cA + hstepA, voffA);
    if (wr == 1) PG8_BAR;
    PG8_WAIT_V(2); PG8_BAR;
    PG8_STAGE(PG8_SB(1, 0), cB + kstep, voffB); PG8_STAGE(PG8_SA(1, 0), cA + kstep, voffA); PG8_STAGE(PG8_SB(1, 1), cB + hstepB + kstep, voffB);
    PG8_WAIT_V(6); PG8_BAR;
    for (;;) {
        const bool has_next = S.next(ui + 1, nxt);
        const char* nA = has_next ? (const char*)g.A + (size_t)nxt.pm * tstepA : cA; const char* nB = has_next ? (const char*)g.Bt + (size_t)nxt.pn * tstepB : cB;
        for (int t = 0; t < nt; t += 2) {
            const bool last = (t == nt - 2);
            const char* a1 = cA + (size_t)(t + 1) * kstep;
            const char* a2 = last ? nA : cA + (size_t)(t + 2) * kstep; const char* b2 = last ? nB : cB + (size_t)(t + 2) * kstep;
            const char* a3 = a2 + kstep; const char* b3 = b2 + kstep;
            PG8_LDB(B0, 0, 0); PG8_LDB(B1, 0, 1); PG8_SCHED; PG8_LDA(At, 0, 0); PG8_STAGE(PG8_SA(1, 1), a1 + hstepA, voffA);
            PG8_WAIT_V(8); PG8_WAIT_L(0); PG8_BAR; PG8_MMA(0, 0, At, B0); PG8_MMA(0, 1, At, B1); PG8_BAR; PG8_SCHED;
            PG8_LDA(At, 0, 1); PG8_STAGE(PG8_SB(0, 0), b2, voffB); PG8_STAGE(PG8_SB(0, 1), b2 + hstepB, voffB); PG8_STAGE(PG8_SA(0, 0), a2, voffA);
            PG8_WAIT_V(8); PG8_WAIT_L(0); PG8_BAR; PG8_MMA(1, 0, At, B0); PG8_MMA(1, 1, At, B1); PG8_BAR; PG8_SCHED;
            PG8_LDB(B0, 1, 0); PG8_LDB(B1, 1, 1); PG8_SCHED; PG8_LDA(At, 1, 0); PG8_STAGE(PG8_SA(0, 1), a2 + hstepA, voffA);
            PG8_WAIT_V(8); PG8_WAIT_L(0); PG8_BAR; PG8_MMA(0, 0, At, B0); PG8_MMA(0, 1, At, B1); PG8_BAR; PG8_SCHED;
            PG8_LDA(At, 1, 1); PG8_STAGE(PG8_SB(1, 0), b3, voffB); PG8_STAGE(PG8_SB(1, 1), b3 + hstepB, voffB); PG8_STAGE(PG8_SA(1, 0), a3, voffA);
            PG8_WAIT_V(8); PG8_WAIT_L(0); PG8_BAR; PG8_MMA(1, 0, At, B0); PG8_MMA(1, 1, At, B1); PG8_BAR; PG8_SCHED;
        }
        if (wr == 0) PG8_BAR;
        E(acc, cur, wr, wc, fr, fq);
        if (!has_next) break;
#pragma unroll
        for (int a = 0; a < 2; ++a)
#pragma unroll
            for (int b = 0; b < 2; ++b)
#pragma unroll
                for (int m = 0; m < 4; ++m)
#pragma unroll
                    for (int n = 0; n < 2; ++n) acc[a][b][m][n] = (f32x4){0.f, 0.f, 0.f, 0.f};
        cur = nxt; cA = nA; cB = nB; ++ui;
        if (wr == 1) PG8_BAR;
    }
    PG8_WAIT_V(0);
    PG8_BAR;
#undef PG8_SA
#undef PG8_SB
#undef PG8_STAGE
#undef PG8_LDA
#undef PG8_LDB
#undef PG8_MMA
#undef PG8_WAIT_V
#undef PG8_WAIT_L
#undef PG8_BAR
#undef PG8_SCHED
}
}

using pg8::bf16_t; using pg8::f32x4; using pg8::u32x4; using pg8::bf16x8;
typedef unsigned u32x2 __attribute__((ext_vector_type(2)));
#define LAS __attribute__((address_space(3)))

constexpr int BATCH = 8, SEQ = 8192, D = 1024, FF = 2816, M = BATCH * SEQ;
constexpr int AW = 768, RS = 3360, INC = 7712;
constexpr int LAW = 384;
constexpr int NWAVES = 8, NT = 512;
constexpr float NORM_EPS = 1e-6f, GN_EPS = 64e-5f;

constexpr size_t MiB = 1u << 20;
constexpr size_t WS_WGU1 = 1 * MiB;
constexpr size_t WS_WD1 = WS_WGU1 + 11 * MiB;
constexpr size_t WS_WGU2 = WS_WD1 + 5 * MiB + MiB / 2;
constexpr size_t WS_WD2 = WS_WGU2 + 11 * MiB;
constexpr size_t WS_WIN = WS_WD2 + 5 * MiB + MiB / 2;
constexpr size_t WS_WUP = WS_WIN + 15 * MiB + MiB / 2;
constexpr size_t WS_WOUT = WS_WUP + MiB / 2;
constexpr size_t WS_WO = WS_WOUT + 2 * MiB;
constexpr size_t WS_LW = WS_WO + 2 * MiB;
constexpr size_t WS_LA2 = WS_LW + MiB / 4;
constexpr size_t WS_LG = WS_LA2 + MiB / 4;
constexpr size_t WS_ROPE = WS_LG + MiB / 2;
static_assert(WS_ROPE + MiB / 2 <= 56 * MiB, "weights region");
constexpr size_t WS_LA = 56 * MiB;
constexpr size_t WS_HALO = 104 * MiB;
constexpr size_t WS_HALOLA = 104 * MiB;
constexpr size_t WS_BC = 111 * MiB;
constexpr size_t WS_LSE = 115 * MiB;
constexpr size_t WS_BRKR = 118 * MiB;
constexpr size_t CH = 128 * MiB;
constexpr size_t WS_C0 = 128 * MiB;
#define WS_C(i) (WS_C0 + (size_t)(i) * CH)
constexpr size_t WS_END = 1024 * MiB;
constexpr int LDS_BYTES = 147456;

__device__ __forceinline__ float bf2f(unsigned short h) { return __uint_as_float(((unsigned)h) << 16); }
__device__ __forceinline__ float bflo(unsigned w) { return __uint_as_float(w << 16); }
__device__ __forceinline__ float bfhi(unsigned w) { return __uint_as_float(w & 0xffff0000u); }
__device__ __forceinline__ unsigned pk2(float lo, float hi) { return pg8::cvt_pk_bf16(lo, hi); }
__device__ __forceinline__ void unpack8(const u32x4 w, float (&f)[8]) { f[0] = bflo(w.x); f[1] = bfhi(w.x); f[2] = bflo(w.y); f[3] = bfhi(w.y); f[4] = bflo(w.z); f[5] = bfhi(w.z); f[6] = bflo(w.w); f[7] = bfhi(w.w); }
__device__ __forceinline__ u32x4 pack8(const float (&f)[8]) { u32x4 w; w.x = pk2(f[0], f[1]); w.y = pk2(f[2], f[3]); w.z = pk2(f[4], f[5]); w.w = pk2(f[6], f[7]); return w; }
__device__ __forceinline__ float sigm(float x) { return __builtin_amdgcn_rcpf(1.f + __expf(-x)); }
__device__ __forceinline__ float wave_sum(float v) {
#pragma unroll
    for (int o = 1; o < 64; o <<= 1) v += __shfl_xor(v, o);
    return v;
}

struct OpGateUp {
    bf16_t* H;
    __device__ __forceinline__ void operator()(const f32x4 g0, const f32x4 g1, const f32x4 u0, const f32x4 u1, int row, int pn, int wc, int fq) const {
        const int col = pn * 128 + wc * 32 + 8 * fq; float o[8];
#pragma unroll
        for (int i = 0; i < 4; ++i) { o[i] = g0[i] * sigm(g0[i]) * u0[i]; o[4 + i] = g1[i] * sigm(g1[i]) * u1[i]; }
        *(u32x4*)(H + (size_t)row * FF + col) = pack8(o);
    }
};
struct OpStoreBf16 {
    bf16_t* O; int ld; float scale;
    __device__ __forceinline__ void operator()(const f32x4 a0, const f32x4 a1, const f32x4 b0, const f32x4 b1, int row, int pn, int wc, int fq) const {
        const int col = pn * 256 + wc * 32 + 8 * fq; float o[8];
#pragma unroll
        for (int i = 0; i < 4; ++i) { o[i] = a0[i] * scale; o[4 + i] = a1[i] * scale; }
        *(u32x4*)(O + (size_t)row * ld + col) = pack8(o);
#pragma unroll
        for (int i = 0; i < 4; ++i) { o[i] = b0[i] * scale; o[4 + i] = b1[i] * scale; }
        *(u32x4*)(O + (size_t)row * ld + col + 128) = pack8(o);
    }
};
struct OpRes {
    const float* base; const bf16_t* dlt; float* out; float scale;
    __device__ __forceinline__ void half(const f32x4 a0, const f32x4 a1, size_t off) const {
        f32x4 r0 = a0 * scale, r1 = a1 * scale;
        if (base) { r0 += *(const f32x4*)(base + off); r1 += *(const f32x4*)(base + off + 4); }
        if (dlt) { float d[8]; unpack8(*(const u32x4*)(dlt + off), d); r0 += (f32x4){d[0], d[1], d[2], d[3]}; r1 += (f32x4){d[4], d[5], d[6], d[7]}; }
        *(f32x4*)(out + off) = r0; *(f32x4*)(out + off + 4) = r1;
    }
    __device__ __forceinline__ void operator()(const f32x4 a0, const f32x4 a1, const f32x4 b0, const f32x4 b1, int row, int pn, int wc, int fq) const {
        const size_t off = (size_t)row * D + pn * 256 + wc * 32 + 8 * fq;
        half(a0, a1, off); half(b0, b1, off + 128);
    }
};
struct OpAttnQKV {
    bf16_t* q; bf16_t* k; bf16_t* v; const float* rope;
    __device__ __forceinline__ void half(const f32x4 a0, const f32x4 a1, bf16_t* dst, int row, int wc, int fq, int which) const {
        float o[8];
#pragma unroll
        for (int i = 0; i < 4; ++i) { o[i] = a0[i]; o[4 + i] = a1[i]; }
        if (which < 2 && (wc & 1) == 0) {
            float p[8];
#pragma unroll
            for (int i = 0; i < 8; ++i) p[i] = __shfl_xor(o[i], 16);
            if (fq < 2) {
                const float* cs = rope + (size_t)(row & (SEQ - 1)) * 16;
                const f32x4 c0 = *(const f32x4*)(cs), c1 = *(const f32x4*)(cs + 4), s0 = *(const f32x4*)(cs + 8), s1 = *(const f32x4*)(cs + 12);
                const float sg = fq == 0 ? -1.f : 1.f;
#pragma unroll
                for (int i = 0; i < 4; ++i) { o[i] = o[i] * c0[i] + sg * p[i] * s0[i]; o[4 + i] = o[4 + i] * c1[i] + sg * p[4 + i] * s1[i]; }
            }
        }
        if (which == 0) {
#pragma unroll
            for (int i = 0; i < 8; ++i) o[i] *= 0.125f;
        }
        *(u32x4*)dst = pack8(o);
    }
    __device__ __forceinline__ void operator()(const f32x4 a0, const f32x4 a1, const f32x4 b0, const f32x4 b1, int row, int pn, int wc, int fq) const {
        const int which = pn / 3, col = (pn - which * 3) * 256 + wc * 32 + 8 * fq;
        bf16_t* base = q + (size_t)which * (CH / 2) + (size_t)row * AW + col;
        half(a0, a1, base, row, wc, fq, which); half(b0, b1, base + 128, row, wc, fq, which);
    }
};
struct OpRwkvZ {
    bf16_t* r; bf16_t* k; bf16_t* v; bf16_t* la; bf16_t* halo; bf16_t* halola;
    __device__ __forceinline__ void operator()(const f32x4 a0, const f32x4 a1, const f32x4 b0, const f32x4 b1, int row, int pn, int wc, int fq) const {
        float o0[8], o1[8];
#pragma unroll
        for (int i = 0; i < 4; ++i) { o0[i] = a0[i]; o0[4 + i] = a1[i]; o1[i] = b0[i]; o1[4 + i] = b1[i]; }
        const u32x4 w0 = pack8(o0), w1 = pack8(o1);
        const bool hrow = (row & 31) == 31;
        if (pn < 12) {
            const int s = pn >> 2, col = (pn & 3) * 256 + wc * 32 + 8 * fq;
            bf16_t* dst = r + (size_t)s * (CH / 2) + (size_t)row * D + col;
            *(u32x4*)dst = w0; *(u32x4*)(dst + 128) = w1;
        } else {
            const int col = (pn - 12) * 256 + wc * 32 + 8 * fq;
            if (col < 288) { *(u32x4*)(la + (size_t)row * LAW + col) = w0; if (hrow) *(u32x4*)(halola + (size_t)(row >> 5) * LAW + col) = w0; }
            if (col + 128 < 288) { *(u32x4*)(la + (size_t)row * LAW + col + 128) = w1; if (hrow) *(u32x4*)(halola + (size_t)(row >> 5) * LAW + col + 128) = w1; }
        }
    }
};
struct OpGates {
    bf16_t* ga; bf16_t* gr; const float* bias;
    __device__ __forceinline__ void operator()(const f32x4 a0, const f32x4 a1, const f32x4 b0, const f32x4 b1, int row, int pn, int wc, int fq) const {
        const int s = pn >> 2, col = (pn & 3) * 256 + wc * 32 + 8 * fq; const float* bp = bias + s * 1024 + col;
        bf16_t* dst = ga + (size_t)s * (CH / 2) + (size_t)row * D + col; float o[8];
        { const f32x4 c0 = *(const f32x4*)bp, c1 = *(const f32x4*)(bp + 4);
#pragma unroll
          for (int i = 0; i < 4; ++i) { o[i] = sigm(a0[i] + c0[i]); o[4 + i] = sigm(a1[i] + c1[i]); }
          *(u32x4*)dst = pack8(o); }
        { const f32x4 c0 = *(const f32x4*)(bp + 128), c1 = *(const f32x4*)(bp + 132);
#pragma unroll
          for (int i = 0; i < 4; ++i) { o[i] = sigm(b0[i] + c0[i]); o[4 + i] = sigm(b1[i] + c1[i]); }
          *(u32x4*)(dst + 128) = pack8(o); }
    }
};
template <int MODE> struct OpLora {
    bf16_t* O; const float* p0;
    __device__ __forceinline__ float f(float x) const { const float s = sigm(x); return MODE == 0 ? 1.f - __expf(-0.60653065971f * s) : s; }
    __device__ __forceinline__ void operator()(const f32x4 a0, const f32x4 a1, const f32x4 b0, const f32x4 b1, int row, int pn, int wc, int fq) const {
        const int col = pn * 256 + wc * 32 + 8 * fq; const float* bp = p0 + col; bf16_t* dst = O + (size_t)row * D + col; float o[8];
        { const f32x4 c0 = *(const f32x4*)bp, c1 = *(const f32x4*)(bp + 4);
#pragma unroll
          for (int i = 0; i < 4; ++i) { o[i] = f(a0[i] + c0[i]); o[4 + i] = f(a1[i] + c1[i]); }
          *(u32x4*)dst = pack8(o); }
        { const f32x4 c0 = *(const f32x4*)(bp + 128), c1 = *(const f32x4*)(bp + 132);
#pragma unroll
          for (int i = 0; i < 4; ++i) { o[i] = f(b0[i] + c0[i]); o[4 + i] = f(b1[i] + c1[i]); }
          *(u32x4*)(dst + 128) = pack8(o); }
    }
};
struct OpMerge {
    const bf16_t* ga; const bf16_t* ya; const bf16_t* gr; bf16_t* out;
    __device__ __forceinline__ void half(const f32x4 a0, const f32x4 a1, size_t off) const {
        float A[8], Y[8], R[8], o[8]; unpack8(*(const u32x4*)(ga + off), A); unpack8(*(const u32x4*)(ya + off), Y); unpack8(*(const u32x4*)(gr + off), R);
#pragma unroll
        for (int i = 0; i < 4; ++i) { o[i] = A[i] * Y[i] + R[i] * a0[i]; o[4 + i] = A[4 + i] * Y[4 + i] + R[4 + i] * a1[i]; }
        *(u32x4*)(out + off) = pack8(o);
    }
    __device__ __forceinline__ void operator()(const f32x4 a0, const f32x4 a1, const f32x4 b0, const f32x4 b1, int row, int pn, int wc, int fq) const {
        const size_t off = (size_t)row * D + pn * 256 + wc * 32 + 8 * fq;
        half(a0, a1, off); half(b0, b1, off + 128);
    }
};

struct Args {
    const float* in[27]; float* out; unsigned char* ws; int ph_lo, ph_hi;
};
enum { I_X = 0, I_F1N, I_F1G, I_F1U, I_F1D, I_MN, I_WIN, I_GB, I_AUP, I_MU, I_W0, I_W2, I_A0, I_A2, I_G2, I_KK, I_KA, I_RK, I_LNW, I_LNB, I_WOUT, I_WO, I_F2N, I_F2G, I_F2U, I_F2D, I_FN };

__device__ __forceinline__ void tr_job(const float* W0, const float* W1, int ldw, int Ksrc, bf16_t* WT, int ldt, int nrows, int mode, int coff, int climit,
                                       float* scr, int gw, int NGW, int lane) {
    const int nblk = nrows / 64, nitems = (ldt / 64) * nblk;
    for (int it = gw; it < nitems; it += NGW) {
        const int kb = it / nblk, nb = it % nblk, k0 = 64 * kb;
        const float* Wh[2]; int ch[2]; bool vh[2];
#pragma unroll
        for (int hh = 0; hh < 2; ++hh) {
            const int nb32 = 2 * nb + hh;
            if (mode == 0) { ch[hh] = coff + 32 * nb32; vh[hh] = ch[hh] < climit; Wh[hh] = W0; }
            else { const int tile = nb32 >> 3, j0 = (nb32 & 7) * 32; Wh[hh] = j0 < 128 ? W0 : W1; ch[hh] = tile * 128 + (j0 & 127); vh[hh] = true; }
        }
        const int r4 = lane >> 4, pc = lane & 15, hsel = pc >> 3;
        const float* Wsel = hsel ? Wh[1] : Wh[0]; const int csel = (hsel ? ch[1] : ch[0]) + (pc & 7) * 4; const bool vsel = hsel ? vh[1] : vh[0];
        f32x4 v[16];
#pragma unroll
        for (int i = 0; i < 16; ++i) { const int k = k0 + 4 * i + r4; v[i] = (vsel && k < Ksrc) ? *(const f32x4*)(Wsel + (size_t)k * ldw + csel) : (f32x4){0.f, 0.f, 0.f, 0.f}; }
#pragma unroll
        for (int i = 0; i < 16; ++i) { float* d = scr + (4 * i + r4) * 65 + pc * 4; d[0] = v[i].x; d[1] = v[i].y; d[2] = v[i].z; d[3] = v[i].w; }
        __builtin_amdgcn_s_waitcnt(0); asm volatile("" ::: "memory");
        const int c = lane & 7;
#pragma unroll
        for (int j = 0; j < 8; ++j) { const int n = (lane >> 3) + 8 * j; const float* sp = scr + (8 * c) * 65 + n;
            u32x4 o; o.x = pk2(sp[0 * 65], sp[1 * 65]); o.y = pk2(sp[2 * 65], sp[3 * 65]); o.z = pk2(sp[4 * 65], sp[5 * 65]); o.w = pk2(sp[6 * 65], sp[7 * 65]);
            *(u32x4*)(WT + (size_t)(64 * nb + n) * ldt + k0 + 8 * c) = o; }
        __builtin_amdgcn_s_waitcnt(0); asm volatile("" ::: "memory");
    }
}
__device__ __forceinline__ void norm_row(const float* xrow, const bf16_t* drow, const float* gain, bf16_t* orow, float* frow, int lane) {
    f32x4 v[4]; float s = 0.f;
#pragma unroll
    for (int j = 0; j < 4; ++j) {
        v[j] = *((const f32x4*)xrow + lane + 64 * j);
        if (drow) { const u32x2 w = *((const u32x2*)drow + lane + 64 * j); v[j] += (f32x4){bflo(w.x), bfhi(w.x), bflo(w.y), bfhi(w.y)}; }
        s += (v[j].x * v[j].x + v[j].y * v[j].y) + (v[j].z * v[j].z + v[j].w * v[j].w);
    }
    const float inv = rsqrtf(wave_sum(s) * (1.f / D) + NORM_EPS);
#pragma unroll
    for (int j = 0; j < 4; ++j) {
        const f32x4 gn = *((const f32x4*)gain + lane + 64 * j); const f32x4 o = v[j] * inv * gn;
        if (orow) { u32x2 w; w.x = pk2(o.x, o.y); w.y = pk2(o.z, o.w); *((u32x2*)orow + lane + 64 * j) = w; }
        else *((f32x4*)frow + lane + 64 * j) = o;
    }
}

struct AttnUnit { int b, h, g, hg, d, r, i; };
__device__ __forceinline__ AttnUnit attn_decode(int u) {
    AttnUnit a; const int rb = u & 63, bh = u >> 6; a.h = bh % 12; a.b = bh / 12; a.g = a.h >> 2; a.hg = a.h & 3;
    const int dsh = 2 * a.g, nb = 64 >> dsh; a.d = 1 << dsh; a.r = rb / nb; a.i = rb % nb; return a;
}
__device__ __forceinline__ void attn_phase(unsigned char* lds, const bf16_t* Q, const bf16_t* K, const bf16_t* V, bf16_t* Og, float* lse, int G, int bid) {
    bf16_t* Ks = (bf16_t*)lds;
    bf16_t* Vt = (bf16_t*)(lds + 36864);
    int tid_ = threadIdx.x; asm volatile("" : "+v"(tid_));
    const int tid = tid_, w = tid >> 6, lane = tid & 63, fr = lane & 15, fq = lane >> 4;
    constexpr int NU = ATT_REP * BATCH * 12 * 64;
    u32x4 kreg[4], vreg[4];
#define ATT_LOADKV(uu) do { const AttnUnit n_ = attn_decode((uu) % (BATCH * 12 * 64)); const size_t br_ = (size_t)n_.b * SEQ; \
        _Pragma("unroll") for (int c_ = 0; c_ < 4; ++c_) { const int p_ = tid + 512 * c_; \
            { const int key_ = p_ >> 3, seg_ = p_ & 7, l_ = 128 * (n_.i - 1) + key_; kreg[c_] = (u32x4){0u, 0u, 0u, 0u}; \
              if (l_ >= 0) kreg[c_] = *(const u32x4*)(K + (br_ + (size_t)l_ * n_.d + n_.r) * AW + n_.h * 64 + seg_ * 8); } \
            { const int seg_ = p_ >> 8, key_ = p_ & 255, l_ = 128 * (n_.i - 1) + key_; vreg[c_] = (u32x4){0u, 0u, 0u, 0u}; \
              if (l_ >= 0) vreg[c_] = *(const u32x4*)(V + (br_ + (size_t)l_ * n_.d + n_.r) * AW + n_.h * 64 + seg_ * 8); } } } while (0)
    if (bid < NU) ATT_LOADKV(bid);
    for (int u_ = bid; u_ < NU; u_ += G) {
        const AttnUnit U = attn_decode(u_ % (BATCH * 12 * 64));
        const int h = U.h, g = U.g, hg = U.hg, d = U.d, r = U.r, i = U.i;
        const size_t brow = (size_t)U.b * SEQ;
        __syncthreads();
#pragma unroll
        for (int c = 0; c < 4; ++c) {
            const int p = tid + 512 * c;
            *(u32x4*)(Ks + (p >> 3) * 72 + (p & 7) * 8) = kreg[c];
            const u32x4 val = vreg[c];
            bf16_t* vp = Vt + ((p >> 8) * 8) * 264 + (p & 255);
            vp[0 * 264] = (bf16_t)(val.x & 0xffffu); vp[1 * 264] = (bf16_t)(val.x >> 16); vp[2 * 264] = (bf16_t)(val.y & 0xffffu); vp[3 * 264] = (bf16_t)(val.y >> 16);
            vp[4 * 264] = (bf16_t)(val.z & 0xffffu); vp[5 * 264] = (bf16_t)(val.z >> 16); vp[6 * 264] = (bf16_t)(val.w & 0xffffu); vp[7 * 264] = (bf16_t)(val.w >> 16);
        }
        const size_t rowq = brow + (size_t)(128 * i + 16 * w + fr) * d + r;
        bf16x8 qf[2];
#pragma unroll
        for (int ks = 0; ks < 2; ++ks) qf[ks] = *(const bf16x8*)(Q + rowq * AW + h * 64 + ks * 32 + fq * 8);
        if (u_ + G < NU) ATT_LOADKV(u_ + G);
        __syncthreads();
        f32x4 s[10];
#pragma unroll
        for (int tt = 0; tt < 10; ++tt) {
            const int T = w + tt, Tc = T < 16 ? T : 15;
            const bf16x8 k0 = *(const bf16x8*)(Ks + (16 * Tc + fr) * 72 + fq * 8), k1 = *(const bf16x8*)(Ks + (16 * Tc + fr) * 72 + 32 + fq * 8);
            f32x4 a = (f32x4){0.f, 0.f, 0.f, 0.f};
            a = __builtin_amdgcn_mfma_f32_16x16x32_bf16(k0, qf[0], a, 0, 0, 0);
            a = __builtin_amdgcn_mfma_f32_16x16x32_bf16(k1, qf[1], a, 0, 0, 0);
            s[tt] = a;
        }
        const int qi = 16 * w + fr; float mx = -INFINITY;
#pragma unroll
        for (int tt = 0; tt < 10; ++tt)
#pragma unroll
            for (int e = 0; e < 4; ++e) {
                const int ki = 16 * (w + tt) + 4 * fq + e;
                const bool valid = (ki >= qi) && (ki <= qi + 128) && (ki < 256) && (i > 0 || ki >= 128);
                s[tt][e] = valid ? s[tt][e] : -INFINITY; mx = fmaxf(mx, s[tt][e]);
            }
        mx = fmaxf(mx, __shfl_xor(mx, 16)); mx = fmaxf(mx, __shfl_xor(mx, 32));
        float l = 0.f;
#pragma unroll
        for (int tt = 0; tt < 10; ++tt)
#pragma unroll
            for (int e = 0; e < 4; ++e) { const float p = __expf(s[tt][e] - mx); s[tt][e] = p; l += p; }
        l += __shfl_xor(l, 16); l += __shfl_xor(l, 32);
        f32x4 o[4];
#pragma unroll
        for (int dt = 0; dt < 4; ++dt) o[dt] = (f32x4){0.f, 0.f, 0.f, 0.f};
#pragma unroll
        for (int s2 = 0; s2 < 5; ++s2) {
            const int T0 = w + 2 * s2, T1 = T0 + 1, T0c = T0 < 16 ? T0 : 15, T1c = T1 < 16 ? T1 : 15;
            union { bf16x8 v; unsigned u[4]; } pf;
            pf.u[0] = pk2(s[2 * s2][0], s[2 * s2][1]); pf.u[1] = pk2(s[2 * s2][2], s[2 * s2][3]);
            pf.u[2] = pk2(s[2 * s2 + 1][0], s[2 * s2 + 1][1]); pf.u[3] = pk2(s[2 * s2 + 1][2], s[2 * s2 + 1][3]);
#pragma unroll
            for (int dt = 0; dt < 4; ++dt) {
                union { bf16x8 v; u32x2 h[2]; } vf;
                vf.h[0] = *(const u32x2*)(Vt + (16 * dt + fr) * 264 + 16 * T0c + 4 * fq);
                vf.h[1] = *(const u32x2*)(Vt + (16 * dt + fr) * 264 + 16 * T1c + 4 * fq);
                o[dt] = __builtin_amdgcn_mfma_f32_16x16x32_bf16(vf.v, pf.v, o[dt], 0, 0, 0);
            }
        }
        const float il = 1.f / l;
        bf16_t* op = Og + ((size_t)g * M + rowq) * 256 + hg * 64 + 4 * fq;
#pragma unroll
        for (int dt = 0; dt < 4; ++dt) { u32x2 wv; wv.x = pk2(o[dt][0] * il, o[dt][1] * il); wv.y = pk2(o[dt][2] * il, o[dt][3] * il); *(u32x2*)(op + 16 * dt) = wv; }
        if (fq == 0) lse[((size_t)g * M + rowq) * 4 + hg] = mx + __logf(l);
    }
    __syncthreads();
}

template <int CTRL> __device__ __forceinline__ float dpp_f(float x) { return __builtin_bit_cast(float, __builtin_amdgcn_update_dpp(0, __builtin_bit_cast(int, x), CTRL, 0xf, 0xf, true)); }
__device__ __forceinline__ float row16_sum(float x) { x += dpp_f<0x128>(x); x += dpp_f<0x124>(x); x += dpp_f<0x122>(x); x += dpp_f<0x121>(x); return x; }
constexpr int TC = 32;
constexpr int SC_BUF = TC * 5 * 64 * 4;
constexpr int SC_V = TC * 32 * 4;
typedef float f32x2 __attribute__((ext_vector_type(2)));
struct ScanOps { f32x4 a0, a1, q0, q1, w0, w1, b0, b1, k0, k1; f32x2 bk; float v; };
__device__ __forceinline__ void scan_phase(unsigned char* lds, const bf16_t* Rz, const bf16_t* Wm, const bf16_t* Kz, const bf16_t* Vz, const bf16_t* Aa, const float* mu, const float* pkk, const float* pka, const float* prk, float* BCo, bf16_t* Y, int G, int bid) {
    int tid_ = threadIdx.x; asm volatile("" : "+v"(tid_));
    const int tid = tid_, w = __builtin_amdgcn_readfirstlane(tid >> 6), lane = tid & 63, kq = lane & 15, rw = lane >> 4;
    float* const kb0 = (float*)lds; float* const vb0 = (float*)(lds + 2 * SC_BUF); float* const yb0 = (float*)(lds + 2 * SC_BUF + 2 * SC_V);
    float* const bb0 = (float*)(lds + 2 * SC_BUF + 4 * SC_V);
#define KB(bi) (kb0 + (bi) * (SC_BUF / 4))
#define VB(bi) (vb0 + (bi) * (SC_V / 4))
#define YB(bi) (yb0 + (bi) * (SC_V / 4))
#define BB(bi) (bb0 + (bi) * (TC * 2))
    constexpr int NCH = SEQ / TC;
    for (int u = bid; u < BATCH * 16 * 2; u += G) {
        const int half = u & 1, h = (u >> 1) & 15, b = u >> 5;
        const size_t row0 = (size_t)b * SEQ;
        __syncthreads();
        if (w >= 4) {
            const int ht = tid - 256, st = ht >> 3, sg = ht & 7;
            const size_t goff = (row0 + st) * D + h * 64 + sg * 8;
            const int lo = st * 320 + sg * 8;
            const bool hv = ht < 128;
            const size_t voff = (row0 + (ht >> 2)) * D + h * 64 + half * 32 + (ht & 3) * 8; const int lov = (ht >> 2) * 32 + (ht & 3) * 8;
            bf16_t* yo = Y + voff;
            float mur[8], muk[8], muv[8], kkp[8], kap[8], rkp[8];
#pragma unroll
            for (int i = 0; i < 8; ++i) { const int cc = h * 64 + sg * 8 + i; mur[i] = mu[cc]; muk[i] = mu[1024 + cc]; kkp[i] = pkk[cc]; kap[i] = pka[cc]; rkp[i] = prk[cc];
                muv[i] = mu[2048 + h * 64 + half * 32 + (ht & 3) * 8 + i]; }
            struct HReg { u32x4 rc, rp, kc, kp, om, aa, vc, vp; };
            HReg P, Q; P.vc = (u32x4){0u, 0u, 0u, 0u}; P.vp = P.vc; Q.vc = P.vc; Q.vp = P.vc;
            const u32x4 z4 = (u32x4){0u, 0u, 0u, 0u};
#define SC_ISSUE(X, c) do { const size_t o_ = (size_t)(c) * TC * D; const bool first_ = ((c) == 0 && st == 0); \
                X.rc = *(const u32x4*)(Rz + goff + o_); X.kc = *(const u32x4*)(Kz + goff + o_); X.om = *(const u32x4*)(Wm + goff + o_); X.aa = *(const u32x4*)(Aa + goff + o_); \
                X.rp = first_ ? z4 : *(const u32x4*)(Rz + goff + o_ - D); X.kp = first_ ? z4 : *(const u32x4*)(Kz + goff + o_ - D); \
                if (hv) { X.vc = *(const u32x4*)(Vz + voff + o_); X.vp = ((c) == 0 && ht < 4) ? z4 : *(const u32x4*)(Vz + voff + o_ - D); } } while (0)
#define SC_ST8(dst, f) do { *(f32x4*)(dst) = (f32x4){f[0], f[1], f[2], f[3]}; *(f32x4*)((dst) + 4) = (f32x4){f[4], f[5], f[6], f[7]}; } while (0)
#define SC_COMMIT(X, bi, c) do { float rc_[8], rp_[8], kc_[8], kp_[8], om_[8], av_[8]; float* kb_ = KB(bi) + lo; \
                unpack8(X.rc, rc_); unpack8(X.rp, rp_); unpack8(X.kc, kc_); unpack8(X.kp, kp_); unpack8(X.om, om_); unpack8(X.aa, av_); \
                float kk_[8], ko_[8], bo_[8], wr_[8]; float ss_ = 0.f, bs_ = 0.f, sbr_ = 0.f, skr_ = 0.f; \
                _Pragma("unroll") for (int i_ = 0; i_ < 8; ++i_) { const float r_ = rc_[i_] + (rp_[i_] - rc_[i_]) * mur[i_]; const float kz_ = kc_[i_] + (kp_[i_] - kc_[i_]) * muk[i_]; \
                    kk_[i_] = kz_ * kkp[i_]; ss_ += kk_[i_] * kk_[i_]; ko_[i_] = kz_ * (1.f + (av_[i_] - 1.f) * kap[i_]); bs_ += r_ * ko_[i_] * rkp[i_]; skr_ += ko_[i_] * r_; \
                    om_[i_] = 1.f - om_[i_]; wr_[i_] = om_[i_] * r_; rc_[i_] = r_; } \
                ss_ += __shfl_xor(ss_, 1); ss_ += __shfl_xor(ss_, 2); ss_ += __shfl_xor(ss_, 4); \
                const float inv_ = 1.f / fmaxf(sqrtf(ss_), 1e-12f); \
                _Pragma("unroll") for (int i_ = 0; i_ < 8; ++i_) { const float k2_ = kk_[i_] * inv_; bo_[i_] = k2_ * av_[i_]; sbr_ += bo_[i_] * rc_[i_]; kk_[i_] = -k2_; } \
                bs_ += __shfl_xor(bs_, 1); bs_ += __shfl_xor(bs_, 2); bs_ += __shfl_xor(bs_, 4); \
                sbr_ += __shfl_xor(sbr_, 1); sbr_ += __shfl_xor(sbr_, 2); sbr_ += __shfl_xor(sbr_, 4); \
                skr_ += __shfl_xor(skr_, 1); skr_ += __shfl_xor(skr_, 2); skr_ += __shfl_xor(skr_, 4); \
                SC_ST8(kb_, kk_); SC_ST8(kb_ + 64, wr_); SC_ST8(kb_ + 128, om_); SC_ST8(kb_ + 192, bo_); SC_ST8(kb_ + 256, ko_); \
                if (sg == 0) { *(f32x2*)(BB(bi) + st * 2) = (f32x2){sbr_, skr_}; if (half == 0) BCo[(row0 + (size_t)(c) * TC + st) * 16 + h] = bs_; } \
                if (hv) { float vc_[8], vp_[8]; unpack8(X.vc, vc_); unpack8(X.vp, vp_); _Pragma("unroll") for (int i_ = 0; i_ < 8; ++i_) vc_[i_] += (vp_[i_] - vc_[i_]) * muv[i_]; float* d_ = VB(bi) + lov; SC_ST8(d_, vc_); } } while (0)
#define SC_YOUT(c) do { if (hv) { const float* yp_ = YB((c) & 1) + lov; const f32x4 y0_ = *(const f32x4*)yp_, y1_ = *(const f32x4*)(yp_ + 4); \
                u32x4 o_; o_.x = pk2(y0_.x, y0_.y); o_.y = pk2(y0_.z, y0_.w); o_.z = pk2(y1_.x, y1_.y); o_.w = pk2(y1_.z, y1_.w); *(u32x4*)(yo + (size_t)(c) * TC * D) = o_; } } while (0)
            SC_ISSUE(P, 0); SC_ISSUE(Q, 1); SC_COMMIT(P, 0, 0);
            __syncthreads();
            for (int c = 0; c < NCH; c += 2) {
                if (c + 2 < NCH) SC_ISSUE(P, c + 2);
                if (c > 0) SC_YOUT(c - 1);
                SC_COMMIT(Q, 1, c + 1);
                __syncthreads();
                if (c + 3 < NCH) SC_ISSUE(Q, c + 3);
                SC_YOUT(c);
                if (c + 2 < NCH) SC_COMMIT(P, 0, c + 2);
                __syncthreads();
            }
            SC_YOUT(NCH - 1);
        } else {
            const int kq8 = lane & 7, rowA = w * 8 + (lane >> 3);
            __syncthreads();
            f32x2 S0 = (f32x2){0.f, 0.f}, S1 = S0, S2 = S0, S3 = S0;
            for (int c = 0; c < NCH; ++c) {
                const int bi = c & 1;
                const float* kbp = KB(bi) + kq8 * 8; const float* vbp = VB(bi) + rowA; const float* bbp = BB(bi); float* ybp = YB(bi) + rowA;
#define SC_LOAD(dst, t) do { const float* q_ = kbp + (t) * 320; dst.a0 = *(const f32x4*)q_; dst.a1 = *(const f32x4*)(q_ + 4); dst.q0 = *(const f32x4*)(q_ + 64); dst.q1 = *(const f32x4*)(q_ + 68); \
                dst.w0 = *(const f32x4*)(q_ + 128); dst.w1 = *(const f32x4*)(q_ + 132); dst.b0 = *(const f32x4*)(q_ + 192); dst.b1 = *(const f32x4*)(q_ + 196); dst.k0 = *(const f32x4*)(q_ + 256); dst.k1 = *(const f32x4*)(q_ + 260); \
                dst.v = vbp[(t) * 32]; dst.bk = *(const f32x2*)(bbp + (t) * 2); } while (0)
#define LO2(V_) ((f32x2){(V_).x, (V_).y})
#define HI2(V_) ((f32x2){(V_).z, (V_).w})
                ScanOps o0, o1, o2; SC_LOAD(o0, 0); SC_LOAD(o1, 1);
                float yr = 0.f;
#pragma unroll
                for (int t = 0; t < TC; ++t) {
                    if (t + 2 < TC) SC_LOAD(o2, t + 2);
                    f32x2 pa = S0 * LO2(o0.a0), py = S0 * LO2(o0.q0);
                    pa = __builtin_elementwise_fma(S1, HI2(o0.a0), pa); py = __builtin_elementwise_fma(S1, HI2(o0.q0), py);
                    pa = __builtin_elementwise_fma(S2, LO2(o0.a1), pa); py = __builtin_elementwise_fma(S2, LO2(o0.q1), py);
                    pa = __builtin_elementwise_fma(S3, HI2(o0.a1), pa); py = __builtin_elementwise_fma(S3, HI2(o0.q1), py);
                    float sa = pa.x + pa.y, ys = py.x + py.y;
                    sa += dpp_f<0x141>(sa); ys += dpp_f<0x141>(ys);
                    sa += dpp_f<0xB1>(sa); ys += dpp_f<0xB1>(ys);
                    sa += dpp_f<0x4E>(sa); ys += dpp_f<0x4E>(ys);
                    const f32x2 sa2 = (f32x2){sa, sa}, v2 = (f32x2){o0.v, o0.v};
                    f32x2 t0 = LO2(o0.k0) * v2, t1 = HI2(o0.k0) * v2, t2 = LO2(o0.k1) * v2, t3 = HI2(o0.k1) * v2;
                    t0 = __builtin_elementwise_fma(LO2(o0.b0), sa2, t0); t1 = __builtin_elementwise_fma(HI2(o0.b0), sa2, t1);
                    t2 = __builtin_elementwise_fma(LO2(o0.b1), sa2, t2); t3 = __builtin_elementwise_fma(HI2(o0.b1), sa2, t3);
                    S0 = __builtin_elementwise_fma(S0, LO2(o0.w0), t0); S1 = __builtin_elementwise_fma(S1, HI2(o0.w0), t1);
                    S2 = __builtin_elementwise_fma(S2, LO2(o0.w1), t2); S3 = __builtin_elementwise_fma(S3, HI2(o0.w1), t3);
                    const float y = ys + sa * o0.bk.x + o0.v * o0.bk.y;
                    yr = (kq8 == (t & 7)) ? y : yr;
                    if ((t & 7) == 7) ybp[(t - 7 + kq8) * 32] = yr;
                    o0 = o1; o1 = o2;
                }
                __syncthreads();
            }
        }
    }
    __syncthreads();
}

#define RLX_AGENT __ATOMIC_RELAXED, __HIP_MEMORY_SCOPE_AGENT
#define XB_TMO      128
#define XB_XCNT(j)  (256  + 64 * (j))
#define XB_XSUB(j)  (1280 + 64 * (j))
#define XB_XGEN(j)  (2304 + 64 * (j))
#define XB_TOP      3328
#define XB_TOPGEN   3392
#define XCD_BAR_WORDS 3456
#define XB_SPIN_CAP (1u << 18)

__device__ __forceinline__ unsigned xb_ld(unsigned* p)              { return __hip_atomic_load(p, __ATOMIC_RELAXED, __HIP_MEMORY_SCOPE_AGENT); }
__device__ __forceinline__ unsigned xb_add(unsigned* p, unsigned v) { return __hip_atomic_fetch_add(p, v, __ATOMIC_RELAXED, __HIP_MEMORY_SCOPE_AGENT); }
__device__ __forceinline__ unsigned xb_xcc_id() { return (unsigned)__builtin_amdgcn_s_getreg((3 << 11) | 20) & 0xFu; }
#define XB_SPIN(cond, bar) do { unsigned _sp = 0; while (cond) { __builtin_amdgcn_s_sleep(1); \
    if ((++_sp & 255u) == 0u) { if (xb_ld(&(bar)[XB_TMO])) break; if (_sp > XB_SPIN_CAP) { atomicAdd(&(bar)[XB_TMO], 1u); break; } } } } while (0)

struct XcdBarrier {
    unsigned* bar; unsigned x;
    volatile LAS unsigned* st;
};

__device__ __forceinline__ XcdBarrier xcd_barrier_post(unsigned* bar, volatile LAS unsigned* st) {
    XcdBarrier b; b.bar = bar; b.x = xb_xcc_id(); b.st = st;
    if (threadIdx.x == 0) (void)xb_add(&bar[XB_XCNT(b.x)], 1u);
    return b;
}
__device__ __forceinline__ void xcd_barrier_complete(unsigned* bar, unsigned x, unsigned& nloc, unsigned& nx) {
    const unsigned G = gridDim.x * gridDim.y * gridDim.z;
    unsigned sum, cnt, mine, sp = 0u;
    for (;;) {
        sum = 0u; cnt = 0u; mine = 0u;
#pragma unroll
        for (unsigned j = 0; j < 16; ++j) { const unsigned c = xb_ld(&bar[XB_XCNT(j)]); sum += c; cnt += (c > 0u) ? 1u : 0u; mine = (j == x) ? c : mine; }
        if (sum == G) break;
        __builtin_amdgcn_s_sleep(1);
        if ((++sp & 255u) == 0u) { if (xb_ld(&bar[XB_TMO])) break; if (sp > XB_SPIN_CAP) { atomicAdd(&bar[XB_TMO], 1u); break; } }
    }
    nloc = mine > 0u ? mine : 1u; nx = cnt > 0u ? cnt : 1u;
}

__device__ __forceinline__ void xcd_barrier(const XcdBarrier& b) {
    asm volatile("s_waitcnt vmcnt(0)" ::: "memory");
    __syncthreads();
    if (threadIdx.x == 0) {
        unsigned* bar = b.bar;
        __builtin_amdgcn_s_waitcnt(0);
        unsigned nloc = b.st[0], nx = b.st[1];
        if (nloc == 0u) { xcd_barrier_complete(bar, b.x, nloc, nx); b.st[0] = nloc; b.st[1] = nx; }
        const unsigned old = xb_add(&bar[XB_XSUB(b.x)], 1u);
        const unsigned gen = old / nloc;
        if (old + 1u == (gen + 1u) * nloc) {
            __builtin_amdgcn_fence(__ATOMIC_RELEASE, "agent");
            asm volatile("s_waitcnt vmcnt(0)" ::: "memory");
            const unsigned og = xb_add(&bar[XB_TOP], 1u);
            const unsigned tg = og / nx;
            if (og + 1u == (tg + 1u) * nx) xb_add(&bar[XB_TOPGEN], 1u);
            else XB_SPIN(xb_ld(&bar[XB_TOPGEN]) == tg, bar);
            __builtin_amdgcn_fence(__ATOMIC_ACQUIRE, "agent");
            xb_add(&bar[XB_XGEN(b.x)], 1u);
            asm volatile("s_waitcnt vmcnt(0)" ::: "memory");
        } else {
            XB_SPIN(xb_ld(&bar[XB_XGEN(b.x)]) == gen, bar);
            __builtin_amdgcn_fence(__ATOMIC_ACQUIRE, "agent");
            asm volatile("s_waitcnt vmcnt(0)" ::: "memory");
        }
    }
    __syncthreads();
}


__global__ void __launch_bounds__(NT, 2) mk_fwd(Args args) {
    extern __shared__ __attribute__((aligned(16))) unsigned char lds[];
    const int G = gridDim.x, bid = blockIdx.x, NGW = G * NWAVES;
    PG8_LAS unsigned char* glds = (PG8_LAS unsigned char*)lds;
    typedef const __attribute__((address_space(4))) Args* ArgP;
#define PH_ARGS() ArgP ap = (ArgP)__builtin_amdgcn_kernarg_segment_ptr(); asm volatile("" : "+s"(ap)); unsigned char* const ws = ap->ws; (void)ws; \
    int tid = threadIdx.x; asm volatile("" : "+v"(tid)); const int lane = tid & 63, wave = __builtin_amdgcn_readfirstlane(tid >> 6), gw = bid * NWAVES + wave; (void)lane; (void)gw
#define INP(i) (ap->in[i])
#define WB(off) ((bf16_t*)(ws + (off)))
#define CB(i) ((bf16_t*)(ws + WS_C(i)))
#define D1P ((bf16_t*)ap->out)
#define YSP ((bf16_t*)((unsigned char*)ap->out + CH))
#define X2P ((float*)(ws + WS_C(2)))
#define ATTOP (CB(0) + (size_t)3 * M * 256)
#if MK_MULTI
    const int lo = args.ph_lo, hi = args.ph_hi; int ph = 0;
#define SEAM() do { ++ph; } while (0)
#define SEAM0() SEAM()
#define IN() (lo <= ph && ph < hi)
#else
    cg::grid_group grid = cg::this_grid();
    unsigned* const barw = (unsigned*)args.ws;
    volatile LAS unsigned* const bst = (volatile LAS unsigned*)((LAS unsigned char*)lds + LDS_BYTES - 64);
    if (threadIdx.x < 2) bst[threadIdx.x] = 0u;
    if (bid == 0) for (int i = threadIdx.x; i < XCD_BAR_WORDS; i += NT) barw[i] = 0u;
    __syncthreads();
    XcdBarrier xbar; xbar.bar = barw; xbar.x = 0; xbar.st = bst;
#define SEAM0() do { __threadfence(); grid.sync(); xbar = xcd_barrier_post(barw, bst); } while (0)
#define SEAM() do { xcd_barrier(xbar); } while (0)
#define IN() true
#endif
#define PHASE(p) for (int rep_ = 0; IN() && rep_ < 1 + (int)((PROBE_MASK >> (p)) & 1u); ++rep_)

    PHASE(0) {
        PH_ARGS();
        float* scr = (float*)(lds + wave * 16896);
        tr_job(INP(I_F1G), INP(I_F1U), FF, D, WB(WS_WGU1), D, 2 * FF, 1, 0, 0, scr, gw, NGW, lane);
        tr_job(INP(I_F1D), nullptr, D, FF, WB(WS_WD1), FF, D, 0, 0, D, scr, gw, NGW, lane);
        tr_job(INP(I_F2G), INP(I_F2U), FF, D, WB(WS_WGU2), D, 2 * FF, 1, 0, 0, scr, gw, NGW, lane);
        tr_job(INP(I_F2D), nullptr, D, FF, WB(WS_WD2), FF, D, 0, 0, D, scr, gw, NGW, lane);
        tr_job(INP(I_WIN), nullptr, INC, D, WB(WS_WIN), D, 5888, 0, 0, 5664, scr, gw, NGW, lane);
        tr_job(INP(I_WIN), nullptr, INC, D, WB(WS_WIN) + (size_t)5888 * D, D, 2048, 0, 5664, INC, scr, gw, NGW, lane);
        tr_job(INP(I_AUP), nullptr, D, 256, WB(WS_WUP), 256, D, 0, 0, D, scr, gw, NGW, lane);
        tr_job(INP(I_WOUT), nullptr, D, D, WB(WS_WOUT), D, D, 0, 0, D, scr, gw, NGW, lane);
        tr_job(INP(I_WO), nullptr, D, D, WB(WS_WO), D, D, 0, 0, D, scr, gw, NGW, lane);
        tr_job(INP(I_W2), nullptr, D, 64, WB(WS_LW), 128, D, 0, 0, D, scr, gw, NGW, lane);
        tr_job(INP(I_A2), nullptr, D, 64, WB(WS_LA2), 128, D, 0, 0, D, scr, gw, NGW, lane);
        tr_job(INP(I_G2), nullptr, D, 160, WB(WS_LG), 256, D, 0, 0, D, scr, gw, NGW, lane);
        for (int i = bid * NT + tid; i < SEQ * 8; i += G * NT) {
            const int pos = i >> 3, j = i & 7;
            const float invf = powf(500000.0f, -(float)j * 0.125f);
            const float ang = (float)pos * invf;
            double rev = (double)ang * 0.15915494309189535; rev -= rint(rev);
            const float rf = (float)rev;
            ((float*)(ws + WS_ROPE))[pos * 16 + j] = __builtin_amdgcn_cosf(rf); ((float*)(ws + WS_ROPE))[pos * 16 + 8 + j] = __builtin_amdgcn_sinf(rf);
        }
        for (int m = gw; m < M; m += NGW) norm_row(INP(I_X) + (size_t)m * D, nullptr, INP(I_F1N), CB(0) + (size_t)m * D, nullptr, lane);
    }
    SEAM0();
    PHASE(1) {
        PH_ARGS();
        pg8::Gemm g{CB(0), WB(WS_WGU1), M, 2 * FF, D, D, D}; pg8::StaticOrder S; S.init(M, 2 * FF, G, bid);
        pg8::EpiOp<OpGateUp> E{{CB(1)}};
        pg8::gemm_phase(glds, g, S, E);
    }
    SEAM();
    PHASE(2) {
        PH_ARGS();
        pg8::Gemm g{CB(1), WB(WS_WD1), M, D, FF, FF, FF}; pg8::StaticOrder S; S.init(M, D, G, bid);
        pg8::EpiOp<OpStoreBf16> E{{D1P, D, 0.5f}};
        pg8::gemm_phase(glds, g, S, E);
    }
    SEAM();
    PHASE(3) {
        PH_ARGS();
        for (int m = gw; m < M; m += NGW) norm_row(INP(I_X) + (size_t)m * D, D1P + (size_t)m * D, INP(I_MN), CB(0) + (size_t)m * D, nullptr, lane);
    }
    SEAM();
    PHASE(4) {
        PH_ARGS();
        { pg8::Gemm g{CB(0), WB(WS_WIN), M, 2304, D, D, D}; pg8::StaticOrder S; S.init(M, 2304, G, bid);
          pg8::EpiOp<OpAttnQKV> E{{CB(1), CB(2), CB(3), ((float*)(ws + WS_ROPE))}};
          pg8::gemm_phase(glds, g, S, E); }
        { pg8::Gemm g{CB(0), WB(WS_WIN) + (size_t)2304 * D, M, 3584, D, D, D}; pg8::StaticOrder S; S.init(M, 3584, G, bid);
          pg8::EpiOp<OpRwkvZ> E{{CB(4), CB(5), CB(6), WB(WS_LA), WB(WS_HALO), WB(WS_HALOLA)}};
          pg8::gemm_phase(glds, g, S, E); }
    }
    SEAM();
    PHASE(5) { PH_ARGS(); attn_phase(lds, CB(1), CB(2), CB(3), CB(0), (float*)(ws + WS_LSE), G, bid); }
    SEAM();
    PHASE(6) {
        PH_ARGS();
        const float* mu = INP(I_MU) + 3072;
        for (int grp = gw; grp < M / 32; grp += NGW) {
            if (lane < 48) {
                const int c0 = lane * 8; bf16_t* base = WB(WS_LA) + (size_t)grp * 32 * LAW + c0;
                if (lane >= 36) { for (int rr = 0; rr < 32; ++rr) *(u32x4*)(base + (size_t)rr * LAW) = (u32x4){0u, 0u, 0u, 0u}; }
                else {
                    float mv[8];
#pragma unroll
                    for (int i = 0; i < 8; ++i) mv[i] = mu[c0 + i];
                    float prev[8];
                    if ((grp & 255) == 0) {
#pragma unroll
                        for (int i = 0; i < 8; ++i) prev[i] = 0.f; }
                    else unpack8(*(const u32x4*)(WB(WS_HALOLA) + (size_t)(grp - 1) * LAW + c0), prev);
                    for (int r8 = 0; r8 < 32; r8 += 8) {
                        u32x4 raw[8];
#pragma unroll
                        for (int j = 0; j < 8; ++j) raw[j] = *(const u32x4*)(base + (size_t)(r8 + j) * LAW);
#pragma unroll
                        for (int j = 0; j < 8; ++j) {
                            float cur[8], o[8]; unpack8(raw[j], cur);
#pragma unroll
                            for (int i = 0; i < 8; ++i) { const float z = cur[i] + (prev[i] - cur[i]) * mv[i];
                                o[i] = c0 < 64 ? (1.f - 2.f * __builtin_amdgcn_rcpf(1.f + __expf(2.f * z))) : (c0 < 128 ? z : sigm(z)); prev[i] = cur[i]; }
                            *(u32x4*)(base + (size_t)(r8 + j) * LAW) = pack8(o);
                        }
                    }
                }
            }
        }
        for (int it = gw; it < M / 2; it += NGW) {
            const int row = it * 2 + (lane >> 5), pc = lane & 31, hg = pc >> 3;
            const float l0 = ((float*)(ws + WS_LSE))[((size_t)0 * M + row) * 4 + hg], l1 = ((float*)(ws + WS_LSE))[((size_t)1 * M + row) * 4 + hg], l2 = ((float*)(ws + WS_LSE))[((size_t)2 * M + row) * 4 + hg];
            const float mx = fmaxf(l0, fmaxf(l1, l2)); float w0 = __expf(l0 - mx), w1 = __expf(l1 - mx), w2 = __expf(l2 - mx);
            const float iw = 1.f / (w0 + w1 + w2); w0 *= iw; w1 *= iw; w2 *= iw;
            float a[8], bb[8], c[8], o[8];
            unpack8(*(const u32x4*)(CB(0) + ((size_t)0 * M + row) * 256 + pc * 8), a); unpack8(*(const u32x4*)(CB(0) + ((size_t)1 * M + row) * 256 + pc * 8), bb);
            unpack8(*(const u32x4*)(CB(0) + ((size_t)2 * M + row) * 256 + pc * 8), c);
#pragma unroll
            for (int i = 0; i < 8; ++i) o[i] = w0 * a[i] + w1 * bb[i] + w2 * c[i];
            *(u32x4*)(ATTOP + (size_t)row * 256 + pc * 8) = pack8(o);
        }
    }
    SEAM();
    PHASE(7) {
        PH_ARGS();
        { pg8::Gemm g{WB(WS_LA), WB(WS_LW), M, D, 128, LAW, 128}; pg8::StaticOrder S; S.init(M, D, G, bid);
          pg8::EpiOp<OpLora<0>> E{{CB(1), INP(I_W0)}};
          pg8::gemm_phase(glds, g, S, E); }
        { pg8::Gemm g{WB(WS_LA) + 64, WB(WS_LA2), M, D, 128, LAW, 128}; pg8::StaticOrder S; S.init(M, D, G, bid);
          pg8::EpiOp<OpLora<1>> E{{CB(3), INP(I_A0)}};
          pg8::gemm_phase(glds, g, S, E); }
    }
    SEAM();
    PHASE(9) { PH_ARGS(); scan_phase(lds, CB(4), CB(1), CB(5), CB(6), CB(3), INP(I_MU), INP(I_KK), INP(I_KA), INP(I_RK), (float*)(ws + WS_BC), YSP, G, bid); }
    SEAM();
    PHASE(10) {
        PH_ARGS();
        { pg8::Gemm g{WB(WS_LA) + 128, WB(WS_LG), M, D, 256, LAW, 256}; pg8::StaticOrder S; S.init(M, D, G, bid);
          pg8::EpiOp<OpStoreBf16> E{{CB(1), D, 1.0f}};
          pg8::gemm_phase(glds, g, S, E); }
        for (int m = gw; m < M; m += NGW) norm_row(INP(I_X) + (size_t)m * D, D1P + (size_t)m * D, INP(I_MN), CB(2) + (size_t)m * D, nullptr, lane);
    }
    SEAM();
    PHASE(11) {
        PH_ARGS();
        const int r8 = lane >> 3, seg = lane & 7;
        for (int it = gw; it < (M / 8) * 16; it += NGW) {
            const int h = it & 15; const size_t row = (size_t)(it >> 4) * 8 + r8; const int c0 = h * 64 + seg * 8; const size_t off = row * D + c0;
            float yv[8], vv[8], gv[8], o[8];
            unpack8(*(const u32x4*)(YSP + off), yv); unpack8(*(const u32x4*)(CB(6) + off), vv); unpack8(*(const u32x4*)(CB(1) + off), gv);
            { float vp[8]; const u32x4 z4 = (u32x4){0u, 0u, 0u, 0u}; unpack8((row & (SEQ - 1)) == 0 ? z4 : *(const u32x4*)(CB(6) + off - D), vp);
#pragma unroll
              for (int i = 0; i < 8; ++i) vv[i] += (vp[i] - vv[i]) * INP(I_MU)[2048 + c0 + i]; }
            const float bc = ((float*)(ws + WS_BC))[row * 16 + h];
            float s = 0.f;
#pragma unroll
            for (int i = 0; i < 8; ++i) s += yv[i];
            s += __shfl_xor(s, 1); s += __shfl_xor(s, 2); s += __shfl_xor(s, 4);
            const float mean = s * (1.f / 64.f); float q = 0.f;
#pragma unroll
            for (int i = 0; i < 8; ++i) { yv[i] -= mean; q += yv[i] * yv[i]; }
            q += __shfl_xor(q, 1); q += __shfl_xor(q, 2); q += __shfl_xor(q, 4);
            const float rstd = rsqrtf(q * (1.f / 64.f) + GN_EPS);
#pragma unroll
            for (int i = 0; i < 8; ++i) o[i] = (yv[i] * rstd * INP(I_LNW)[c0 + i] + INP(I_LNB)[c0 + i] + bc * vv[i]) * gv[i];
            *(u32x4*)(CB(3) + off) = pack8(o);
        }
    }
    SEAM();
    PHASE(12) {
        PH_ARGS();
        { pg8::Gemm g{CB(2), WB(WS_WIN) + (size_t)5888 * D, M, 2048, D, D, D}; pg8::StaticOrder S; S.init(M, 2048, G, bid);
          pg8::EpiOp<OpGates> E{{CB(4), CB(5), INP(I_GB)}};
          pg8::gemm_phase(glds, g, S, E); }
        { pg8::Gemm g{ATTOP, WB(WS_WUP), M, D, 256, 256, 256}; pg8::StaticOrder S; S.init(M, D, G, bid);
          pg8::EpiOp<OpStoreBf16> E{{CB(6), D, 1.0f}};
          pg8::gemm_phase(glds, g, S, E); }
    }
    SEAM();
    PHASE(13) {
        PH_ARGS();
        pg8::Gemm g{CB(3), WB(WS_WOUT), M, D, D, D, D}; pg8::StaticOrder S; S.init(M, D, G, bid);
        pg8::EpiOp<OpMerge> E{{CB(4), CB(6), CB(5), CB(1)}};
        pg8::gemm_phase(glds, g, S, E);
    }
    SEAM();
    PHASE(14) {
        PH_ARGS();
        pg8::Gemm g{CB(1), WB(WS_WO), M, D, D, D, D}; pg8::StaticOrder S; S.init(M, D, G, bid);
        pg8::EpiOp<OpRes> E{{INP(I_X), D1P, X2P, 1.0f}};
        pg8::gemm_phase(glds, g, S, E);
    }
    SEAM();
    PHASE(15) {
        PH_ARGS();
        for (int m = gw; m < M; m += NGW) norm_row(X2P + (size_t)m * D, nullptr, INP(I_F2N), CB(0) + (size_t)m * D, nullptr, lane);
    }
    SEAM();
    PHASE(16) {
        PH_ARGS();
        pg8::Gemm g{CB(0), WB(WS_WGU2), M, 2 * FF, D, D, D}; pg8::StaticOrder S; S.init(M, 2 * FF, G, bid);
        pg8::EpiOp<OpGateUp> E{{CB(4)}};
        pg8::gemm_phase(glds, g, S, E);
    }
    SEAM();
    PHASE(17) {
        PH_ARGS();
        pg8::Gemm g{CB(4), WB(WS_WD2), M, D, FF, FF, FF}; pg8::StaticOrder S; S.init(M, D, G, bid);
        pg8::EpiOp<OpRes> E{{X2P, nullptr, ap->out, 0.5f}};
        pg8::gemm_phase(glds, g, S, E);
    }
    SEAM();
    PHASE(18) {
        PH_ARGS();
        for (int m = gw; m < M; m += NGW) norm_row(ap->out + (size_t)m * D, nullptr, INP(I_FN), nullptr, ap->out + (size_t)m * D, lane);
    }
}
constexpr int N_PHASES = 19;

extern "C" void kernel_launch(void* const* d_in, const int* in_sizes, int n_in, void* d_out, int out_size, void* d_ws, size_t ws_size, hipStream_t stream) {
    static int grid = 0;
    if (grid == 0) {
        if (n_in != 27 || in_sizes[0] != M * D || out_size != M * D || ws_size < WS_END) { fprintf(stderr, "kernel_launch: unexpected shapes (n_in %d, in0 %d, out %d, ws %zu)\n", n_in, n_in > 0 ? in_sizes[0] : -1, out_size, ws_size); grid = -1; return; }
        int dev = 0, cus = 0, per_cu = 0;
        hipGetDevice(&dev); hipDeviceGetAttribute(&cus, hipDeviceAttributeMultiprocessorCount, dev);
        if (hipFuncSetAttribute((const void*)mk_fwd, hipFuncAttributeMaxDynamicSharedMemorySize, LDS_BYTES) != hipSuccess) { fprintf(stderr, "kernel_launch: hipFuncSetAttribute failed\n"); grid = -1; return; }
        if (hipOccupancyMaxActiveBlocksPerMultiprocessor(&per_cu, (const void*)mk_fwd, NT, LDS_BYTES) != hipSuccess || per_cu < 1) { fprintf(stderr, "kernel_launch: occupancy query says %d\n", per_cu); per_cu = 1; }
        (void)hipGetLastError();
        grid = cus;
    }
    if (grid < 0) return;
    Args a{};
    for (int i = 0; i < 27; ++i) a.in[i] = (const float*)d_in[i];
    a.out = (float*)d_out; a.ws = (unsigned char*)d_ws;
#if MK_MULTI
    for (int p = 0; p < N_PHASES; ++p) { a.ph_lo = p; a.ph_hi = p + 1; hipLaunchKernelGGL(mk_fwd, dim3(grid), dim3(NT), LDS_BYTES, stream, a); }
#else
    a.ph_lo = 0; a.ph_hi = N_PHASES;
    void* kargs[] = {&a};
    hipError_t e = hipLaunchCooperativeKernel((const void*)mk_fwd, dim3(grid), dim3(NT), kargs, LDS_BYTES, stream);
    if (e != hipSuccess) fprintf(stderr, "kernel_launch: cooperative launch failed: %s (grid %d)\n", hipGetErrorString(e), grid);
#endif
}
```

```cpp
#include <hip/hip_runtime.h>
#include <hip/hip_cooperative_groups.h>
#include <cstdio>
#include <cstdint>
namespace cg = cooperative_groups;

#ifndef MK_MULTI
#define MK_MULTI 0
#endif
#ifndef ATT_REP
#define ATT_REP 1
#endif
#ifndef PROBE_MASK
#define PROBE_MASK 0u
#endif

__device__ __forceinline__ int lane_id_fresh() { int l; asm volatile("v_mbcnt_lo_u32_b32 %0, -1, 0\n\tv_mbcnt_hi_u32_b32 %0, -1, %0" : "=v"(l)); return l; }
#define KTID(wv) ((wv) * 64 + lane_id_fresh())
namespace pg8 {
#define PG8_LAS __attribute__((address_space(3)))
typedef unsigned short bf16_t;
typedef short bf16x8 __attribute__((ext_vector_type(8)));
typedef float f32x4 __attribute__((ext_vector_type(4)));
typedef unsigned u32x4 __attribute__((ext_vector_type(4)));
constexpr int BM = 256, BK = 64, HALF = 128, HTB = HALF * BK * 2, STAGE_BYTES = 8 * HTB, NXCD = 8, WGM = 8;

__host__ __device__ __forceinline__ int lds_byte(int r, int c) { const int st = (r >> 4) * 2 + (c >> 5), rr = r & 15, cc = c & 31, ob = rr * 64 + cc * 2; return st * 1024 + (ob ^ (((ob >> 9) & 1) << 5)); }
__host__ __device__ __forceinline__ void stage_rc(int b, int& R, int& C) { const int st = b / 1024, sb = b % 1024, swz = sb ^ (((sb >> 9) & 1) << 5); R = (st >> 1) * 16 + swz / 64; C = (st & 1) * 32 + (swz % 64) / 2; }
__host__ __device__ __forceinline__ int perm32(int rho) { const int n = rho >> 4, i = rho & 15; return 8 * (i >> 2) + 4 * n + (i & 3); }

struct Unit { int pm, pn; };
struct Gemm { const bf16_t* A; const bf16_t* Bt; int M, N, K, lda, ldb; };

struct StaticOrder {
    int nM, nN, nwg, G, c;
    __host__ __device__ void init(int M, int N, int G_, int c_) { nM = M / BM; nN = N / BM; nwg = nM * nN; G = G_; c = c_; }
    __host__ __device__ bool next(int i, Unit& u) const {
        const long L = (long)i * G + c; if (L >= nwg) return false;
        int wgid = (int)L; { const int q = nwg / NXCD, r = nwg % NXCD, xcd = wgid % NXCD, off = wgid / NXCD; wgid = (xcd < r ? xcd * (q + 1) : r * (q + 1) + (xcd - r) * q) + off; }
        const int nig = WGM * nN, gid = wgid / nig, fm = gid * WGM, gsz = (nM - fm) < WGM ? (nM - fm) : WGM;
        u.pm = fm + ((wgid % nig) % gsz); u.pn = (wgid % nig) / gsz; return true;
    }
};

__device__ __forceinline__ unsigned cvt_pk_bf16(float lo, float hi) { unsigned r; asm volatile("v_cvt_pk_bf16_f32 %0, %1, %2" : "=v"(r) : "v"(lo), "v"(hi)); return r; }

template <class Op> struct EpiOp {
    Op op;
    __device__ __forceinline__ void operator()(const f32x4 (&acc)[2][2][4][2], const Unit& u, int wr, int wc, int fr, int fq) const {
#pragma unroll
        for (int ai = 0; ai < 2; ++ai)
#pragma unroll
            for (int m = 0; m < 4; ++m) {
                const int row = u.pm * BM + ai * HALF + wr * 64 + m * 16 + fr;
                op(acc[ai][0][m][0], acc[ai][0][m][1], acc[ai][1][m][0], acc[ai][1][m][1], row, u.pn, wc, fq);
                asm volatile("" ::: "memory");
            }
    }
};

template <class Epi, class Sched>
__device__ __forceinline__ void gemm_phase(PG8_LAS unsigned char* lds, const Gemm g, const Sched& S, const Epi& E, const int wv) {
    int tid_ = KTID(wv);
    const int tid = tid_, wid = __builtin_amdgcn_readfirstlane(tid >> 6), lane = tid & 63, wr = wid >> 2, wc = wid & 3, fr = lane & 15, fq = lane >> 4;
    const int K = g.K, nt = K / BK;
    unsigned voffA[2], voffB[2];
#pragma unroll
    for (int i = 0; i < 2; ++i) { int R, C; stage_rc(tid * 16 + i * 8192, R, C); const int Rb = (R & ~31) + perm32(R & 31);
        voffA[i] = (unsigned)(R * g.lda + C) * 2u; voffB[i] = (unsigned)(Rb * g.ldb + C) * 2u; }
    const size_t kstep = (size_t)(BK * 2);
    const size_t hstepA = (size_t)HALF * g.lda * 2, hstepB = (size_t)HALF * g.ldb * 2;
    const size_t tstepA = 2 * hstepA, tstepB = 2 * hstepB;
    const unsigned ldsw = (unsigned)wid * 1024u;
    const int aoff = lds_byte(wr * 64 + fr, fq * 8), boff = lds_byte(wc * 32 + fr, fq * 8);
#define PG8_SA(b, h) (((b) * 2 + (h)) * HTB)
#define PG8_SB(b, h) ((4 + (b) * 2 + (h)) * HTB)
#define PG8_STAGE(bufoff, gbase, voff) do { _Pragma("unroll") for (int _i = 0; _i < 2; ++_i) \
        __builtin_amdgcn_global_load_lds((const unsigned*)((const char*)(gbase) + (voff)[_i]), (PG8_LAS unsigned*)(lds + (bufoff) + ldsw + _i * 8192), 16, 0, 0); } while (0)
#define PG8_LDA(dst, b, h) do { _Pragma("unroll") for (int m = 0; m < 4; ++m) _Pragma("unroll") for (int k = 0; k < 2; ++k) dst[m][k] = *(const PG8_LAS bf16x8*)(lds + PG8_SA(b, h) + aoff + m * 2048 + k * 1024); } while (0)
#define PG8_LDB(dst, b, h) do { _Pragma("unroll") for (int n = 0; n < 2; ++n) _Pragma("unroll") for (int k = 0; k < 2; ++k) dst[n][k] = *(const PG8_LAS bf16x8*)(lds + PG8_SB(b, h) + boff + n * 2048 + k * 1024); } while (0)
#define PG8_MMA(ai, bj, At, Bt) do { __builtin_amdgcn_s_setprio(1); _Pragma("unroll") for (int m = 0; m < 4; ++m) _Pragma("unroll") for (int n = 0; n < 2; ++n) _Pragma("unroll") for (int k = 0; k < 2; ++k) \
        acc[ai][bj][m][n] = __builtin_amdgcn_mfma_f32_16x16x32_bf16(Bt[n][k], At[m][k], acc[ai][bj][m][n], 0, 0, 0); __builtin_amdgcn_s_setprio(0); } while (0)
#define PG8_WAIT_V(n) asm volatile("s_waitcnt vmcnt(" #n ")" ::: "memory")
#define PG8_WAIT_L(n) asm volatile("s_waitcnt lgkmcnt(" #n ")" ::: "memory")
#define PG8_BAR __builtin_amdgcn_s_barrier()
#define PG8_SCHED __builtin_amdgcn_sched_barrier(0)
    Unit cur, nxt; int ui = 0;
    if (!S.next(0, cur)) return;
    f32x4 acc[2][2][4][2];
#pragma unroll
    for (int a = 0; a < 2; ++a)
#pragma unroll
        for (int b = 0; b < 2; ++b)
#pragma unroll
            for (int m = 0; m < 4; ++m)
#pragma unroll
                for (int n = 0; n < 2; ++n) acc[a][b][m][n] = (f32x4){0.f, 0.f, 0.f, 0.f};
    bf16x8 At[4][2], B0[2][2], B1[2][2];
    const char* cA = (const char*)g.A + (size_t)cur.pm * tstepA; const char* cB = (const char*)g.Bt + (size_t)cur.pn * tstepB;
    PG8_STAGE(PG8_SB(0, 0), cB, voffB); PG8_STAGE(PG8_SB(0, 1), cB + hstepB, voffB); PG8_STAGE(PG8_SA(0, 0), cA, voffA); PG8_STAGE(PG8_SA(0, 1), cA + hstepA, voffA);
    if (wr == 1) PG8_BAR;
    PG8_WAIT_V(2); PG8_BAR;
    PG8_STAGE(PG8_SB(1, 0), cB + kstep, voffB); PG8_STAGE(PG8_SA(1, 0), cA + kstep, voffA); PG8_STAGE(PG8_SB(1, 1), cB + hstepB + kstep, voffB);
    PG8_WAIT_V(6); PG8_BAR;
    for (;;) {
        const bool has_next = S.next(ui + 1, nxt);
        const char* nA = has_next ? (const char*)g.A + (size_t)nxt.pm * tstepA : cA; const char* nB = has_next ? (const char*)g.Bt + (size_t)nxt.pn * tstepB : cB;
        for (int t = 0; t < nt; t += 2) {
            const bool last = (t == nt - 2);
            const char* a1 = cA + (size_t)(t + 1) * kstep;
            const char* a2 = last ? nA : cA + (size_t)(t + 2) * kstep; const char* b2 = last ? nB : cB + (size_t)(t + 2) * kstep;
            const char* a3 = a2 + kstep; const char* b3 = b2 + kstep;
            PG8_LDB(B0, 0, 0); PG8_LDB(B1, 0, 1); PG8_SCHED; PG8_LDA(At, 0, 0); PG8_STAGE(PG8_SA(1, 1), a1 + hstepA, voffA);
            PG8_WAIT_V(8); PG8_WAIT_L(0); PG8_BAR; PG8_MMA(0, 0, At, B0); PG8_MMA(0, 1, At, B1); PG8_BAR; PG8_SCHED;
            PG8_LDA(At, 0, 1); PG8_STAGE(PG8_SB(0, 0), b2, voffB); PG8_STAGE(PG8_SB(0, 1), b2 + hstepB, voffB); PG8_STAGE(PG8_SA(0, 0), a2, voffA);
            PG8_WAIT_V(8); PG8_WAIT_L(0); PG8_BAR; PG8_MMA(1, 0, At, B0); PG8_MMA(1, 1, At, B1); PG8_BAR; PG8_SCHED;
            PG8_LDB(B0, 1, 0); PG8_LDB(B1, 1, 1); PG8_SCHED; PG8_LDA(At, 1, 0); PG8_STAGE(PG8_SA(0, 1), a2 + hstepA, voffA);
            PG8_WAIT_V(8); PG8_WAIT_L(0); PG8_BAR; PG8_MMA(0, 0, At, B0); PG8_MMA(0, 1, At, B1); PG8_BAR; PG8_SCHED;
            PG8_LDA(At, 1, 1); PG8_STAGE(PG8_SB(1, 0), b3, voffB); PG8_STAGE(PG8_SB(1, 1), b3 + hstepB, voffB); PG8_STAGE(PG8_SA(1, 0), a3, voffA);
            PG8_WAIT_V(8); PG8_WAIT_L(0); PG8_BAR; PG8_MMA(1, 0, At, B0); PG8_MMA(1, 1, At, B1); PG8_BAR; PG8_SCHED;
        }
        if (wr == 0) PG8_BAR;
        { const int le_ = lane_id_fresh(); E(acc, cur, wr, wc, le_ & 15, le_ >> 4); }
        if (!has_next) break;
#pragma unroll
        for (int a = 0; a < 2; ++a)
#pragma unroll
            for (int b = 0; b < 2; ++b)
#pragma unroll
                for (int m = 0; m < 4; ++m)
#pragma unroll
                    for (int n = 0; n < 2; ++n) acc[a][b][m][n] = (f32x4){0.f, 0.f, 0.f, 0.f};
        cur = nxt; cA = nA; cB = nB; ++ui;
        if (wr == 1) PG8_BAR;
    }
    PG8_WAIT_V(0);
    PG8_BAR;
#undef PG8_SA
#undef PG8_SB
#undef PG8_STAGE
#undef PG8_LDA
#undef PG8_LDB
#undef PG8_MMA
#undef PG8_WAIT_V
#undef PG8_WAIT_L
#undef PG8_BAR
#undef PG8_SCHED
}
}

using pg8::bf16_t; using pg8::f32x4; using pg8::u32x4; using pg8::bf16x8;
typedef unsigned u32x2 __attribute__((ext_vector_type(2)));
#define LAS __attribute__((address_space(3)))

constexpr int BATCH = 8, SEQ = 8192, D = 1024, FF = 2816, M = BATCH * SEQ;
constexpr int AW = 768, RS = 3360, INC = 7712;
constexpr int LAW = 384;
constexpr int NWAVES = 8, NT = 512;
constexpr float NORM_EPS = 1e-6f, GN_EPS = 64e-5f;

constexpr size_t MiB = 1u << 20;
constexpr size_t WS_WGU1 = 1 * MiB;
constexpr size_t WS_WD1 = WS_WGU1 + 11 * MiB;
constexpr size_t WS_WGU2 = WS_WD1 + 5 * MiB + MiB / 2;
constexpr size_t WS_WD2 = WS_WGU2 + 11 * MiB;
constexpr size_t WS_WIN = WS_WD2 + 5 * MiB + MiB / 2;
constexpr size_t WS_WUP = WS_WIN + 15 * MiB + MiB / 2;
constexpr size_t WS_WOUT = WS_WUP + MiB / 2;
constexpr size_t WS_WO = WS_WOUT + 2 * MiB;
constexpr size_t WS_LW = WS_WO + 2 * MiB;
constexpr size_t WS_LA2 = WS_LW + MiB / 4;
constexpr size_t WS_LG = WS_LA2 + MiB / 4;
constexpr size_t WS_ROPE = WS_LG + MiB / 2;
static_assert(WS_ROPE + MiB / 2 <= 56 * MiB, "weights region");
constexpr size_t WS_LA = 56 * MiB;
constexpr size_t WS_HALO = 104 * MiB;
constexpr size_t WS_HALOLA = 104 * MiB;
constexpr size_t WS_BC = 111 * MiB;
constexpr size_t WS_LSE = 115 * MiB;
constexpr size_t WS_BRKR = 118 * MiB;
constexpr size_t WS_SS1 = 118 * MiB, WS_SS2 = WS_SS1 + MiB;
constexpr size_t CH = 128 * MiB;
constexpr size_t WS_C0 = 128 * MiB;
#define WS_C(i) (WS_C0 + (size_t)(i) * CH)
constexpr size_t WS_END = 1024 * MiB;
constexpr int LDS_BYTES = 147456;

__device__ __forceinline__ float bf2f(unsigned short h) { return __uint_as_float(((unsigned)h) << 16); }
__device__ __forceinline__ float bflo(unsigned w) { return __uint_as_float(w << 16); }
__device__ __forceinline__ float bfhi(unsigned w) { return __uint_as_float(w & 0xffff0000u); }
__device__ __forceinline__ unsigned pk2(float lo, float hi) { return pg8::cvt_pk_bf16(lo, hi); }
__device__ __forceinline__ void unpack8(const u32x4 w, float (&f)[8]) { f[0] = bflo(w.x); f[1] = bfhi(w.x); f[2] = bflo(w.y); f[3] = bfhi(w.y); f[4] = bflo(w.z); f[5] = bfhi(w.z); f[6] = bflo(w.w); f[7] = bfhi(w.w); }
__device__ __forceinline__ u32x4 pack8(const float (&f)[8]) { u32x4 w; w.x = pk2(f[0], f[1]); w.y = pk2(f[2], f[3]); w.z = pk2(f[4], f[5]); w.w = pk2(f[6], f[7]); return w; }
__device__ __forceinline__ float sigm(float x) { return __builtin_amdgcn_rcpf(1.f + __expf(-x)); }
__device__ __forceinline__ float wave_sum(float v) {
#pragma unroll
    for (int o = 1; o < 64; o <<= 1) v += __shfl_xor(v, o);
    return v;
}

__device__ __forceinline__ float row_rs(const float* ss, int row) { return rsqrtf(ss[row] * (1.f / D) + NORM_EPS); }
struct OpGateUp {
    bf16_t* H; const float* ss;
    __device__ __forceinline__ void operator()(const f32x4 g0_, const f32x4 g1_, const f32x4 u0_, const f32x4 u1_, int row, int pn, int wc, int fq) const {
        const int col = pn * 128 + wc * 32 + 8 * fq; float o[8];
        const float sc = ss ? row_rs(ss, row) : 1.f; const f32x4 g0 = g0_ * sc, g1 = g1_ * sc, u0 = u0_ * sc, u1 = u1_ * sc;
#pragma unroll
        for (int i = 0; i < 4; ++i) { o[i] = g0[i] * sigm(g0[i]) * u0[i]; o[4 + i] = g1[i] * sigm(g1[i]) * u1[i]; }
        *(u32x4*)(H + (size_t)row * FF + col) = pack8(o);
    }
};
struct OpStoreBf16 {
    bf16_t* O; int ld; float scale;
    __device__ __forceinline__ void operator()(const f32x4 a0, const f32x4 a1, const f32x4 b0, const f32x4 b1, int row, int pn, int wc, int fq) const {
        const int col = pn * 256 + wc * 32 + 8 * fq; float o[8];
#pragma unroll
        for (int i = 0; i < 4; ++i) { o[i] = a0[i] * scale; o[4 + i] = a1[i] * scale; }
        *(u32x4*)(O + (size_t)row * ld + col) = pack8(o);
#pragma unroll
        for (int i = 0; i < 4; ++i) { o[i] = b0[i] * scale; o[4 + i] = b1[i] * scale; }
        *(u32x4*)(O + (size_t)row * ld + col + 128) = pack8(o);
    }
};
struct OpRes {
    const float* base; const bf16_t* dlt; float* out; float scale; bf16_t* dout; bf16_t* xg; const float* gain; float* ss;
    __device__ __forceinline__ float half(const f32x4 a0, const f32x4 a1, size_t off, int col) const {
        const float sc_ = scale; f32x4 r0, r1;
#pragma unroll
        for (int i = 0; i < 4; ++i) { r0[i] = a0[i] * sc_; r1[i] = a1[i] * sc_; }
        if (dout) { u32x4 w; w.x = pk2(r0[0], r0[1]); w.y = pk2(r0[2], r0[3]); w.z = pk2(r1[0], r1[1]); w.w = pk2(r1[2], r1[3]); *(u32x4*)(dout + off) = w; }
        if (base) { r0 += *(const f32x4*)(base + off); r1 += *(const f32x4*)(base + off + 4); }
        if (dlt) { float d[8]; unpack8(*(const u32x4*)(dlt + off), d); r0 += (f32x4){d[0], d[1], d[2], d[3]}; r1 += (f32x4){d[4], d[5], d[6], d[7]}; }
        if (out) { *(f32x4*)(out + off) = r0; *(f32x4*)(out + off + 4) = r1; }
        float q = 0.f;
        if (xg) { const f32x4 g0 = *(const f32x4*)(gain + col), g1 = *(const f32x4*)(gain + col + 4); const f32x4 y0 = r0 * g0, y1 = r1 * g1;
            u32x4 w; w.x = pk2(y0[0], y0[1]); w.y = pk2(y0[2], y0[3]); w.z = pk2(y1[0], y1[1]); w.w = pk2(y1[2], y1[3]); *(u32x4*)(xg + off) = w;
            q = (r0[0] * r0[0] + r0[1] * r0[1]) + (r0[2] * r0[2] + r0[3] * r0[3]) + (r1[0] * r1[0] + r1[1] * r1[1]) + (r1[2] * r1[2] + r1[3] * r1[3]); }
        return q;
    }
    __device__ __forceinline__ void operator()(const f32x4 a0, const f32x4 a1, const f32x4 b0, const f32x4 b1, int row, int pn, int wc, int fq) const {
        const int col = pn * 256 + wc * 32 + 8 * fq; const size_t off = (size_t)row * D + col;
        float q = half(a0, a1, off, col) + half(b0, b1, off + 128, col + 128);
        if (xg) { q += __shfl_xor(q, 16); q += __shfl_xor(q, 32); if (fq == 0) atomicAdd(ss + row, q); }
    }
};
struct OpAttnQKV {
    bf16_t* q; bf16_t* k; bf16_t* v; const float* rope; const float* ss;
    __device__ __forceinline__ void half(const f32x4 a0, const f32x4 a1, bf16_t* dst, int row, int wc, int fq, int which) const {
        float o[8];
#pragma unroll
        for (int i = 0; i < 4; ++i) { o[i] = a0[i]; o[4 + i] = a1[i]; }
        if (which < 2 && (wc & 1) == 0) {
            float p[8];
#pragma unroll
            for (int i = 0; i < 8; ++i) p[i] = __shfl_xor(o[i], 16);
            if (fq < 2) {
                const float* cs = rope + (size_t)(row & (SEQ - 1)) * 16;
                const f32x4 c0 = *(const f32x4*)(cs), c1 = *(const f32x4*)(cs + 4), s0 = *(const f32x4*)(cs + 8), s1 = *(const f32x4*)(cs + 12);
                const float sg = fq == 0 ? -1.f : 1.f;
#pragma unroll
                for (int i = 0; i < 4; ++i) { o[i] = o[i] * c0[i] + sg * p[i] * s0[i]; o[4 + i] = o[4 + i] * c1[i] + sg * p[4 + i] * s1[i]; }
            }
        }
        if (which == 0) {
#pragma unroll
            for (int i = 0; i < 8; ++i) o[i] *= 0.125f;
        }
        *(u32x4*)dst = pack8(o);
    }
    __device__ __forceinline__ void operator()(const f32x4 a0, const f32x4 a1, const f32x4 b0, const f32x4 b1, int row, int pn, int wc, int fq) const {
        const int which = pn / 3, col = (pn - which * 3) * 256 + wc * 32 + 8 * fq;
        bf16_t* base = q + (size_t)which * (CH / 2) + (size_t)row * AW + col;
        const float sc = row_rs(ss, row);
        half(a0 * sc, a1 * sc, base, row, wc, fq, which); half(b0 * sc, b1 * sc, base + 128, row, wc, fq, which);
    }
};
struct OpRwkvZ {
    bf16_t* r; bf16_t* k; bf16_t* v; bf16_t* la; const float* ss; bf16_t* halola;
    __device__ __forceinline__ void operator()(const f32x4 a0, const f32x4 a1, const f32x4 b0, const f32x4 b1, int row, int pn, int wc, int fq) const {
        float o0[8], o1[8]; const float sc = row_rs(ss, row);
#pragma unroll
        for (int i = 0; i < 4; ++i) { o0[i] = a0[i] * sc; o0[4 + i] = a1[i] * sc; o1[i] = b0[i] * sc; o1[4 + i] = b1[i] * sc; }
        const u32x4 w0 = pack8(o0), w1 = pack8(o1);
        const bool hrow = (row & 31) == 31;
        if (pn < 12) {
            const int s = pn >> 2, col = (pn & 3) * 256 + wc * 32 + 8 * fq;
            bf16_t* dst = r + (size_t)s * (CH / 2) + (size_t)row * D + col;
            *(u32x4*)dst = w0; *(u32x4*)(dst + 128) = w1;
        } else {
            const int col = (pn - 12) * 256 + wc * 32 + 8 * fq;
            if (col < 288) { *(u32x4*)(la + (size_t)row * LAW + col) = w0; if (hrow) *(u32x4*)(halola + (size_t)(row >> 5) * LAW + col) = w0; }
            if (col + 128 < 288) { *(u32x4*)(la + (size_t)row * LAW + col + 128) = w1; if (hrow) *(u32x4*)(halola + (size_t)(row >> 5) * LAW + col + 128) = w1; }
        }
    }
};
struct OpGates {
    bf16_t* ga; bf16_t* gr; const float* bias; const float* ss;
    __device__ __forceinline__ void operator()(const f32x4 a0, const f32x4 a1, const f32x4 b0, const f32x4 b1, int row, int pn, int wc, int fq) const {
        const int s = pn >> 2, col = (pn & 3) * 256 + wc * 32 + 8 * fq; const float* bp = bias + s * 1024 + col;
        bf16_t* dst = ga + (size_t)s * (CH / 2) + (size_t)row * D + col; float o[8]; const float sc = row_rs(ss, row);
        { const f32x4 c0 = *(const f32x4*)bp, c1 = *(const f32x4*)(bp + 4);
#pragma unroll
          for (int i = 0; i < 4; ++i) { o[i] = sigm(a0[i] * sc + c0[i]); o[4 + i] = sigm(a1[i] * sc + c1[i]); }
          *(u32x4*)dst = pack8(o); }
        { const f32x4 c0 = *(const f32x4*)(bp + 128), c1 = *(const f32x4*)(bp + 132);
#pragma unroll
          for (int i = 0; i < 4; ++i) { o[i] = sigm(b0[i] * sc + c0[i]); o[4 + i] = sigm(b1[i] * sc + c1[i]); }
          *(u32x4*)(dst + 128) = pack8(o); }
    }
};
template <int MODE> struct OpLora {
    bf16_t* O; const float* p0;
    __device__ __forceinline__ float f(float x) const { const float s = sigm(x); return MODE == 0 ? 1.f - __expf(-0.60653065971f * s) : s; }
    __device__ __forceinline__ void operator()(const f32x4 a0, const f32x4 a1, const f32x4 b0, const f32x4 b1, int row, int pn, int wc, int fq) const {
        const int col = pn * 256 + wc * 32 + 8 * fq; const float* bp = p0 + col; bf16_t* dst = O + (size_t)row * D + col; float o[8];
        { const f32x4 c0 = *(const f32x4*)bp, c1 = *(const f32x4*)(bp + 4);
#pragma unroll
          for (int i = 0; i < 4; ++i) { o[i] = f(a0[i] + c0[i]); o[4 + i] = f(a1[i] + c1[i]); }
          *(u32x4*)dst = pack8(o); }
        { const f32x4 c0 = *(const f32x4*)(bp + 128), c1 = *(const f32x4*)(bp + 132);
#pragma unroll
          for (int i = 0; i < 4; ++i) { o[i] = f(b0[i] + c0[i]); o[4 + i] = f(b1[i] + c1[i]); }
          *(u32x4*)(dst + 128) = pack8(o); }
    }
};
struct OpMerge {
    const bf16_t* ga; const bf16_t* ya; const bf16_t* gr; bf16_t* out;
    __device__ __forceinline__ void half(const f32x4 a0, const f32x4 a1, size_t off) const {
        float A[8], Y[8], R[8], o[8]; unpack8(*(const u32x4*)(ga + off), A); unpack8(*(const u32x4*)(ya + off), Y); unpack8(*(const u32x4*)(gr + off), R);
#pragma unroll
        for (int i = 0; i < 4; ++i) { o[i] = A[i] * Y[i] + R[i] * a0[i]; o[4 + i] = A[4 + i] * Y[4 + i] + R[4 + i] * a1[i]; }
        *(u32x4*)(out + off) = pack8(o);
    }
    __device__ __forceinline__ void operator()(const f32x4 a0, const f32x4 a1, const f32x4 b0, const f32x4 b1, int row, int pn, int wc, int fq) const {
        const size_t off = (size_t)row * D + pn * 256 + wc * 32 + 8 * fq;
        half(a0, a1, off); half(b0, b1, off + 128);
    }
};

struct Args {
    const float* in[27]; float* out; unsigned char* ws; int ph_lo, ph_hi;
};
enum { I_X = 0, I_F1N, I_F1G, I_F1U, I_F1D, I_MN, I_WIN, I_GB, I_AUP, I_MU, I_W0, I_W2, I_A0, I_A2, I_G2, I_KK, I_KA, I_RK, I_LNW, I_LNB, I_WOUT, I_WO, I_F2N, I_F2G, I_F2U, I_F2D, I_FN };

__device__ __forceinline__ void tr_job(const float* W0, const float* W1, int ldw, int Ksrc, bf16_t* WT, int ldt, int nrows, int mode, int coff, int climit,
                                       float* scr, int gw, int NGW, int lane) {
    const int nblk = nrows / 64, nitems = (ldt / 64) * nblk;
    for (int it = gw; it < nitems; it += NGW) {
        const int kb = it / nblk, nb = it % nblk, k0 = 64 * kb;
        const float* Wh[2]; int ch[2]; bool vh[2];
#pragma unroll
        for (int hh = 0; hh < 2; ++hh) {
            const int nb32 = 2 * nb + hh;
            if (mode == 0) { ch[hh] = coff + 32 * nb32; vh[hh] = ch[hh] < climit; Wh[hh] = W0; }
            else { const int tile = nb32 >> 3, j0 = (nb32 & 7) * 32; Wh[hh] = j0 < 128 ? W0 : W1; ch[hh] = tile * 128 + (j0 & 127); vh[hh] = true; }
        }
        const int r4 = lane >> 4, pc = lane & 15, hsel = pc >> 3;
        const float* Wsel = hsel ? Wh[1] : Wh[0]; const int csel = (hsel ? ch[1] : ch[0]) + (pc & 7) * 4; const bool vsel = hsel ? vh[1] : vh[0];
        f32x4 v[16];
#pragma unroll
        for (int i = 0; i < 16; ++i) { const int k = k0 + 4 * i + r4; v[i] = (vsel && k < Ksrc) ? *(const f32x4*)(Wsel + (size_t)k * ldw + csel) : (f32x4){0.f, 0.f, 0.f, 0.f}; }
#pragma unroll
        for (int i = 0; i < 16; ++i) { float* d = scr + (4 * i + r4) * 65 + pc * 4; d[0] = v[i].x; d[1] = v[i].y; d[2] = v[i].z; d[3] = v[i].w; }
        __builtin_amdgcn_s_waitcnt(0); asm volatile("" ::: "memory");
        const int c = lane & 7;
#pragma unroll
        for (int j = 0; j < 8; ++j) { const int n = (lane >> 3) + 8 * j; const float* sp = scr + (8 * c) * 65 + n;
            u32x4 o; o.x = pk2(sp[0 * 65], sp[1 * 65]); o.y = pk2(sp[2 * 65], sp[3 * 65]); o.z = pk2(sp[4 * 65], sp[5 * 65]); o.w = pk2(sp[6 * 65], sp[7 * 65]);
            *(u32x4*)(WT + (size_t)(64 * nb + n) * ldt + k0 + 8 * c) = o; }
        __builtin_amdgcn_s_waitcnt(0); asm volatile("" ::: "memory");
    }
}
__device__ __forceinline__ void norm_row(const float* xrow, const bf16_t* drow, const float* gain, bf16_t* orow, float* frow, int lane) {
    f32x4 v[4]; float s = 0.f;
#pragma unroll
    for (int j = 0; j < 4; ++j) {
        v[j] = *((const f32x4*)xrow + lane + 64 * j);
        if (drow) { const u32x2 w = *((const u32x2*)drow + lane + 64 * j); v[j] += (f32x4){bflo(w.x), bfhi(w.x), bflo(w.y), bfhi(w.y)}; }
        s += (v[j].x * v[j].x + v[j].y * v[j].y) + (v[j].z * v[j].z + v[j].w * v[j].w);
    }
    const float inv = rsqrtf(wave_sum(s) * (1.f / D) + NORM_EPS);
#pragma unroll
    for (int j = 0; j < 4; ++j) {
        const f32x4 gn = *((const f32x4*)gain + lane + 64 * j); const f32x4 o = v[j] * inv * gn;
        if (orow) { u32x2 w; w.x = pk2(o.x, o.y); w.y = pk2(o.z, o.w); *((u32x2*)orow + lane + 64 * j) = w; }
        else *((f32x4*)frow + lane + 64 * j) = o;
    }
}

struct AttnUnit { int b, h, g, hg, d, r, i; };
__device__ __forceinline__ AttnUnit attn_decode(int u) {
    AttnUnit a; const int rb = u & 63, bh = u >> 6; a.h = bh % 12; a.b = bh / 12; a.g = a.h >> 2; a.hg = a.h & 3;
    const int dsh = 2 * a.g, nb = 64 >> dsh; a.d = 1 << dsh; a.r = rb / nb; a.i = rb % nb; return a;
}
__device__ __forceinline__ void attn_phase(unsigned char* lds, const bf16_t* Q, const bf16_t* K, const bf16_t* V, bf16_t* Og, float* lse, int G, int bid, const int wv) {
    bf16_t* Ks = (bf16_t*)lds;
    bf16_t* Vt = (bf16_t*)(lds + 36864);
    int tid_ = KTID(wv);
    const int tid = tid_, w = tid >> 6, lane = tid & 63, fr = lane & 15, fq = lane >> 4;
    constexpr int NU = ATT_REP * BATCH * 12 * 64;
    u32x4 kreg[4], vreg[4];
#define ATT_LOADKV(uu) do { const AttnUnit n_ = attn_decode((uu) % (BATCH * 12 * 64)); const size_t br_ = (size_t)n_.b * SEQ; \
        _Pragma("unroll") for (int c_ = 0; c_ < 4; ++c_) { const int p_ = tid + 512 * c_; \
            { const int key_ = p_ >> 3, seg_ = p_ & 7, l_ = 128 * (n_.i - 1) + key_; kreg[c_] = (u32x4){0u, 0u, 0u, 0u}; \
              if (l_ >= 0) kreg[c_] = *(const u32x4*)(K + (br_ + (size_t)l_ * n_.d + n_.r) * AW + n_.h * 64 + seg_ * 8); } \
            { const int seg_ = p_ >> 8, key_ = p_ & 255, l_ = 128 * (n_.i - 1) + key_; vreg[c_] = (u32x4){0u, 0u, 0u, 0u}; \
              if (l_ >= 0) vreg[c_] = *(const u32x4*)(V + (br_ + (size_t)l_ * n_.d + n_.r) * AW + n_.h * 64 + seg_ * 8); } } } while (0)
    if (bid < NU) ATT_LOADKV(bid);
    for (int u_ = bid; u_ < NU; u_ += G) {
        const AttnUnit U = attn_decode(u_ % (BATCH * 12 * 64));
        const int h = U.h, g = U.g, hg = U.hg, d = U.d, r = U.r, i = U.i;
        const size_t brow = (size_t)U.b * SEQ;
        __syncthreads();
#pragma unroll
        for (int c = 0; c < 4; ++c) {
            const int p = tid + 512 * c;
            *(u32x4*)(Ks + (p >> 3) * 72 + (p & 7) * 8) = kreg[c];
            const u32x4 val = vreg[c];
            bf16_t* vp = Vt + ((p >> 8) * 8) * 264 + (p & 255);
            vp[0 * 264] = (bf16_t)(val.x & 0xffffu); vp[1 * 264] = (bf16_t)(val.x >> 16); vp[2 * 264] = (bf16_t)(val.y & 0xffffu); vp[3 * 264] = (bf16_t)(val.y >> 16);
            vp[4 * 264] = (bf16_t)(val.z & 0xffffu); vp[5 * 264] = (bf16_t)(val.z >> 16); vp[6 * 264] = (bf16_t)(val.w & 0xffffu); vp[7 * 264] = (bf16_t)(val.w >> 16);
        }
        const size_t rowq = brow + (size_t)(128 * i + 16 * w + fr) * d + r;
        bf16x8 qf[2];
#pragma unroll
        for (int ks = 0; ks < 2; ++ks) qf[ks] = *(const bf16x8*)(Q + rowq * AW + h * 64 + ks * 32 + fq * 8);
        if (u_ + G < NU) ATT_LOADKV(u_ + G);
        __syncthreads();
        f32x4 s[10];
#pragma unroll
        for (int tt = 0; tt < 10; ++tt) {
            const int T = w + tt, Tc = T < 16 ? T : 15;
            const bf16x8 k0 = *(const bf16x8*)(Ks + (16 * Tc + fr) * 72 + fq * 8), k1 = *(const bf16x8*)(Ks + (16 * Tc + fr) * 72 + 32 + fq * 8);
            f32x4 a = (f32x4){0.f, 0.f, 0.f, 0.f};
            a = __builtin_amdgcn_mfma_f32_16x16x32_bf16(k0, qf[0], a, 0, 0, 0);
            a = __builtin_amdgcn_mfma_f32_16x16x32_bf16(k1, qf[1], a, 0, 0, 0);
            s[tt] = a;
        }
        const int qi = 16 * w + fr; float mx = -INFINITY;
#pragma unroll
        for (int tt = 0; tt < 10; ++tt)
#pragma unroll
            for (int e = 0; e < 4; ++e) {
                const int ki = 16 * (w + tt) + 4 * fq + e;
                const bool valid = (ki >= qi) && (ki <= qi + 128) && (ki < 256) && (i > 0 || ki >= 128);
                s[tt][e] = valid ? s[tt][e] : -INFINITY; mx = fmaxf(mx, s[tt][e]);
            }
        mx = fmaxf(mx, __shfl_xor(mx, 16)); mx = fmaxf(mx, __shfl_xor(mx, 32));
        float l = 0.f;
#pragma unroll
        for (int tt = 0; tt < 10; ++tt)
#pragma unroll
            for (int e = 0; e < 4; ++e) { const float p = __expf(s[tt][e] - mx); s[tt][e] = p; l += p; }
        l += __shfl_xor(l, 16); l += __shfl_xor(l, 32);
        f32x4 o[4];
#pragma unroll
        for (int dt = 0; dt < 4; ++dt) o[dt] = (f32x4){0.f, 0.f, 0.f, 0.f};
#pragma unroll
        for (int s2 = 0; s2 < 5; ++s2) {
            const int T0 = w + 2 * s2, T1 = T0 + 1, T0c = T0 < 16 ? T0 : 15, T1c = T1 < 16 ? T1 : 15;
            union { bf16x8 v; unsigned u[4]; } pf;
            pf.u[0] = pk2(s[2 * s2][0], s[2 * s2][1]); pf.u[1] = pk2(s[2 * s2][2], s[2 * s2][3]);
            pf.u[2] = pk2(s[2 * s2 + 1][0], s[2 * s2 + 1][1]); pf.u[3] = pk2(s[2 * s2 + 1][2], s[2 * s2 + 1][3]);
#pragma unroll
            for (int dt = 0; dt < 4; ++dt) {
                union { bf16x8 v; u32x2 h[2]; } vf;
                vf.h[0] = *(const u32x2*)(Vt + (16 * dt + fr) * 264 + 16 * T0c + 4 * fq);
                vf.h[1] = *(const u32x2*)(Vt + (16 * dt + fr) * 264 + 16 * T1c + 4 * fq);
                o[dt] = __builtin_amdgcn_mfma_f32_16x16x32_bf16(vf.v, pf.v, o[dt], 0, 0, 0);
            }
        }
        const float il = 1.f / l;
        bf16_t* op = Og + ((size_t)g * M + rowq) * 256 + hg * 64 + 4 * fq;
#pragma unroll
        for (int dt = 0; dt < 4; ++dt) { u32x2 wv; wv.x = pk2(o[dt][0] * il, o[dt][1] * il); wv.y = pk2(o[dt][2] * il, o[dt][3] * il); *(u32x2*)(op + 16 * dt) = wv; }
        if (fq == 0) lse[((size_t)g * M + rowq) * 4 + hg] = mx + __logf(l);
    }
    __syncthreads();
}

template <int CTRL> __device__ __forceinline__ float dpp_f(float x) { return __builtin_bit_cast(float, __builtin_amdgcn_update_dpp(0, __builtin_bit_cast(int, x), CTRL, 0xf, 0xf, true)); }
__device__ __forceinline__ float row16_sum(float x) { x += dpp_f<0x128>(x); x += dpp_f<0x124>(x); x += dpp_f<0x122>(x); x += dpp_f<0x121>(x); return x; }
constexpr int TC = 32;
constexpr int SC_BUF = TC * 5 * 64 * 4;
constexpr int SC_V = TC * 32 * 4;
typedef float f32x2 __attribute__((ext_vector_type(2)));
struct ScanOps { f32x4 a0, a1, q0, q1, w0, w1, b0, b1, k0, k1; f32x2 bk; float v; };
__device__ __forceinline__ void scan_phase(unsigned char* lds, const bf16_t* Rz, const bf16_t* Wm, const bf16_t* Kz, const bf16_t* Vz, const bf16_t* Aa, const float* mu, const float* pkk, const float* pka, const float* prk, float* BCo, bf16_t* Y, int G, int bid, const int wv) {
    int tid_ = KTID(wv);
    const int tid = tid_, w = __builtin_amdgcn_readfirstlane(tid >> 6), lane = tid & 63, kq = lane & 15, rw = lane >> 4;
    float* const kb0 = (float*)lds; float* const vb0 = (float*)(lds + 2 * SC_BUF); float* const yb0 = (float*)(lds + 2 * SC_BUF + 2 * SC_V);
    float* const bb0 = (float*)(lds + 2 * SC_BUF + 4 * SC_V);
#define KB(bi) (kb0 + (bi) * (SC_BUF / 4))
#define VB(bi) (vb0 + (bi) * (SC_V / 4))
#define YB(bi) (yb0 + (bi) * (SC_V / 4))
#define BB(bi) (bb0 + (bi) * (TC * 2))
    constexpr int NCH = SEQ / TC;
    for (int u = bid; u < BATCH * 16 * 2; u += G) {
        const int half = u & 1, h = (u >> 1) & 15, b = u >> 5;
        const size_t row0 = (size_t)b * SEQ;
        __syncthreads();
        if (w >= 4) {
            const int ht = tid - 256, st = ht >> 3, sg = ht & 7;
            const size_t goff = (row0 + st) * D + h * 64 + sg * 8;
            const int lo = st * 320 + sg * 8;
            const bool hv = ht < 128;
            const size_t voff = (row0 + (ht >> 2)) * D + h * 64 + half * 32 + (ht & 3) * 8; const int lov = (ht >> 2) * 32 + (ht & 3) * 8;
            bf16_t* yo = Y + voff;
            float mur[8], muk[8], muv[8], kkp[8], kap[8], rkp[8];
#pragma unroll
            for (int i = 0; i < 8; ++i) { const int cc = h * 64 + sg * 8 + i; mur[i] = mu[cc]; muk[i] = mu[1024 + cc]; kkp[i] = pkk[cc]; kap[i] = pka[cc]; rkp[i] = prk[cc];
                muv[i] = mu[2048 + h * 64 + half * 32 + (ht & 3) * 8 + i]; }
            struct HReg { u32x4 rc, rp, kc, kp, om, aa, vc, vp; };
            HReg P, Q; P.vc = (u32x4){0u, 0u, 0u, 0u}; P.vp = P.vc; Q.vc = P.vc; Q.vp = P.vc;
            const u32x4 z4 = (u32x4){0u, 0u, 0u, 0u};
#define SC_ISSUE(X, c) do { const size_t o_ = (size_t)(c) * TC * D; const bool first_ = ((c) == 0 && st == 0); \
                X.rc = *(const u32x4*)(Rz + goff + o_); X.kc = *(const u32x4*)(Kz + goff + o_); X.om = *(const u32x4*)(Wm + goff + o_); X.aa = *(const u32x4*)(Aa + goff + o_); \
                X.rp = first_ ? z4 : *(const u32x4*)(Rz + goff + o_ - D); X.kp = first_ ? z4 : *(const u32x4*)(Kz + goff + o_ - D); \
                if (hv) { X.vc = *(const u32x4*)(Vz + voff + o_); X.vp = ((c) == 0 && ht < 4) ? z4 : *(const u32x4*)(Vz + voff + o_ - D); } } while (0)
#define SC_ST8(dst, f) do { *(f32x4*)(dst) = (f32x4){f[0], f[1], f[2], f[3]}; *(f32x4*)((dst) + 4) = (f32x4){f[4], f[5], f[6], f[7]}; } while (0)
#define SC_COMMIT(X, bi, c) do { float rc_[8], rp_[8], kc_[8], kp_[8], om_[8], av_[8]; float* kb_ = KB(bi) + lo; \
                unpack8(X.rc, rc_); unpack8(X.rp, rp_); unpack8(X.kc, kc_); unpack8(X.kp, kp_); unpack8(X.om, om_); unpack8(X.aa, av_); \
                float kk_[8], ko_[8], bo_[8], wr_[8]; float ss_ = 0.f, bs_ = 0.f, sbr_ = 0.f, skr_ = 0.f; \
                _Pragma("unroll") for (int i_ = 0; i_ < 8; ++i_) { const float r_ = rc_[i_] + (rp_[i_] - rc_[i_]) * mur[i_]; const float kz_ = kc_[i_] + (kp_[i_] - kc_[i_]) * muk[i_]; \
                    kk_[i_] = kz_ * kkp[i_]; ss_ += kk_[i_] * kk_[i_]; ko_[i_] = kz_ * (1.f + (av_[i_] - 1.f) * kap[i_]); bs_ += r_ * ko_[i_] * rkp[i_]; skr_ += ko_[i_] * r_; \
                    om_[i_] = 1.f - om_[i_]; wr_[i_] = om_[i_] * r_; rc_[i_] = r_; } \
                ss_ += __shfl_xor(ss_, 1); ss_ += __shfl_xor(ss_, 2); ss_ += __shfl_xor(ss_, 4); \
                const float inv_ = 1.f / fmaxf(sqrtf(ss_), 1e-12f); \
                _Pragma("unroll") for (int i_ = 0; i_ < 8; ++i_) { const float k2_ = kk_[i_] * inv_; bo_[i_] = k2_ * av_[i_]; sbr_ += bo_[i_] * rc_[i_]; kk_[i_] = -k2_; } \
                bs_ += __shfl_xor(bs_, 1); bs_ += __shfl_xor(bs_, 2); bs_ += __shfl_xor(bs_, 4); \
                sbr_ += __shfl_xor(sbr_, 1); sbr_ += __shfl_xor(sbr_, 2); sbr_ += __shfl_xor(sbr_, 4); \
                skr_ += __shfl_xor(skr_, 1); skr_ += __shfl_xor(skr_, 2); skr_ += __shfl_xor(skr_, 4); \
                SC_ST8(kb_, kk_); SC_ST8(kb_ + 64, wr_); SC_ST8(kb_ + 128, om_); SC_ST8(kb_ + 192, bo_); SC_ST8(kb_ + 256, ko_); \
                if (sg == 0) { *(f32x2*)(BB(bi) + st * 2) = (f32x2){sbr_, skr_}; if (half == 0) BCo[(row0 + (size_t)(c) * TC + st) * 16 + h] = bs_; } \
                if (hv) { float vc_[8], vp_[8]; unpack8(X.vc, vc_); unpack8(X.vp, vp_); _Pragma("unroll") for (int i_ = 0; i_ < 8; ++i_) vc_[i_] += (vp_[i_] - vc_[i_]) * muv[i_]; float* d_ = VB(bi) + lov; SC_ST8(d_, vc_); } } while (0)
#define SC_YOUT(c) do { if (hv) { const float* yp_ = YB((c) & 1) + lov; const f32x4 y0_ = *(const f32x4*)yp_, y1_ = *(const f32x4*)(yp_ + 4); \
                u32x4 o_; o_.x = pk2(y0_.x, y0_.y); o_.y = pk2(y0_.z, y0_.w); o_.z = pk2(y1_.x, y1_.y); o_.w = pk2(y1_.z, y1_.w); *(u32x4*)(yo + (size_t)(c) * TC * D) = o_; } } while (0)
            SC_ISSUE(P, 0); SC_ISSUE(Q, 1); SC_COMMIT(P, 0, 0);
            __syncthreads();
            for (int c = 0; c < NCH; c += 2) {
                if (c + 2 < NCH) SC_ISSUE(P, c + 2);
                if (c > 0) SC_YOUT(c - 1);
                SC_COMMIT(Q, 1, c + 1);
                __syncthreads();
                if (c + 3 < NCH) SC_ISSUE(Q, c + 3);
                SC_YOUT(c);
                if (c + 2 < NCH) SC_COMMIT(P, 0, c + 2);
                __syncthreads();
            }
            SC_YOUT(NCH - 1);
        } else {
            const int kq8 = lane & 7, rowA = w * 8 + (lane >> 3);
            __syncthreads();
            f32x2 S0 = (f32x2){0.f, 0.f}, S1 = S0, S2 = S0, S3 = S0;
            for (int c = 0; c < NCH; ++c) {
                const int bi = c & 1;
                const float* kbp = KB(bi) + kq8 * 8; const float* vbp = VB(bi) + rowA; const float* bbp = BB(bi); float* ybp = YB(bi) + rowA;
#define SC_LOAD(dst, t) do { const float* q_ = kbp + (t) * 320; dst.a0 = *(const f32x4*)q_; dst.a1 = *(const f32x4*)(q_ + 4); dst.q0 = *(const f32x4*)(q_ + 64); dst.q1 = *(const f32x4*)(q_ + 68); \
                dst.w0 = *(const f32x4*)(q_ + 128); dst.w1 = *(const f32x4*)(q_ + 132); dst.b0 = *(const f32x4*)(q_ + 192); dst.b1 = *(const f32x4*)(q_ + 196); dst.k0 = *(const f32x4*)(q_ + 256); dst.k1 = *(const f32x4*)(q_ + 260); \
                dst.v = vbp[(t) * 32]; dst.bk = *(const f32x2*)(bbp + (t) * 2); } while (0)
#define LO2(V_) ((f32x2){(V_).x, (V_).y})
#define HI2(V_) ((f32x2){(V_).z, (V_).w})
                ScanOps o0, o1, o2; SC_LOAD(o0, 0); SC_LOAD(o1, 1);
                float yr = 0.f;
#pragma unroll
                for (int t = 0; t < TC; ++t) {
                    if (t + 2 < TC) SC_LOAD(o2, t + 2);
                    f32x2 pa = S0 * LO2(o0.a0), py = S0 * LO2(o0.q0);
                    pa = __builtin_elementwise_fma(S1, HI2(o0.a0), pa); py = __builtin_elementwise_fma(S1, HI2(o0.q0), py);
                    pa = __builtin_elementwise_fma(S2, LO2(o0.a1), pa); py = __builtin_elementwise_fma(S2, LO2(o0.q1), py);
                    pa = __builtin_elementwise_fma(S3, HI2(o0.a1), pa); py = __builtin_elementwise_fma(S3, HI2(o0.q1), py);
                    float sa = pa.x + pa.y, ys = py.x + py.y;
                    sa += dpp_f<0x141>(sa); ys += dpp_f<0x141>(ys);
                    sa += dpp_f<0xB1>(sa); ys += dpp_f<0xB1>(ys);
                    sa += dpp_f<0x4E>(sa); ys += dpp_f<0x4E>(ys);
                    const f32x2 sa2 = (f32x2){sa, sa}, v2 = (f32x2){o0.v, o0.v};
                    f32x2 t0 = LO2(o0.k0) * v2, t1 = HI2(o0.k0) * v2, t2 = LO2(o0.k1) * v2, t3 = HI2(o0.k1) * v2;
                    t0 = __builtin_elementwise_fma(LO2(o0.b0), sa2, t0); t1 = __builtin_elementwise_fma(HI2(o0.b0), sa2, t1);
                    t2 = __builtin_elementwise_fma(LO2(o0.b1), sa2, t2); t3 = __builtin_elementwise_fma(HI2(o0.b1), sa2, t3);
                    S0 = __builtin_elementwise_fma(S0, LO2(o0.w0), t0); S1 = __builtin_elementwise_fma(S1, HI2(o0.w0), t1);
                    S2 = __builtin_elementwise_fma(S2, LO2(o0.w1), t2); S3 = __builtin_elementwise_fma(S3, HI2(o0.w1), t3);
                    const float y = ys + sa * o0.bk.x + o0.v * o0.bk.y;
                    yr = (kq8 == (t & 7)) ? y : yr;
                    if ((t & 7) == 7) ybp[(t - 7 + kq8) * 32] = yr;
                    o0 = o1; o1 = o2;
                }
                __syncthreads();
            }
        }
    }
    __syncthreads();
}

#define RLX_AGENT __ATOMIC_RELAXED, __HIP_MEMORY_SCOPE_AGENT
#define XB_TMO      128
#define XB_XCNT(j)  (256  + 64 * (j))
#define XB_XSUB(j)  (1280 + 64 * (j))
#define XB_XGEN(j)  (2304 + 64 * (j))
#define XB_TOP      3328
#define XB_TOPGEN   3392
#define XCD_BAR_WORDS 3456
#define XB_SPIN_CAP (1u << 18)

__device__ __forceinline__ unsigned xb_ld(unsigned* p)              { return __hip_atomic_load(p, __ATOMIC_RELAXED, __HIP_MEMORY_SCOPE_AGENT); }
__device__ __forceinline__ unsigned xb_add(unsigned* p, unsigned v) { return __hip_atomic_fetch_add(p, v, __ATOMIC_RELAXED, __HIP_MEMORY_SCOPE_AGENT); }
__device__ __forceinline__ unsigned xb_xcc_id() { return (unsigned)__builtin_amdgcn_s_getreg((3 << 11) | 20) & 0xFu; }
#define XB_SPIN(cond, bar) do { unsigned _sp = 0; while (cond) { __builtin_amdgcn_s_sleep(1); \
    if ((++_sp & 255u) == 0u) { if (xb_ld(&(bar)[XB_TMO])) break; if (_sp > XB_SPIN_CAP) { atomicAdd(&(bar)[XB_TMO], 1u); break; } } } } while (0)

struct XcdBarrier {
    unsigned* bar; unsigned x;
    volatile LAS unsigned* st;
};

__device__ __forceinline__ XcdBarrier xcd_barrier_post(unsigned* bar, volatile LAS unsigned* st) {
    XcdBarrier b; b.bar = bar; b.x = xb_xcc_id(); b.st = st;
    if (threadIdx.x == 0) (void)xb_add(&bar[XB_XCNT(b.x)], 1u);
    return b;
}
__device__ __forceinline__ void xcd_barrier_complete(unsigned* bar, unsigned x, unsigned& nloc, unsigned& nx) {
    const unsigned G = gridDim.x * gridDim.y * gridDim.z;
    unsigned sum, cnt, mine, sp = 0u;
    for (;;) {
        sum = 0u; cnt = 0u; mine = 0u;
#pragma unroll
        for (unsigned j = 0; j < 16; ++j) { const unsigned c = xb_ld(&bar[XB_XCNT(j)]); sum += c; cnt += (c > 0u) ? 1u : 0u; mine = (j == x) ? c : mine; }
        if (sum == G) break;
        __builtin_amdgcn_s_sleep(1);
        if ((++sp & 255u) == 0u) { if (xb_ld(&bar[XB_TMO])) break; if (sp > XB_SPIN_CAP) { atomicAdd(&bar[XB_TMO], 1u); break; } }
    }
    nloc = mine > 0u ? mine : 1u; nx = cnt > 0u ? cnt : 1u;
}

__device__ __forceinline__ void xcd_barrier(const XcdBarrier& b, const int wv) {
    asm volatile("s_waitcnt vmcnt(0)" ::: "memory");
    __syncthreads();
    if (KTID(wv) == 0) {
        unsigned* bar = b.bar;
        __builtin_amdgcn_s_waitcnt(0);
        unsigned nloc = b.st[0], nx = b.st[1];
        if (nloc == 0u) { xcd_barrier_complete(bar, b.x, nloc, nx); b.st[0] = nloc; b.st[1] = nx; }
        const unsigned old = xb_add(&bar[XB_XSUB(b.x)], 1u);
        const unsigned gen = old / nloc;
        if (old + 1u == (gen + 1u) * nloc) {
            __builtin_amdgcn_fence(__ATOMIC_RELEASE, "agent");
            asm volatile("s_waitcnt vmcnt(0)" ::: "memory");
            const unsigned og = xb_add(&bar[XB_TOP], 1u);
            const unsigned tg = og / nx;
            if (og + 1u == (tg + 1u) * nx) xb_add(&bar[XB_TOPGEN], 1u);
            else XB_SPIN(xb_ld(&bar[XB_TOPGEN]) == tg, bar);
            __builtin_amdgcn_fence(__ATOMIC_ACQUIRE, "agent");
            xb_add(&bar[XB_XGEN(b.x)], 1u);
            asm volatile("s_waitcnt vmcnt(0)" ::: "memory");
        } else {
            XB_SPIN(xb_ld(&bar[XB_XGEN(b.x)]) == gen, bar);
            __builtin_amdgcn_fence(__ATOMIC_ACQUIRE, "agent");
            asm volatile("s_waitcnt vmcnt(0)" ::: "memory");
        }
    }
    __syncthreads();
}


__global__ void __launch_bounds__(NT, 2) mk_fwd(Args args) {
    extern __shared__ __attribute__((aligned(16))) unsigned char lds[];
    const int wv = __builtin_amdgcn_readfirstlane((int)threadIdx.x >> 6);
    const int G = gridDim.x, bid = blockIdx.x, NGW = G * NWAVES;
    PG8_LAS unsigned char* glds = (PG8_LAS unsigned char*)lds;
    typedef const __attribute__((address_space(4))) Args* ArgP;
#define PH_ARGS() ArgP ap = (ArgP)__builtin_amdgcn_kernarg_segment_ptr(); asm volatile("" : "+s"(ap)); unsigned char* const ws = ap->ws; (void)ws; \
    const int tid = KTID(wv), lane = tid & 63, wave = wv, gw = bid * NWAVES + wave; (void)lane; (void)gw
#define INP(i) (ap->in[i])
#define WB(off) ((bf16_t*)(ws + (off)))
#define CB(i) ((bf16_t*)(ws + WS_C(i)))
#define D1P ((bf16_t*)ap->out)
#define YSP ((bf16_t*)((unsigned char*)ap->out + CH))
#define X2P ((float*)(ws + WS_C(2)))
#define ATTOP CB(2)
#define OGP YSP
#if MK_MULTI
    const int lo = args.ph_lo, hi = args.ph_hi; int ph = 0;
#define SEAM() do { ++ph; } while (0)
#define SEAM0() SEAM()
#define IN() (lo <= ph && ph < hi)
#else
    cg::grid_group grid = cg::this_grid();
    unsigned* const barw = (unsigned*)args.ws;
    volatile LAS unsigned* const bst = (volatile LAS unsigned*)((LAS unsigned char*)lds + LDS_BYTES - 64);
    { const int t0 = KTID(wv); if (t0 < 2) bst[t0] = 0u; if (bid == 0) for (int i = t0; i < XCD_BAR_WORDS; i += NT) barw[i] = 0u; }
    __syncthreads();
#define XB_MAKE(xb_) XcdBarrier xb_; { ArgP ap_ = (ArgP)__builtin_amdgcn_kernarg_segment_ptr(); asm volatile("" : "+s"(ap_)); xb_.bar = (unsigned*)ap_->ws; xb_.x = xb_xcc_id(); \
        xb_.st = (volatile LAS unsigned*)((LAS unsigned char*)lds + LDS_BYTES - 64); }
#define SEAM0() do { __threadfence(); grid.sync(); XB_MAKE(xb0_); if (KTID(wv) == 0) (void)xb_add(&xb0_.bar[XB_XCNT(xb0_.x)], 1u); } while (0)
#define SEAM() do { XB_MAKE(xb1_); xcd_barrier(xb1_, wv); } while (0)
#define IN() true
#endif
#define PHASE(p) for (int rep_ = 0; IN() && rep_ < 1 + (int)((PROBE_MASK >> (p)) & 1u); ++rep_)

    PHASE(0) {
        PH_ARGS();
        float* scr = (float*)(lds + wave * 16896);
        tr_job(INP(I_F1G), INP(I_F1U), FF, D, WB(WS_WGU1), D, 2 * FF, 1, 0, 0, scr, gw, NGW, lane);
        tr_job(INP(I_F1D), nullptr, D, FF, WB(WS_WD1), FF, D, 0, 0, D, scr, gw, NGW, lane);
        tr_job(INP(I_F2G), INP(I_F2U), FF, D, WB(WS_WGU2), D, 2 * FF, 1, 0, 0, scr, gw, NGW, lane);
        tr_job(INP(I_F2D), nullptr, D, FF, WB(WS_WD2), FF, D, 0, 0, D, scr, gw, NGW, lane);
        tr_job(INP(I_WIN), nullptr, INC, D, WB(WS_WIN), D, 5888, 0, 0, 5664, scr, gw, NGW, lane);
        tr_job(INP(I_WIN), nullptr, INC, D, WB(WS_WIN) + (size_t)5888 * D, D, 2048, 0, 5664, INC, scr, gw, NGW, lane);
        tr_job(INP(I_AUP), nullptr, D, 256, WB(WS_WUP), 256, D, 0, 0, D, scr, gw, NGW, lane);
        tr_job(INP(I_WOUT), nullptr, D, D, WB(WS_WOUT), D, D, 0, 0, D, scr, gw, NGW, lane);
        tr_job(INP(I_WO), nullptr, D, D, WB(WS_WO), D, D, 0, 0, D, scr, gw, NGW, lane);
        tr_job(INP(I_W2), nullptr, D, 64, WB(WS_LW), 128, D, 0, 0, D, scr, gw, NGW, lane);
        tr_job(INP(I_A2), nullptr, D, 64, WB(WS_LA2), 128, D, 0, 0, D, scr, gw, NGW, lane);
        tr_job(INP(I_G2), nullptr, D, 160, WB(WS_LG), 256, D, 0, 0, D, scr, gw, NGW, lane);
        for (int i = bid * NT + tid; i < SEQ * 8; i += G * NT) {
            const int pos = i >> 3, j = i & 7;
            const float invf = powf(500000.0f, -(float)j * 0.125f);
            const float ang = (float)pos * invf;
            double rev = (double)ang * 0.15915494309189535; rev -= rint(rev);
            const float rf = (float)rev;
            ((float*)(ws + WS_ROPE))[pos * 16 + j] = __builtin_amdgcn_cosf(rf); ((float*)(ws + WS_ROPE))[pos * 16 + 8 + j] = __builtin_amdgcn_sinf(rf);
        }
        for (int m = gw; m < M; m += NGW) norm_row(INP(I_X) + (size_t)m * D, nullptr, INP(I_F1N), CB(0) + (size_t)m * D, nullptr, lane);
        for (int i = bid * NT + tid; i < M; i += G * NT) { ((float*)(ws + WS_SS1))[i] = 0.f; ((float*)(ws + WS_SS2))[i] = 0.f; }
    }
    SEAM0();
    PHASE(1) {
        PH_ARGS();
        pg8::Gemm g{CB(0), WB(WS_WGU1), M, 2 * FF, D, D, D}; pg8::StaticOrder S; S.init(M, 2 * FF, G, bid);
        pg8::EpiOp<OpGateUp> E{{CB(1), nullptr}};
        pg8::gemm_phase(glds, g, S, E, wv);
    }
    SEAM();
    PHASE(2) {
        PH_ARGS();
        pg8::Gemm g{CB(1), WB(WS_WD1), M, D, FF, FF, FF}; pg8::StaticOrder S; S.init(M, D, G, bid);
        pg8::EpiOp<OpRes> E{{INP(I_X), nullptr, nullptr, 0.5f, D1P, CB(0), INP(I_MN), ((float*)(ws + WS_SS1))}};
        pg8::gemm_phase(glds, g, S, E, wv);
    }
    SEAM();
    PHASE(4) {
        PH_ARGS();
        { pg8::Gemm g{CB(0), WB(WS_WIN), M, 2304, D, D, D}; pg8::StaticOrder S; S.init(M, 2304, G, bid);
          pg8::EpiOp<OpAttnQKV> E{{CB(1), CB(2), CB(3), ((float*)(ws + WS_ROPE)), ((float*)(ws + WS_SS1))}};
          pg8::gemm_phase(glds, g, S, E, wv); }
        { pg8::Gemm g{CB(0), WB(WS_WIN) + (size_t)2304 * D, M, 3584, D, D, D}; pg8::StaticOrder S; S.init(M, 3584, G, bid);
          pg8::EpiOp<OpRwkvZ> E{{CB(4), CB(5), CB(6), WB(WS_LA), ((float*)(ws + WS_SS1)), WB(WS_HALOLA)}};
          pg8::gemm_phase(glds, g, S, E, wv); }
    }
    SEAM();
    PHASE(5) {
        PH_ARGS(); attn_phase(lds, CB(1), CB(2), CB(3), OGP, (float*)(ws + WS_LSE), G, bid, wv);
        const float* mu = INP(I_MU) + 3072;
        for (int grp = gw; grp < M / 32; grp += NGW) {
            if (lane < 48) {
                const int c0 = lane * 8; bf16_t* base = WB(WS_LA) + (size_t)grp * 32 * LAW + c0;
                if (lane >= 36) { for (int rr = 0; rr < 32; ++rr) *(u32x4*)(base + (size_t)rr * LAW) = (u32x4){0u, 0u, 0u, 0u}; }
                else {
                    float mv[8];
#pragma unroll
                    for (int i = 0; i < 8; ++i) mv[i] = mu[c0 + i];
                    float prev[8];
                    if ((grp & 255) == 0) {
#pragma unroll
                        for (int i = 0; i < 8; ++i) prev[i] = 0.f; }
                    else unpack8(*(const u32x4*)(WB(WS_HALOLA) + (size_t)(grp - 1) * LAW + c0), prev);
                    for (int r8 = 0; r8 < 32; r8 += 8) {
                        u32x4 raw[8];
#pragma unroll
                        for (int j = 0; j < 8; ++j) raw[j] = *(const u32x4*)(base + (size_t)(r8 + j) * LAW);
#pragma unroll
                        for (int j = 0; j < 8; ++j) {
                            float cur[8], o[8]; unpack8(raw[j], cur);
#pragma unroll
                            for (int i = 0; i < 8; ++i) { const float z = cur[i] + (prev[i] - cur[i]) * mv[i];
                                o[i] = c0 < 64 ? (1.f - 2.f * __builtin_amdgcn_rcpf(1.f + __expf(2.f * z))) : (c0 < 128 ? z : sigm(z)); prev[i] = cur[i]; }
                            *(u32x4*)(base + (size_t)(r8 + j) * LAW) = pack8(o);
                        }
                    }
                }
            }
        }
    }
    SEAM();
    PHASE(7) {
        PH_ARGS();
        for (int it = gw; it < M / 2; it += NGW) {
            const int row = it * 2 + (lane >> 5), pc = lane & 31, hg = pc >> 3;
            const float l0 = ((float*)(ws + WS_LSE))[((size_t)0 * M + row) * 4 + hg], l1 = ((float*)(ws + WS_LSE))[((size_t)1 * M + row) * 4 + hg], l2 = ((float*)(ws + WS_LSE))[((size_t)2 * M + row) * 4 + hg];
            const float mx = fmaxf(l0, fmaxf(l1, l2)); float w0 = __expf(l0 - mx), w1 = __expf(l1 - mx), w2 = __expf(l2 - mx);
            const float iw = 1.f / (w0 + w1 + w2); w0 *= iw; w1 *= iw; w2 *= iw;
            float a[8], bb[8], c[8], o[8];
            unpack8(*(const u32x4*)(OGP + ((size_t)0 * M + row) * 256 + pc * 8), a); unpack8(*(const u32x4*)(OGP + ((size_t)1 * M + row) * 256 + pc * 8), bb);
            unpack8(*(const u32x4*)(OGP + ((size_t)2 * M + row) * 256 + pc * 8), c);
#pragma unroll
            for (int i = 0; i < 8; ++i) o[i] = w0 * a[i] + w1 * bb[i] + w2 * c[i];
            *(u32x4*)(ATTOP + (size_t)row * 256 + pc * 8) = pack8(o);
        }
        { pg8::Gemm g{WB(WS_LA), WB(WS_LW), M, D, 128, LAW, 128}; pg8::StaticOrder S; S.init(M, D, G, bid);
          pg8::EpiOp<OpLora<0>> E{{CB(1), INP(I_W0)}};
          pg8::gemm_phase(glds, g, S, E, wv); }
        { pg8::Gemm g{WB(WS_LA) + 64, WB(WS_LA2), M, D, 128, LAW, 128}; pg8::StaticOrder S; S.init(M, D, G, bid);
          pg8::EpiOp<OpLora<1>> E{{CB(3), INP(I_A0)}};
          pg8::gemm_phase(glds, g, S, E, wv); }
    }
    SEAM();
    PHASE(9) { PH_ARGS(); scan_phase(lds, CB(4), CB(1), CB(5), CB(6), CB(3), INP(I_MU), INP(I_KK), INP(I_KA), INP(I_RK), (float*)(ws + WS_BC), YSP, G, bid, wv); }
    SEAM();
    PHASE(10) {
        PH_ARGS();
        { pg8::Gemm g{WB(WS_LA) + 128, WB(WS_LG), M, D, 256, LAW, 256}; pg8::StaticOrder S; S.init(M, D, G, bid);
          pg8::EpiOp<OpStoreBf16> E{{CB(1), D, 1.0f}};
          pg8::gemm_phase(glds, g, S, E, wv); }
    }
    SEAM();
    PHASE(11) {
        PH_ARGS();
        const int r8 = lane >> 3, seg = lane & 7;
        for (int it = gw; it < (M / 8) * 16; it += NGW) {
            const int h = it & 15; const size_t row = (size_t)(it >> 4) * 8 + r8; const int c0 = h * 64 + seg * 8; const size_t off = row * D + c0;
            float yv[8], vv[8], gv[8], o[8];
            unpack8(*(const u32x4*)(YSP + off), yv); unpack8(*(const u32x4*)(CB(6) + off), vv); unpack8(*(const u32x4*)(CB(1) + off), gv);
            { float vp[8]; const u32x4 z4 = (u32x4){0u, 0u, 0u, 0u}; unpack8((row & (SEQ - 1)) == 0 ? z4 : *(const u32x4*)(CB(6) + off - D), vp);
#pragma unroll
              for (int i = 0; i < 8; ++i) vv[i] += (vp[i] - vv[i]) * INP(I_MU)[2048 + c0 + i]; }
            const float bc = ((float*)(ws + WS_BC))[row * 16 + h];
            float s = 0.f;
#pragma unroll
            for (int i = 0; i < 8; ++i) s += yv[i];
            s += __shfl_xor(s, 1); s += __shfl_xor(s, 2); s += __shfl_xor(s, 4);
            const float mean = s * (1.f / 64.f); float q = 0.f;
#pragma unroll
            for (int i = 0; i < 8; ++i) { yv[i] -= mean; q += yv[i] * yv[i]; }
            q += __shfl_xor(q, 1); q += __shfl_xor(q, 2); q += __shfl_xor(q, 4);
            const float rstd = rsqrtf(q * (1.f / 64.f) + GN_EPS);
#pragma unroll
            for (int i = 0; i < 8; ++i) o[i] = (yv[i] * rstd * INP(I_LNW)[c0 + i] + INP(I_LNB)[c0 + i] + bc * vv[i]) * gv[i];
            *(u32x4*)(CB(3) + off) = pack8(o);
        }
    }
    SEAM();
    PHASE(12) {
        PH_ARGS();
        { pg8::Gemm g{CB(0), WB(WS_WIN) + (size_t)5888 * D, M, 2048, D, D, D}; pg8::StaticOrder S; S.init(M, 2048, G, bid);
          pg8::EpiOp<OpGates> E{{CB(4), CB(5), INP(I_GB), ((float*)(ws + WS_SS1))}};
          pg8::gemm_phase(glds, g, S, E, wv); }
        { pg8::Gemm g{ATTOP, WB(WS_WUP), M, D, 256, 256, 256}; pg8::StaticOrder S; S.init(M, D, G, bid);
          pg8::EpiOp<OpStoreBf16> E{{CB(6), D, 1.0f}};
          pg8::gemm_phase(glds, g, S, E, wv); }
    }
    SEAM();
    PHASE(13) {
        PH_ARGS();
        pg8::Gemm g{CB(3), WB(WS_WOUT), M, D, D, D, D}; pg8::StaticOrder S; S.init(M, D, G, bid);
        pg8::EpiOp<OpMerge> E{{CB(4), CB(6), CB(5), CB(1)}};
        pg8::gemm_phase(glds, g, S, E, wv);
    }
    SEAM();
    PHASE(14) {
        PH_ARGS();
        pg8::Gemm g{CB(1), WB(WS_WO), M, D, D, D, D}; pg8::StaticOrder S; S.init(M, D, G, bid);
        pg8::EpiOp<OpRes> E{{INP(I_X), D1P, X2P, 1.0f, nullptr, CB(0), INP(I_F2N), ((float*)(ws + WS_SS2))}};
        pg8::gemm_phase(glds, g, S, E, wv);
    }
    SEAM();
    PHASE(16) {
        PH_ARGS();
        pg8::Gemm g{CB(0), WB(WS_WGU2), M, 2 * FF, D, D, D}; pg8::StaticOrder S; S.init(M, 2 * FF, G, bid);
        pg8::EpiOp<OpGateUp> E{{CB(4), ((float*)(ws + WS_SS2))}};
        pg8::gemm_phase(glds, g, S, E, wv);
    }
    SEAM();
    PHASE(17) {
        PH_ARGS();
        pg8::Gemm g{CB(4), WB(WS_WD2), M, D, FF, FF, FF}; pg8::StaticOrder S; S.init(M, D, G, bid);
        pg8::EpiOp<OpRes> E{{X2P, nullptr, ap->out, 0.5f, nullptr, nullptr, nullptr, nullptr}};
        pg8::gemm_phase(glds, g, S, E, wv);
    }
    SEAM();
    PHASE(18) {
        PH_ARGS();
        for (int m = gw; m < M; m += NGW) norm_row(ap->out + (size_t)m * D, nullptr, INP(I_FN), nullptr, ap->out + (size_t)m * D, lane);
    }
}
constexpr int N_PHASES = 19;

extern "C" void kernel_launch(void* const* d_in, const int* in_sizes, int n_in, void* d_out, int out_size, void* d_ws, size_t ws_size, hipStream_t stream) {
    static int grid = 0;
    if (grid == 0) {
        if (n_in != 27 || in_sizes[0] != M * D || out_size != M * D || ws_size < WS_END) { fprintf(stderr, "kernel_launch: unexpected shapes (n_in %d, in0 %d, out %d, ws %zu)\n", n_in, n_in > 0 ? in_sizes[0] : -1, out_size, ws_size); grid = -1; return; }
        int dev = 0, cus = 0, per_cu = 0;
        hipGetDevice(&dev); hipDeviceGetAttribute(&cus, hipDeviceAttributeMultiprocessorCount, dev);
        if (hipFuncSetAttribute((const void*)mk_fwd, hipFuncAttributeMaxDynamicSharedMemorySize, LDS_BYTES) != hipSuccess) { fprintf(stderr, "kernel_launch: hipFuncSetAttribute failed\n"); grid = -1; return; }
        if (hipOccupancyMaxActiveBlocksPerMultiprocessor(&per_cu, (const void*)mk_fwd, NT, LDS_BYTES) != hipSuccess || per_cu < 1) { fprintf(stderr, "kernel_launch: occupancy query says %d\n", per_cu); per_cu = 1; }
        (void)hipGetLastError();
        grid = cus;
    }
    if (grid < 0) return;
    Args a{};
    for (int i = 0; i < 27; ++i) a.in[i] = (const float*)d_in[i];
    a.out = (float*)d_out; a.ws = (unsigned char*)d_ws;
#if MK_MULTI
    for (int p = 0; p < N_PHASES; ++p) { a.ph_lo = p; a.ph_hi = p + 1; hipLaunchKernelGGL(mk_fwd, dim3(grid), dim3(NT), LDS_BYTES, stream, a); }
#else
    a.ph_lo = 0; a.ph_hi = N_PHASES;
    void* kargs[] = {&a};
    hipError_t e = hipLaunchCooperativeKernel((const void*)mk_fwd, dim3(grid), dim3(NT), kargs, LDS_BYTES, stream);
    if (e != hipSuccess) fprintf(stderr, "kernel_launch: cooperative launch failed: %s (grid %d)\n", hipGetErrorString(e), grid);
#endif
}
```

```cpp
#include <hip/hip_runtime.h>
#include <hip/hip_cooperative_groups.h>
#include <cstdio>
#include <cstdint>
namespace cg = cooperative_groups;

#ifndef MK_MULTI
#define MK_MULTI 0
#endif
#ifndef ATT_REP
#define ATT_REP 1
#endif
#ifndef PROBE_MASK
#define PROBE_MASK 0u
#endif

__device__ __forceinline__ int lane_id_fresh() { int l; asm volatile("v_mbcnt_lo_u32_b32 %0, -1, 0\n\tv_mbcnt_hi_u32_b32 %0, -1, %0" : "=v"(l)); return l; }
#define KTID(wv) ((wv) * 64 + lane_id_fresh())
namespace pg8 {
#define PG8_LAS __attribute__((address_space(3)))
typedef unsigned short bf16_t;
typedef short bf16x8 __attribute__((ext_vector_type(8)));
typedef float f32x4 __attribute__((ext_vector_type(4)));
typedef unsigned u32x4 __attribute__((ext_vector_type(4)));
constexpr int BM = 256, BK = 64, HALF = 128, HTB = HALF * BK * 2, STAGE_BYTES = 8 * HTB, NXCD = 8, WGM = 8;

__host__ __device__ __forceinline__ int lds_byte(int r, int c) { const int st = (r >> 4) * 2 + (c >> 5), rr = r & 15, cc = c & 31, ob = rr * 64 + cc * 2; return st * 1024 + (ob ^ (((ob >> 9) & 1) << 5)); }
__host__ __device__ __forceinline__ void stage_rc(int b, int& R, int& C) { const int st = b / 1024, sb = b % 1024, swz = sb ^ (((sb >> 9) & 1) << 5); R = (st >> 1) * 16 + swz / 64; C = (st & 1) * 32 + (swz % 64) / 2; }
__host__ __device__ __forceinline__ int perm32(int rho) { const int n = rho >> 4, i = rho & 15; return 8 * (i >> 2) + 4 * n + (i & 3); }

struct Unit { int pm, pn; };
struct Gemm { const bf16_t* A; const bf16_t* Bt; int M, N, K, lda, ldb; };

struct StaticOrder {
    int nM, nN, nwg, G, c;
    __host__ __device__ void init(int M, int N, int G_, int c_) { nM = M / BM; nN = N / BM; nwg = nM * nN; G = G_; c = c_; }
    __host__ __device__ bool next(int i, Unit& u) const {
        const long L = (long)i * G + c; if (L >= nwg) return false;
        int wgid = (int)L; { const int q = nwg / NXCD, r = nwg % NXCD, xcd = wgid % NXCD, off = wgid / NXCD; wgid = (xcd < r ? xcd * (q + 1) : r * (q + 1) + (xcd - r) * q) + off; }
        const int nig = WGM * nN, gid = wgid / nig, fm = gid * WGM, gsz = (nM - fm) < WGM ? (nM - fm) : WGM;
        u.pm = fm + ((wgid % nig) % gsz); u.pn = (wgid % nig) / gsz; return true;
    }
};

__device__ __forceinline__ unsigned cvt_pk_bf16(float lo, float hi) { unsigned r; asm volatile("v_cvt_pk_bf16_f32 %0, %1, %2" : "=v"(r) : "v"(lo), "v"(hi)); return r; }

template <class Op> struct EpiOp {
    Op op;
    __device__ __forceinline__ void operator()(const f32x4 (&acc)[2][2][4][2], const Unit& u, int wr, int wc, int fr, int fq) const {
#pragma unroll
        for (int ai = 0; ai < 2; ++ai)
#pragma unroll
            for (int m = 0; m < 4; ++m) {
                const int row = u.pm * BM + ai * HALF + wr * 64 + m * 16 + fr;
                op(acc[ai][0][m][0], acc[ai][0][m][1], acc[ai][1][m][0], acc[ai][1][m][1], row, u.pn, wc, fq);
                asm volatile("" ::: "memory");
            }
    }
};

template <class Epi, class Sched>
__device__ __forceinline__ void gemm_phase(PG8_LAS unsigned char* lds, const Gemm g, const Sched& S, const Epi& E, const int wv) {
    int tid_ = KTID(wv);
    const int tid = tid_, wid = __builtin_amdgcn_readfirstlane(tid >> 6), lane = tid & 63, wr = wid >> 2, wc = wid & 3, fr = lane & 15, fq = lane >> 4;
    const int K = g.K, nt = K / BK;
    unsigned voffA[2], voffB[2];
#pragma unroll
    for (int i = 0; i < 2; ++i) { int R, C; stage_rc(tid * 16 + i * 8192, R, C); const int Rb = (R & ~31) + perm32(R & 31);
        voffA[i] = (unsigned)(R * g.lda + C) * 2u; voffB[i] = (unsigned)(Rb * g.ldb + C) * 2u; }
    const size_t kstep = (size_t)(BK * 2);
    const size_t hstepA = (size_t)HALF * g.lda * 2, hstepB = (size_t)HALF * g.ldb * 2;
    const size_t tstepA = 2 * hstepA, tstepB = 2 * hstepB;
    const unsigned ldsw = (unsigned)wid * 1024u;
    const int aoff = lds_byte(wr * 64 + fr, fq * 8), boff = lds_byte(wc * 32 + fr, fq * 8);
#define PG8_SA(b, h) (((b) * 2 + (h)) * HTB)
#define PG8_SB(b, h) ((4 + (b) * 2 + (h)) * HTB)
#define PG8_STAGE(bufoff, gbase, voff) do { _Pragma("unroll") for (int _i = 0; _i < 2; ++_i) \
        __builtin_amdgcn_global_load_lds((const unsigned*)((const char*)(gbase) + (voff)[_i]), (PG8_LAS unsigned*)(lds + (bufoff) + ldsw + _i * 8192), 16, 0, 0); } while (0)
#define PG8_LDA(dst, b, h) do { _Pragma("unroll") for (int m = 0; m < 4; ++m) _Pragma("unroll") for (int k = 0; k < 2; ++k) dst[m][k] = *(const PG8_LAS bf16x8*)(lds + PG8_SA(b, h) + aoff + m * 2048 + k * 1024); } while (0)
#define PG8_LDB(dst, b, h) do { _Pragma("unroll") for (int n = 0; n < 2; ++n) _Pragma("unroll") for (int k = 0; k < 2; ++k) dst[n][k] = *(const PG8_LAS bf16x8*)(lds + PG8_SB(b, h) + boff + n * 2048 + k * 1024); } while (0)
#define PG8_MMA(ai, bj, At, Bt) do { __builtin_amdgcn_s_setprio(1); _Pragma("unroll") for (int m = 0; m < 4; ++m) _Pragma("unroll") for (int n = 0; n < 2; ++n) _Pragma("unroll") for (int k = 0; k < 2; ++k) \
        acc[ai][bj][m][n] = __builtin_amdgcn_mfma_f32_16x16x32_bf16(Bt[n][k], At[m][k], acc[ai][bj][m][n], 0, 0, 0); __builtin_amdgcn_s_setprio(0); } while (0)
#define PG8_WAIT_V(n) asm volatile("s_waitcnt vmcnt(" #n ")" ::: "memory")
#define PG8_WAIT_L(n) asm volatile("s_waitcnt lgkmcnt(" #n ")" ::: "memory")
#define PG8_BAR __builtin_amdgcn_s_barrier()
#define PG8_SCHED __builtin_amdgcn_sched_barrier(0)
    Unit cur, nxt; int ui = 0;
    if (!S.next(0, cur)) return;
    f32x4 acc[2][2][4][2];
#pragma unroll
    for (int a = 0; a < 2; ++a)
#pragma unroll
        for (int b = 0; b < 2; ++b)
#pragma unroll
            for (int m = 0; m < 4; ++m)
#pragma unroll
                for (int n = 0; n < 2; ++n) acc[a][b][m][n] = (f32x4){0.f, 0.f, 0.f, 0.f};
    bf16x8 At[4][2], B0[2][2], B1[2][2];
    const char* cA = (const char*)g.A + (size_t)cur.pm * tstepA; const char* cB = (const char*)g.Bt + (size_t)cur.pn * tstepB;
    PG8_STAGE(PG8_SB(0, 0), cB, voffB); PG8_STAGE(PG8_SB(0, 1), cB + hstepB, voffB); PG8_STAGE(PG8_SA(0, 0), cA, voffA); PG8_STAGE(PG8_SA(0, 1), cA + hstepA, voffA);
    if (wr == 1) PG8_BAR;
    PG8_WAIT_V(2); PG8_BAR;
    PG8_STAGE(PG8_SB(1, 0), cB + kstep, voffB); PG8_STAGE(PG8_SA(1, 0), cA + kstep, voffA); PG8_STAGE(PG8_SB(1, 1), cB + hstepB + kstep, voffB);
    PG8_WAIT_V(6); PG8_BAR;
    for (;;) {
        const bool has_next = S.next(ui + 1, nxt);
        const char* nA = has_next ? (const char*)g.A + (size_t)nxt.pm * tstepA : cA; const char* nB = has_next ? (const char*)g.Bt + (size_t)nxt.pn * tstepB : cB;
        for (int t = 0; t < nt; t += 2) {
            const bool last = (t == nt - 2);
            const char* a1 = cA + (size_t)(t + 1) * kstep;
            const char* a2 = last ? nA : cA + (size_t)(t + 2) * kstep; const char* b2 = last ? nB : cB + (size_t)(t + 2) * kstep;
            const char* a3 = a2 + kstep; const char* b3 = b2 + kstep;
            PG8_LDB(B0, 0, 0); PG8_LDB(B1, 0, 1); PG8_SCHED; PG8_LDA(At, 0, 0); PG8_STAGE(PG8_SA(1, 1), a1 + hstepA, voffA);
            PG8_WAIT_V(8); PG8_WAIT_L(0); PG8_BAR; PG8_MMA(0, 0, At, B0); PG8_MMA(0, 1, At, B1); PG8_BAR; PG8_SCHED;
            PG8_LDA(At, 0, 1); PG8_STAGE(PG8_SB(0, 0), b2, voffB); PG8_STAGE(PG8_SB(0, 1), b2 + hstepB, voffB); PG8_STAGE(PG8_SA(0, 0), a2, voffA);
            PG8_WAIT_V(8); PG8_WAIT_L(0); PG8_BAR; PG8_MMA(1, 0, At, B0); PG8_MMA(1, 1, At, B1); PG8_BAR; PG8_SCHED;
            PG8_LDB(B0, 1, 0); PG8_LDB(B1, 1, 1); PG8_SCHED; PG8_LDA(At, 1, 0); PG8_STAGE(PG8_SA(0, 1), a2 + hstepA, voffA);
            PG8_WAIT_V(8); PG8_WAIT_L(0); PG8_BAR; PG8_MMA(0, 0, At, B0); PG8_MMA(0, 1, At, B1); PG8_BAR; PG8_SCHED;
            PG8_LDA(At, 1, 1); PG8_STAGE(PG8_SB(1, 0), b3, voffB); PG8_STAGE(PG8_SB(1, 1), b3 + hstepB, voffB); PG8_STAGE(PG8_SA(1, 0), a3, voffA);
            PG8_WAIT_V(8); PG8_WAIT_L(0); PG8_BAR; PG8_MMA(1, 0, At, B0); PG8_MMA(1, 1, At, B1); PG8_BAR; PG8_SCHED;
        }
        if (wr == 0) PG8_BAR;
        { const int le_ = lane_id_fresh(); E(acc, cur, wr, wc, le_ & 15, le_ >> 4); }
        if (!has_next) break;
#pragma unroll
        for (int a = 0; a < 2; ++a)
#pragma unroll
            for (int b = 0; b < 2; ++b)
#pragma unroll
                for (int m = 0; m < 4; ++m)
#pragma unroll
                    for (int n = 0; n < 2; ++n) acc[a][b][m][n] = (f32x4){0.f, 0.f, 0.f, 0.f};
        cur = nxt; cA = nA; cB = nB; ++ui;
        if (wr == 1) PG8_BAR;
    }
    PG8_WAIT_V(0);
    PG8_BAR;
#undef PG8_SA
#undef PG8_SB
#undef PG8_STAGE
#undef PG8_LDA
#undef PG8_LDB
#undef PG8_MMA
#undef PG8_WAIT_V
#undef PG8_WAIT_L
#undef PG8_BAR
#undef PG8_SCHED
}
}

using pg8::bf16_t; using pg8::f32x4; using pg8::u32x4; using pg8::bf16x8;
typedef unsigned u32x2 __attribute__((ext_vector_type(2)));
#define LAS __attribute__((address_space(3)))

constexpr int BATCH = 8, SEQ = 8192, D = 1024, FF = 2816, M = BATCH * SEQ;
constexpr int AW = 768, RS = 3360, INC = 7712;
constexpr int LAW = 384;
constexpr int NWAVES = 8, NT = 512;
constexpr float NORM_EPS = 1e-6f, GN_EPS = 64e-5f;

constexpr size_t MiB = 1u << 20;
constexpr size_t WS_WGU1 = 1 * MiB;
constexpr size_t WS_WD1 = WS_WGU1 + 11 * MiB;
constexpr size_t WS_WGU2 = WS_WD1 + 5 * MiB + MiB / 2;
constexpr size_t WS_WD2 = WS_WGU2 + 11 * MiB;
constexpr size_t WS_WIN = WS_WD2 + 5 * MiB + MiB / 2;
constexpr size_t WS_WUP = WS_WIN + 15 * MiB + MiB / 2;
constexpr size_t WS_WOUT = WS_WUP + MiB / 2;
constexpr size_t WS_WO = WS_WOUT + 2 * MiB;
constexpr size_t WS_LW = WS_WO + 2 * MiB;
constexpr size_t WS_LA2 = WS_LW + MiB / 4;
constexpr size_t WS_LG = WS_LA2 + MiB / 4;
constexpr size_t WS_ROPE = WS_LG + MiB / 2;
static_assert(WS_ROPE + MiB / 2 <= 56 * MiB, "weights region");
constexpr size_t WS_LA = 56 * MiB;
constexpr size_t WS_HALO = 104 * MiB;
constexpr size_t WS_HALOLA = 104 * MiB;
constexpr size_t WS_BC = 111 * MiB;
constexpr size_t WS_LSE = 115 * MiB;
constexpr size_t WS_BRKR = 118 * MiB;
constexpr size_t WS_SS1 = 118 * MiB, WS_SS2 = WS_SS1 + MiB;
constexpr size_t CH = 128 * MiB;
constexpr size_t WS_C0 = 128 * MiB;
#define WS_C(i) (WS_C0 + (size_t)(i) * CH)
constexpr size_t WS_END = 1024 * MiB;
constexpr int LDS_BYTES = 147456;

__device__ __forceinline__ float bf2f(unsigned short h) { return __uint_as_float(((unsigned)h) << 16); }
__device__ __forceinline__ float bflo(unsigned w) { return __uint_as_float(w << 16); }
__device__ __forceinline__ float bfhi(unsigned w) { return __uint_as_float(w & 0xffff0000u); }
__device__ __forceinline__ unsigned pk2(float lo, float hi) { return pg8::cvt_pk_bf16(lo, hi); }
__device__ __forceinline__ void unpack8(const u32x4 w, float (&f)[8]) { f[0] = bflo(w.x); f[1] = bfhi(w.x); f[2] = bflo(w.y); f[3] = bfhi(w.y); f[4] = bflo(w.z); f[5] = bfhi(w.z); f[6] = bflo(w.w); f[7] = bfhi(w.w); }
__device__ __forceinline__ u32x4 pack8(const float (&f)[8]) { u32x4 w; w.x = pk2(f[0], f[1]); w.y = pk2(f[2], f[3]); w.z = pk2(f[4], f[5]); w.w = pk2(f[6], f[7]); return w; }
__device__ __forceinline__ float sigm(float x) { return __builtin_amdgcn_rcpf(1.f + __expf(-x)); }
__device__ __forceinline__ float wave_sum(float v) {
#pragma unroll
    for (int o = 1; o < 64; o <<= 1) v += __shfl_xor(v, o);
    return v;
}

__device__ __forceinline__ float row_rs(const float* ss, int row) { return rsqrtf(ss[row] * (1.f / D) + NORM_EPS); }
struct OpGateUp {
    bf16_t* H; const float* ss;
    __device__ __forceinline__ void operator()(const f32x4 g0_, const f32x4 g1_, const f32x4 u0_, const f32x4 u1_, int row, int pn, int wc, int fq) const {
        const int col = pn * 128 + wc * 32 + 8 * fq; float o[8];
        const float sc = ss ? row_rs(ss, row) : 1.f; const f32x4 g0 = g0_ * sc, g1 = g1_ * sc, u0 = u0_ * sc, u1 = u1_ * sc;
#pragma unroll
        for (int i = 0; i < 4; ++i) { o[i] = g0[i] * sigm(g0[i]) * u0[i]; o[4 + i] = g1[i] * sigm(g1[i]) * u1[i]; }
        *(u32x4*)(H + (size_t)row * FF + col) = pack8(o);
    }
};
struct OpStoreBf16 {
    bf16_t* O; int ld; float scale;
    __device__ __forceinline__ void operator()(const f32x4 a0, const f32x4 a1, const f32x4 b0, const f32x4 b1, int row, int pn, int wc, int fq) const {
        const int col = pn * 256 + wc * 32 + 8 * fq; float o[8];
#pragma unroll
        for (int i = 0; i < 4; ++i) { o[i] = a0[i] * scale; o[4 + i] = a1[i] * scale; }
        *(u32x4*)(O + (size_t)row * ld + col) = pack8(o);
#pragma unroll
        for (int i = 0; i < 4; ++i) { o[i] = b0[i] * scale; o[4 + i] = b1[i] * scale; }
        *(u32x4*)(O + (size_t)row * ld + col + 128) = pack8(o);
    }
};
struct OpRes {
    const float* base; const bf16_t* dlt; float* out; float scale; bf16_t* dout; bf16_t* xg; const float* gain; float* ss;
    __device__ __forceinline__ float half(const f32x4 a0, const f32x4 a1, size_t off, int col) const {
        const float sc_ = scale; f32x4 r0, r1;
#pragma unroll
        for (int i = 0; i < 4; ++i) { r0[i] = a0[i] * sc_; r1[i] = a1[i] * sc_; }
        if (dout) { u32x4 w; w.x = pk2(r0[0], r0[1]); w.y = pk2(r0[2], r0[3]); w.z = pk2(r1[0], r1[1]); w.w = pk2(r1[2], r1[3]); *(u32x4*)(dout + off) = w; }
        if (base) { r0 += *(const f32x4*)(base + off); r1 += *(const f32x4*)(base + off + 4); }
        if (dlt) { float d[8]; unpack8(*(const u32x4*)(dlt + off), d); r0 += (f32x4){d[0], d[1], d[2], d[3]}; r1 += (f32x4){d[4], d[5], d[6], d[7]}; }
        if (out) { *(f32x4*)(out + off) = r0; *(f32x4*)(out + off + 4) = r1; }
        float q = 0.f;
        if (xg) { const f32x4 g0 = *(const f32x4*)(gain + col), g1 = *(const f32x4*)(gain + col + 4); const f32x4 y0 = r0 * g0, y1 = r1 * g1;
            u32x4 w; w.x = pk2(y0[0], y0[1]); w.y = pk2(y0[2], y0[3]); w.z = pk2(y1[0], y1[1]); w.w = pk2(y1[2], y1[3]); *(u32x4*)(xg + off) = w;
            q = (r0[0] * r0[0] + r0[1] * r0[1]) + (r0[2] * r0[2] + r0[3] * r0[3]) + (r1[0] * r1[0] + r1[1] * r1[1]) + (r1[2] * r1[2] + r1[3] * r1[3]); }
        return q;
    }
    __device__ __forceinline__ void operator()(const f32x4 a0, const f32x4 a1, const f32x4 b0, const f32x4 b1, int row, int pn, int wc, int fq) const {
        const int col = pn * 256 + wc * 32 + 8 * fq; const size_t off = (size_t)row * D + col;
        float q = half(a0, a1, off, col) + half(b0, b1, off + 128, col + 128);
        if (xg) { q += __shfl_xor(q, 16); q += __shfl_xor(q, 32); if (fq == 0) atomicAdd(ss + row, q); }
    }
};
struct OpAttnQKV {
    bf16_t* q; bf16_t* k; bf16_t* v; const float* rope; const float* ss;
    __device__ __forceinline__ void half(const f32x4 a0, const f32x4 a1, bf16_t* dst, int row, int wc, int fq, int which) const {
        float o[8];
#pragma unroll
        for (int i = 0; i < 4; ++i) { o[i] = a0[i]; o[4 + i] = a1[i]; }
        if (which < 2 && (wc & 1) == 0) {
            float p[8];
#pragma unroll
            for (int i = 0; i < 8; ++i) p[i] = __shfl_xor(o[i], 16);
            if (fq < 2) {
                const float* cs = rope + (size_t)(row & (SEQ - 1)) * 16;
                const f32x4 c0 = *(const f32x4*)(cs), c1 = *(const f32x4*)(cs + 4), s0 = *(const f32x4*)(cs + 8), s1 = *(const f32x4*)(cs + 12);
                const float sg = fq == 0 ? -1.f : 1.f;
#pragma unroll
                for (int i = 0; i < 4; ++i) { o[i] = o[i] * c0[i] + sg * p[i] * s0[i]; o[4 + i] = o[4 + i] * c1[i] + sg * p[4 + i] * s1[i]; }
            }
        }
        if (which == 0) {
#pragma unroll
            for (int i = 0; i < 8; ++i) o[i] *= 0.125f;
        }
        *(u32x4*)dst = pack8(o);
    }
    __device__ __forceinline__ void operator()(const f32x4 a0, const f32x4 a1, const f32x4 b0, const f32x4 b1, int row, int pn, int wc, int fq) const {
        const int which = pn / 3, col = (pn - which * 3) * 256 + wc * 32 + 8 * fq;
        bf16_t* base = q + (size_t)which * (CH / 2) + (size_t)row * AW + col;
        const float sc = row_rs(ss, row);
        half(a0 * sc, a1 * sc, base, row, wc, fq, which); half(b0 * sc, b1 * sc, base + 128, row, wc, fq, which);
    }
};
struct OpRwkvZ {
    bf16_t* r; bf16_t* k; bf16_t* v; bf16_t* la; const float* ss; bf16_t* halola;
    __device__ __forceinline__ void operator()(const f32x4 a0, const f32x4 a1, const f32x4 b0, const f32x4 b1, int row, int pn, int wc, int fq) const {
        float o0[8], o1[8]; const float sc = row_rs(ss, row);
#pragma unroll
        for (int i = 0; i < 4; ++i) { o0[i] = a0[i] * sc; o0[4 + i] = a1[i] * sc; o1[i] = b0[i] * sc; o1[4 + i] = b1[i] * sc; }
        const u32x4 w0 = pack8(o0), w1 = pack8(o1);
        const bool hrow = (row & 31) == 31;
        if (pn < 12) {
            const int s = pn >> 2, col = (pn & 3) * 256 + wc * 32 + 8 * fq;
            bf16_t* dst = r + (size_t)s * (CH / 2) + (size_t)row * D + col;
            *(u32x4*)dst = w0; *(u32x4*)(dst + 128) = w1;
        } else {
            const int col = (pn - 12) * 256 + wc * 32 + 8 * fq;
            if (col < 288) { *(u32x4*)(la + (size_t)row * LAW + col) = w0; if (hrow) *(u32x4*)(halola + (size_t)(row >> 5) * LAW + col) = w0; }
            if (col + 128 < 288) { *(u32x4*)(la + (size_t)row * LAW + col + 128) = w1; if (hrow) *(u32x4*)(halola + (size_t)(row >> 5) * LAW + col + 128) = w1; }
        }
    }
};
struct OpGates {
    bf16_t* ga; bf16_t* gr; const float* bias; const float* ss;
    __device__ __forceinline__ void operator()(const f32x4 a0, const f32x4 a1, const f32x4 b0, const f32x4 b1, int row, int pn, int wc, int fq) const {
        const int s = pn >> 2, col = (pn & 3) * 256 + wc * 32 + 8 * fq; const float* bp = bias + s * 1024 + col;
        bf16_t* dst = ga + (size_t)s * (CH / 2) + (size_t)row * D + col; float o[8]; const float sc = row_rs(ss, row);
        { const f32x4 c0 = *(const f32x4*)bp, c1 = *(const f32x4*)(bp + 4);
#pragma unroll
          for (int i = 0; i < 4; ++i) { o[i] = sigm(a0[i] * sc + c0[i]); o[4 + i] = sigm(a1[i] * sc + c1[i]); }
          *(u32x4*)dst = pack8(o); }
        { const f32x4 c0 = *(const f32x4*)(bp + 128), c1 = *(const f32x4*)(bp + 132);
#pragma unroll
          for (int i = 0; i < 4; ++i) { o[i] = sigm(b0[i] * sc + c0[i]); o[4 + i] = sigm(b1[i] * sc + c1[i]); }
          *(u32x4*)(dst + 128) = pack8(o); }
    }
};
template <int MODE> struct OpLora {
    bf16_t* O; const float* p0;
    __device__ __forceinline__ float f(float x) const { const float s = sigm(x); return MODE == 0 ? 1.f - __expf(-0.60653065971f * s) : s; }
    __device__ __forceinline__ void operator()(const f32x4 a0, const f32x4 a1, const f32x4 b0, const f32x4 b1, int row, int pn, int wc, int fq) const {
        const int col = pn * 256 + wc * 32 + 8 * fq; const float* bp = p0 + col; bf16_t* dst = O + (size_t)row * D + col; float o[8];
        { const f32x4 c0 = *(const f32x4*)bp, c1 = *(const f32x4*)(bp + 4);
#pragma unroll
          for (int i = 0; i < 4; ++i) { o[i] = f(a0[i] + c0[i]); o[4 + i] = f(a1[i] + c1[i]); }
          *(u32x4*)dst = pack8(o); }
        { const f32x4 c0 = *(const f32x4*)(bp + 128), c1 = *(const f32x4*)(bp + 132);
#pragma unroll
          for (int i = 0; i < 4; ++i) { o[i] = f(b0[i] + c0[i]); o[4 + i] = f(b1[i] + c1[i]); }
          *(u32x4*)(dst + 128) = pack8(o); }
    }
};
struct OpMerge {
    const bf16_t* ga; const bf16_t* ya; const bf16_t* gr; bf16_t* out;
    __device__ __forceinline__ void half(const f32x4 a0, const f32x4 a1, size_t off) const {
        float A[8], Y[8], R[8], o[8]; unpack8(*(const u32x4*)(ga + off), A); unpack8(*(const u32x4*)(ya + off), Y); unpack8(*(const u32x4*)(gr + off), R);
#pragma unroll
        for (int i = 0; i < 4; ++i) { o[i] = A[i] * Y[i] + R[i] * a0[i]; o[4 + i] = A[4 + i] * Y[4 + i] + R[4 + i] * a1[i]; }
        *(u32x4*)(out + off) = pack8(o);
    }
    __device__ __forceinline__ void operator()(const f32x4 a0, const f32x4 a1, const f32x4 b0, const f32x4 b1, int row, int pn, int wc, int fq) const {
        const size_t off = (size_t)row * D + pn * 256 + wc * 32 + 8 * fq;
        half(a0, a1, off); half(b0, b1, off + 128);
    }
};

struct Args {
    const float* in[27]; float* out; unsigned char* ws; int ph_lo, ph_hi;
};
enum { I_X = 0, I_F1N, I_F1G, I_F1U, I_F1D, I_MN, I_WIN, I_GB, I_AUP, I_MU, I_W0, I_W2, I_A0, I_A2, I_G2, I_KK, I_KA, I_RK, I_LNW, I_LNB, I_WOUT, I_WO, I_F2N, I_F2G, I_F2U, I_F2D, I_FN };

__device__ __forceinline__ void tr_job(const float* W0, const float* W1, int ldw, int Ksrc, bf16_t* WT, int ldt, int nrows, int mode, int coff, int climit,
                                       float* scr, int gw, int NGW, int lane) {
    const int nblk = nrows / 64, nitems = (ldt / 64) * nblk;
    for (int it = gw; it < nitems; it += NGW) {
        const int kb = it / nblk, nb = it % nblk, k0 = 64 * kb;
        const float* Wh[2]; int ch[2]; bool vh[2];
#pragma unroll
        for (int hh = 0; hh < 2; ++hh) {
            const int nb32 = 2 * nb + hh;
            if (mode == 0) { ch[hh] = coff + 32 * nb32; vh[hh] = ch[hh] < climit; Wh[hh] = W0; }
            else { const int tile = nb32 >> 3, j0 = (nb32 & 7) * 32; Wh[hh] = j0 < 128 ? W0 : W1; ch[hh] = tile * 128 + (j0 & 127); vh[hh] = true; }
        }
        const int r4 = lane >> 4, pc = lane & 15, hsel = pc >> 3;
        const float* Wsel = hsel ? Wh[1] : Wh[0]; const int csel = (hsel ? ch[1] : ch[0]) + (pc & 7) * 4; const bool vsel = hsel ? vh[1] : vh[0];
        f32x4 v[16];
#pragma unroll
        for (int i = 0; i < 16; ++i) { const int k = k0 + 4 * i + r4; v[i] = (vsel && k < Ksrc) ? *(const f32x4*)(Wsel + (size_t)k * ldw + csel) : (f32x4){0.f, 0.f, 0.f, 0.f}; }
#pragma unroll
        for (int i = 0; i < 16; ++i) { float* d = scr + (4 * i + r4) * 65 + pc * 4; d[0] = v[i].x; d[1] = v[i].y; d[2] = v[i].z; d[3] = v[i].w; }
        __builtin_amdgcn_s_waitcnt(0); asm volatile("" ::: "memory");
        const int c = lane & 7;
#pragma unroll
        for (int j = 0; j < 8; ++j) { const int n = (lane >> 3) + 8 * j; const float* sp = scr + (8 * c) * 65 + n;
            u32x4 o; o.x = pk2(sp[0 * 65], sp[1 * 65]); o.y = pk2(sp[2 * 65], sp[3 * 65]); o.z = pk2(sp[4 * 65], sp[5 * 65]); o.w = pk2(sp[6 * 65], sp[7 * 65]);
            *(u32x4*)(WT + (size_t)(64 * nb + n) * ldt + k0 + 8 * c) = o; }
        __builtin_amdgcn_s_waitcnt(0); asm volatile("" ::: "memory");
    }
}
__device__ __forceinline__ void norm_row(const float* xrow, const bf16_t* drow, const float* gain, bf16_t* orow, float* frow, int lane) {
    f32x4 v[4]; float s = 0.f;
#pragma unroll
    for (int j = 0; j < 4; ++j) {
        v[j] = *((const f32x4*)xrow + lane + 64 * j);
        if (drow) { const u32x2 w = *((const u32x2*)drow + lane + 64 * j); v[j] += (f32x4){bflo(w.x), bfhi(w.x), bflo(w.y), bfhi(w.y)}; }
        s += (v[j].x * v[j].x + v[j].y * v[j].y) + (v[j].z * v[j].z + v[j].w * v[j].w);
    }
    const float inv = rsqrtf(wave_sum(s) * (1.f / D) + NORM_EPS);
#pragma unroll
    for (int j = 0; j < 4; ++j) {
        const f32x4 gn = *((const f32x4*)gain + lane + 64 * j); const f32x4 o = v[j] * inv * gn;
        if (orow) { u32x2 w; w.x = pk2(o.x, o.y); w.y = pk2(o.z, o.w); *((u32x2*)orow + lane + 64 * j) = w; }
        else *((f32x4*)frow + lane + 64 * j) = o;
    }
}

struct AttnUnit { int b, h, g, hg, d, r, i; };
__device__ __forceinline__ AttnUnit attn_decode(int u) {
    AttnUnit a; const int rb = u & 63, bh = u >> 6; a.h = bh % 12; a.b = bh / 12; a.g = a.h >> 2; a.hg = a.h & 3;
    const int dsh = 2 * a.g, nb = 64 >> dsh; a.d = 1 << dsh; a.r = rb / nb; a.i = rb % nb; return a;
}
__device__ __forceinline__ void attn_phase(unsigned char* lds, const bf16_t* Q, const bf16_t* K, const bf16_t* V, bf16_t* Og, float* lse, int G, int bid, const int wv) {
    bf16_t* Ks = (bf16_t*)lds;
    bf16_t* Vt = (bf16_t*)(lds + 36864);
    int tid_ = KTID(wv);
    const int tid = tid_, w = tid >> 6, lane = tid & 63, fr = lane & 15, fq = lane >> 4;
    constexpr int NU = ATT_REP * BATCH * 12 * 64;
    u32x4 kreg[4], vreg[4];
#define ATT_LOADKV(uu) do { const AttnUnit n_ = attn_decode((uu) % (BATCH * 12 * 64)); const size_t br_ = (size_t)n_.b * SEQ; \
        _Pragma("unroll") for (int c_ = 0; c_ < 4; ++c_) { const int p_ = tid + 512 * c_; \
            { const int key_ = p_ >> 3, seg_ = p_ & 7, l_ = 128 * (n_.i - 1) + key_; kreg[c_] = (u32x4){0u, 0u, 0u, 0u}; \
              if (l_ >= 0) kreg[c_] = *(const u32x4*)(K + (br_ + (size_t)l_ * n_.d + n_.r) * AW + n_.h * 64 + seg_ * 8); } \
            { const int seg_ = p_ >> 8, key_ = p_ & 255, l_ = 128 * (n_.i - 1) + key_; vreg[c_] = (u32x4){0u, 0u, 0u, 0u}; \
              if (l_ >= 0) vreg[c_] = *(const u32x4*)(V + (br_ + (size_t)l_ * n_.d + n_.r) * AW + n_.h * 64 + seg_ * 8); } } } while (0)
    if (bid < NU) ATT_LOADKV(bid);
    for (int u_ = bid; u_ < NU; u_ += G) {
        const AttnUnit U = attn_decode(u_ % (BATCH * 12 * 64));
        const int h = U.h, g = U.g, hg = U.hg, d = U.d, r = U.r, i = U.i;
        const size_t brow = (size_t)U.b * SEQ;
        __syncthreads();
#pragma unroll
        for (int c = 0; c < 4; ++c) {
            const int p = tid + 512 * c;
            *(u32x4*)(Ks + (p >> 3) * 72 + (p & 7) * 8) = kreg[c];
            const u32x4 val = vreg[c];
            bf16_t* vp = Vt + ((p >> 8) * 8) * 264 + (p & 255);
            vp[0 * 264] = (bf16_t)(val.x & 0xffffu); vp[1 * 264] = (bf16_t)(val.x >> 16); vp[2 * 264] = (bf16_t)(val.y & 0xffffu); vp[3 * 264] = (bf16_t)(val.y >> 16);
            vp[4 * 264] = (bf16_t)(val.z & 0xffffu); vp[5 * 264] = (bf16_t)(val.z >> 16); vp[6 * 264] = (bf16_t)(val.w & 0xffffu); vp[7 * 264] = (bf16_t)(val.w >> 16);
        }
        const size_t rowq = brow + (size_t)(128 * i + 16 * w + fr) * d + r;
        bf16x8 qf[2];
#pragma unroll
        for (int ks = 0; ks < 2; ++ks) qf[ks] = *(const bf16x8*)(Q + rowq * AW + h * 64 + ks * 32 + fq * 8);
        if (u_ + G < NU) ATT_LOADKV(u_ + G);
        __syncthreads();
        f32x4 s[10];
#pragma unroll
        for (int tt = 0; tt < 10; ++tt) {
            const int T = w + tt, Tc = T < 16 ? T : 15;
            const bf16x8 k0 = *(const bf16x8*)(Ks + (16 * Tc + fr) * 72 + fq * 8), k1 = *(const bf16x8*)(Ks + (16 * Tc + fr) * 72 + 32 + fq * 8);
            f32x4 a = (f32x4){0.f, 0.f, 0.f, 0.f};
            a = __builtin_amdgcn_mfma_f32_16x16x32_bf16(k0, qf[0], a, 0, 0, 0);
            a = __builtin_amdgcn_mfma_f32_16x16x32_bf16(k1, qf[1], a, 0, 0, 0);
            s[tt] = a;
        }
        const int qi = 16 * w + fr; float mx = -INFINITY;
#pragma unroll
        for (int tt = 0; tt < 10; ++tt)
#pragma unroll
            for (int e = 0; e < 4; ++e) {
                const int ki = 16 * (w + tt) + 4 * fq + e;
                const bool valid = (ki >= qi) && (ki <= qi + 128) && (ki < 256) && (i > 0 || ki >= 128);
                s[tt][e] = valid ? s[tt][e] : -INFINITY; mx = fmaxf(mx, s[tt][e]);
            }
        mx = fmaxf(mx, __shfl_xor(mx, 16)); mx = fmaxf(mx, __shfl_xor(mx, 32));
        float l = 0.f;
#pragma unroll
        for (int tt = 0; tt < 10; ++tt)
#pragma unroll
            for (int e = 0; e < 4; ++e) { const float p = __expf(s[tt][e] - mx); s[tt][e] = p; l += p; }
        l += __shfl_xor(l, 16); l += __shfl_xor(l, 32);
        f32x4 o[4];
#pragma unroll
        for (int dt = 0; dt < 4; ++dt) o[dt] = (f32x4){0.f, 0.f, 0.f, 0.f};
#pragma unroll
        for (int s2 = 0; s2 < 5; ++s2) {
            const int T0 = w + 2 * s2, T1 = T0 + 1, T0c = T0 < 16 ? T0 : 15, T1c = T1 < 16 ? T1 : 15;
            union { bf16x8 v; unsigned u[4]; } pf;
            pf.u[0] = pk2(s[2 * s2][0], s[2 * s2][1]); pf.u[1] = pk2(s[2 * s2][2], s[2 * s2][3]);
            pf.u[2] = pk2(s[2 * s2 + 1][0], s[2 * s2 + 1][1]); pf.u[3] = pk2(s[2 * s2 + 1][2], s[2 * s2 + 1][3]);
#pragma unroll
            for (int dt = 0; dt < 4; ++dt) {
                union { bf16x8 v; u32x2 h[2]; } vf;
                vf.h[0] = *(const u32x2*)(Vt + (16 * dt + fr) * 264 + 16 * T0c + 4 * fq);
                vf.h[1] = *(const u32x2*)(Vt + (16 * dt + fr) * 264 + 16 * T1c + 4 * fq);
                o[dt] = __builtin_amdgcn_mfma_f32_16x16x32_bf16(vf.v, pf.v, o[dt], 0, 0, 0);
            }
        }
        const float il = 1.f / l;
        bf16_t* op = Og + ((size_t)g * M + rowq) * 256 + hg * 64 + 4 * fq;
#pragma unroll
        for (int dt = 0; dt < 4; ++dt) { u32x2 wv; wv.x = pk2(o[dt][0] * il, o[dt][1] * il); wv.y = pk2(o[dt][2] * il, o[dt][3] * il); *(u32x2*)(op + 16 * dt) = wv; }
        if (fq == 0) lse[((size_t)g * M + rowq) * 4 + hg] = mx + __logf(l);
    }
    __syncthreads();
}

template <int CTRL> __device__ __forceinline__ float dpp_f(float x) { return __builtin_bit_cast(float, __builtin_amdgcn_update_dpp(0, __builtin_bit_cast(int, x), CTRL, 0xf, 0xf, true)); }
__device__ __forceinline__ float row16_sum(float x) { x += dpp_f<0x128>(x); x += dpp_f<0x124>(x); x += dpp_f<0x122>(x); x += dpp_f<0x121>(x); return x; }
constexpr int TC = 32;
constexpr int SC_BUF = TC * 5 * 64 * 4;
constexpr int SC_V = TC * 32 * 4;
typedef float f32x2 __attribute__((ext_vector_type(2)));
struct ScanOps { f32x4 a0, a1, q0, q1, w0, w1, b0, b1, k0, k1; f32x2 bk; float v; };
__device__ __forceinline__ void scan_phase(unsigned char* lds, const bf16_t* Rz, const bf16_t* Wm, const bf16_t* Kz, const bf16_t* Vz, const bf16_t* Aa, const float* mu, const float* pkk, const float* pka, const float* prk, float* BCo, bf16_t* Y, int G, int bid, const int wv) {
    int tid_ = KTID(wv);
    const int tid = tid_, w = __builtin_amdgcn_readfirstlane(tid >> 6), lane = tid & 63, kq = lane & 15, rw = lane >> 4;
    float* const kb0 = (float*)lds; float* const vb0 = (float*)(lds + 2 * SC_BUF); float* const yb0 = (float*)(lds + 2 * SC_BUF + 2 * SC_V);
    float* const bb0 = (float*)(lds + 2 * SC_BUF + 4 * SC_V);
#define KB(bi) (kb0 + (bi) * (SC_BUF / 4))
#define VB(bi) (vb0 + (bi) * (SC_V / 4))
#define YB(bi) (yb0 + (bi) * (SC_V / 4))
#define BB(bi) (bb0 + (bi) * (TC * 2))
    constexpr int NCH = SEQ / TC;
    for (int u = bid; u < BATCH * 16 * 2; u += G) {
        const int half = u & 1, h = (u >> 1) & 15, b = u >> 5;
        const size_t row0 = (size_t)b * SEQ;
        __syncthreads();
        if (w >= 4) {
            const int ht = tid - 256, st = ht >> 3, sg = ht & 7;
            const size_t goff = (row0 + st) * D + h * 64 + sg * 8;
            const int lo = st * 320 + sg * 8;
            const bool hv = ht < 128;
            const size_t voff = (row0 + (ht >> 2)) * D + h * 64 + half * 32 + (ht & 3) * 8; const int lov = (ht >> 2) * 32 + (ht & 3) * 8;
            bf16_t* yo = Y + voff;
            float mur[8], muk[8], muv[8], kkp[8], kap[8], rkp[8];
#pragma unroll
            for (int i = 0; i < 8; ++i) { const int cc = h * 64 + sg * 8 + i; mur[i] = mu[cc]; muk[i] = mu[1024 + cc]; kkp[i] = pkk[cc]; kap[i] = pka[cc]; rkp[i] = prk[cc];
                muv[i] = mu[2048 + h * 64 + half * 32 + (ht & 3) * 8 + i]; }
            struct HReg { u32x4 rc, rp, kc, kp, om, aa, vc, vp; };
            HReg P, Q; P.vc = (u32x4){0u, 0u, 0u, 0u}; P.vp = P.vc; Q.vc = P.vc; Q.vp = P.vc;
            const u32x4 z4 = (u32x4){0u, 0u, 0u, 0u};
#define SC_ISSUE(X, c) do { const size_t o_ = (size_t)(c) * TC * D; const bool first_ = ((c) == 0 && st == 0); \
                X.rc = *(const u32x4*)(Rz + goff + o_); X.kc = *(const u32x4*)(Kz + goff + o_); X.om = *(const u32x4*)(Wm + goff + o_); X.aa = *(const u32x4*)(Aa + goff + o_); \
                X.rp = first_ ? z4 : *(const u32x4*)(Rz + goff + o_ - D); X.kp = first_ ? z4 : *(const u32x4*)(Kz + goff + o_ - D); \
                if (hv) { X.vc = *(const u32x4*)(Vz + voff + o_); X.vp = ((c) == 0 && ht < 4) ? z4 : *(const u32x4*)(Vz + voff + o_ - D); } } while (0)
#define SC_ST8(dst, f) do { *(f32x4*)(dst) = (f32x4){f[0], f[1], f[2], f[3]}; *(f32x4*)((dst) + 4) = (f32x4){f[4], f[5], f[6], f[7]}; } while (0)
#define SC_COMMIT(X, bi, c) do { float rc_[8], rp_[8], kc_[8], kp_[8], om_[8], av_[8]; float* kb_ = KB(bi) + lo; \
                unpack8(X.rc, rc_); unpack8(X.rp, rp_); unpack8(X.kc, kc_); unpack8(X.kp, kp_); unpack8(X.om, om_); unpack8(X.aa, av_); \
                float kk_[8], ko_[8], bo_[8], wr_[8]; float ss_ = 0.f, bs_ = 0.f, sbr_ = 0.f, skr_ = 0.f; \
                _Pragma("unroll") for (int i_ = 0; i_ < 8; ++i_) { const float r_ = rc_[i_] + (rp_[i_] - rc_[i_]) * mur[i_]; const float kz_ = kc_[i_] + (kp_[i_] - kc_[i_]) * muk[i_]; \
                    kk_[i_] = kz_ * kkp[i_]; ss_ += kk_[i_] * kk_[i_]; ko_[i_] = kz_ * (1.f + (av_[i_] - 1.f) * kap[i_]); bs_ += r_ * ko_[i_] * rkp[i_]; skr_ += ko_[i_] * r_; \
                    om_[i_] = 1.f - om_[i_]; wr_[i_] = om_[i_] * r_; rc_[i_] = r_; } \
                ss_ += dpp_f<0x141>(ss_); ss_ += dpp_f<0xB1>(ss_); ss_ += dpp_f<0x4E>(ss_); \
                const float inv_ = __builtin_amdgcn_rsqf(fmaxf(ss_, 1e-24f)); \
                _Pragma("unroll") for (int i_ = 0; i_ < 8; ++i_) { const float k2_ = kk_[i_] * inv_; bo_[i_] = k2_ * av_[i_]; sbr_ += bo_[i_] * rc_[i_]; kk_[i_] = -k2_; } \
                bs_ += dpp_f<0x141>(bs_); sbr_ += dpp_f<0x141>(sbr_); skr_ += dpp_f<0x141>(skr_); bs_ += dpp_f<0xB1>(bs_); sbr_ += dpp_f<0xB1>(sbr_); skr_ += dpp_f<0xB1>(skr_); \
                bs_ += dpp_f<0x4E>(bs_); sbr_ += dpp_f<0x4E>(sbr_); skr_ += dpp_f<0x4E>(skr_); \
                SC_ST8(kb_, kk_); SC_ST8(kb_ + 64, wr_); SC_ST8(kb_ + 128, om_); SC_ST8(kb_ + 192, bo_); SC_ST8(kb_ + 256, ko_); \
                if (sg == 0) { *(f32x2*)(BB(bi) + st * 2) = (f32x2){sbr_, skr_}; if (half == 0) BCo[(row0 + (size_t)(c) * TC + st) * 16 + h] = bs_; } \
                if (hv) { float vc_[8], vp_[8]; unpack8(X.vc, vc_); unpack8(X.vp, vp_); _Pragma("unroll") for (int i_ = 0; i_ < 8; ++i_) vc_[i_] += (vp_[i_] - vc_[i_]) * muv[i_]; float* d_ = VB(bi) + lov; SC_ST8(d_, vc_); } } while (0)
#define SC_YOUT(c) do { if (hv) { const float* yp_ = YB((c) & 1) + lov; const f32x4 y0_ = *(const f32x4*)yp_, y1_ = *(const f32x4*)(yp_ + 4); \
                u32x4 o_; o_.x = pk2(y0_.x, y0_.y); o_.y = pk2(y0_.z, y0_.w); o_.z = pk2(y1_.x, y1_.y); o_.w = pk2(y1_.z, y1_.w); *(u32x4*)(yo + (size_t)(c) * TC * D) = o_; } } while (0)
            SC_ISSUE(P, 0); SC_ISSUE(Q, 1); SC_COMMIT(P, 0, 0);
            __syncthreads();
            for (int c = 0; c < NCH; c += 2) {
                if (c + 2 < NCH) SC_ISSUE(P, c + 2);
                if (c > 0) SC_YOUT(c - 1);
                SC_COMMIT(Q, 1, c + 1);
                __syncthreads();
                if (c + 3 < NCH) SC_ISSUE(Q, c + 3);
                SC_YOUT(c);
                if (c + 2 < NCH) SC_COMMIT(P, 0, c + 2);
                __syncthreads();
            }
            SC_YOUT(NCH - 1);
        } else {
            const int kq8 = lane & 7, rowA = w * 8 + (lane >> 3);
            __syncthreads();
            f32x2 S0 = (f32x2){0.f, 0.f}, S1 = S0, S2 = S0, S3 = S0;
            for (int c = 0; c < NCH; ++c) {
                const int bi = c & 1;
                const float* kbp = KB(bi) + kq8 * 8; const float* vbp = VB(bi) + rowA; const float* bbp = BB(bi); float* ybp = YB(bi) + rowA;
#define SC_LOAD(dst, t) do { const float* q_ = kbp + (t) * 320; dst.a0 = *(const f32x4*)q_; dst.a1 = *(const f32x4*)(q_ + 4); dst.q0 = *(const f32x4*)(q_ + 64); dst.q1 = *(const f32x4*)(q_ + 68); \
                dst.w0 = *(const f32x4*)(q_ + 128); dst.w1 = *(const f32x4*)(q_ + 132); dst.b0 = *(const f32x4*)(q_ + 192); dst.b1 = *(const f32x4*)(q_ + 196); dst.k0 = *(const f32x4*)(q_ + 256); dst.k1 = *(const f32x4*)(q_ + 260); \
                dst.v = vbp[(t) * 32]; dst.bk = *(const f32x2*)(bbp + (t) * 2); } while (0)
#define LO2(V_) ((f32x2){(V_).x, (V_).y})
#define HI2(V_) ((f32x2){(V_).z, (V_).w})
                ScanOps o0, o1, o2; SC_LOAD(o0, 0); SC_LOAD(o1, 1);
                float yr = 0.f;
#pragma unroll
                for (int t = 0; t < TC; ++t) {
                    if (t + 2 < TC) SC_LOAD(o2, t + 2);
                    f32x2 pa = S0 * LO2(o0.a0), py = S0 * LO2(o0.q0);
                    pa = __builtin_elementwise_fma(S1, HI2(o0.a0), pa); py = __builtin_elementwise_fma(S1, HI2(o0.q0), py);
                    pa = __builtin_elementwise_fma(S2, LO2(o0.a1), pa); py = __builtin_elementwise_fma(S2, LO2(o0.q1), py);
                    pa = __builtin_elementwise_fma(S3, HI2(o0.a1), pa); py = __builtin_elementwise_fma(S3, HI2(o0.q1), py);
                    float sa = pa.x + pa.y, ys = py.x + py.y;
                    sa += dpp_f<0x141>(sa); ys += dpp_f<0x141>(ys);
                    sa += dpp_f<0xB1>(sa); ys += dpp_f<0xB1>(ys);
                    sa += dpp_f<0x4E>(sa); ys += dpp_f<0x4E>(ys);
                    const f32x2 sa2 = (f32x2){sa, sa}, v2 = (f32x2){o0.v, o0.v};
                    f32x2 t0 = LO2(o0.k0) * v2, t1 = HI2(o0.k0) * v2, t2 = LO2(o0.k1) * v2, t3 = HI2(o0.k1) * v2;
                    t0 = __builtin_elementwise_fma(LO2(o0.b0), sa2, t0); t1 = __builtin_elementwise_fma(HI2(o0.b0), sa2, t1);
                    t2 = __builtin_elementwise_fma(LO2(o0.b1), sa2, t2); t3 = __builtin_elementwise_fma(HI2(o0.b1), sa2, t3);
                    S0 = __builtin_elementwise_fma(S0, LO2(o0.w0), t0); S1 = __builtin_elementwise_fma(S1, HI2(o0.w0), t1);
                    S2 = __builtin_elementwise_fma(S2, LO2(o0.w1), t2); S3 = __builtin_elementwise_fma(S3, HI2(o0.w1), t3);
                    const float y = ys + sa * o0.bk.x + o0.v * o0.bk.y;
                    yr = (kq8 == (t & 7)) ? y : yr;
                    if ((t & 7) == 7) ybp[(t - 7 + kq8) * 32] = yr;
                    o0 = o1; o1 = o2;
                }
                __syncthreads();
            }
        }
    }
    __syncthreads();
}

#define RLX_AGENT __ATOMIC_RELAXED, __HIP_MEMORY_SCOPE_AGENT
#define XB_TMO      128
#define XB_XCNT(j)  (256  + 64 * (j))
#define XB_XSUB(j)  (1280 + 64 * (j))
#define XB_XGEN(j)  (2304 + 64 * (j))
#define XB_TOP      3328
#define XB_TOPGEN   3392
#define XCD_BAR_WORDS 3456
#define XB_SPIN_CAP (1u << 18)

__device__ __forceinline__ unsigned xb_ld(unsigned* p)              { return __hip_atomic_load(p, __ATOMIC_RELAXED, __HIP_MEMORY_SCOPE_AGENT); }
__device__ __forceinline__ unsigned xb_add(unsigned* p, unsigned v) { return __hip_atomic_fetch_add(p, v, __ATOMIC_RELAXED, __HIP_MEMORY_SCOPE_AGENT); }
__device__ __forceinline__ unsigned xb_xcc_id() { return (unsigned)__builtin_amdgcn_s_getreg((3 << 11) | 20) & 0xFu; }
#define XB_SPIN(cond, bar) do { unsigned _sp = 0; while (cond) { __builtin_amdgcn_s_sleep(1); \
    if ((++_sp & 255u) == 0u) { if (xb_ld(&(bar)[XB_TMO])) break; if (_sp > XB_SPIN_CAP) { atomicAdd(&(bar)[XB_TMO], 1u); break; } } } } while (0)

struct XcdBarrier {
    unsigned* bar; unsigned x;
    volatile LAS unsigned* st;
};

__device__ __forceinline__ XcdBarrier xcd_barrier_post(unsigned* bar, volatile LAS unsigned* st) {
    XcdBarrier b; b.bar = bar; b.x = xb_xcc_id(); b.st = st;
    if (threadIdx.x == 0) (void)xb_add(&bar[XB_XCNT(b.x)], 1u);
    return b;
}
__device__ __forceinline__ void xcd_barrier_complete(unsigned* bar, unsigned x, unsigned& nloc, unsigned& nx) {
    const unsigned G = gridDim.x * gridDim.y * gridDim.z;
    unsigned sum, cnt, mine, sp = 0u;
    for (;;) {
        sum = 0u; cnt = 0u; mine = 0u;
#pragma unroll
        for (unsigned j = 0; j < 16; ++j) { const unsigned c = xb_ld(&bar[XB_XCNT(j)]); sum += c; cnt += (c > 0u) ? 1u : 0u; mine = (j == x) ? c : mine; }
        if (sum == G) break;
        __builtin_amdgcn_s_sleep(1);
        if ((++sp & 255u) == 0u) { if (xb_ld(&bar[XB_TMO])) break; if (sp > XB_SPIN_CAP) { atomicAdd(&bar[XB_TMO], 1u); break; } }
    }
    nloc = mine > 0u ? mine : 1u; nx = cnt > 0u ? cnt : 1u;
}

__device__ __forceinline__ void xcd_barrier(const XcdBarrier& b, const int wv) {
    asm volatile("s_waitcnt vmcnt(0)" ::: "memory");
    __syncthreads();
    if (KTID(wv) == 0) {
        unsigned* bar = b.bar;
        __builtin_amdgcn_s_waitcnt(0);
        unsigned nloc = b.st[0], nx = b.st[1];
        if (nloc == 0u) { xcd_barrier_complete(bar, b.x, nloc, nx); b.st[0] = nloc; b.st[1] = nx; }
        const unsigned old = xb_add(&bar[XB_XSUB(b.x)], 1u);
        const unsigned gen = old / nloc;
        if (old + 1u == (gen + 1u) * nloc) {
            __builtin_amdgcn_fence(__ATOMIC_RELEASE, "agent");
            asm volatile("s_waitcnt vmcnt(0)" ::: "memory");
            const unsigned og = xb_add(&bar[XB_TOP], 1u);
            const unsigned tg = og / nx;
            if (og + 1u == (tg + 1u) * nx) xb_add(&bar[XB_TOPGEN], 1u);
            else XB_SPIN(xb_ld(&bar[XB_TOPGEN]) == tg, bar);
            __builtin_amdgcn_fence(__ATOMIC_ACQUIRE, "agent");
            xb_add(&bar[XB_XGEN(b.x)], 1u);
            asm volatile("s_waitcnt vmcnt(0)" ::: "memory");
        } else {
            XB_SPIN(xb_ld(&bar[XB_XGEN(b.x)]) == gen, bar);
            __builtin_amdgcn_fence(__ATOMIC_ACQUIRE, "agent");
            asm volatile("s_waitcnt vmcnt(0)" ::: "memory");
        }
    }
    __syncthreads();
}


__global__ void __launch_bounds__(NT, 2) mk_fwd(Args args) {
    extern __shared__ __attribute__((aligned(16))) unsigned char lds[];
    const int wv = __builtin_amdgcn_readfirstlane((int)threadIdx.x >> 6);
    const int G = gridDim.x, bid = blockIdx.x, NGW = G * NWAVES;
    PG8_LAS unsigned char* glds = (PG8_LAS unsigned char*)lds;
    typedef const __attribute__((address_space(4))) Args* ArgP;
#define PH_ARGS() ArgP ap = (ArgP)__builtin_amdgcn_kernarg_segment_ptr(); asm volatile("" : "+s"(ap)); unsigned char* const ws = ap->ws; (void)ws; \
    const int tid = KTID(wv), lane = tid & 63, wave = wv, gw = bid * NWAVES + wave; (void)lane; (void)gw
#define INP(i) (ap->in[i])
#define WB(off) ((bf16_t*)(ws + (off)))
#define CB(i) ((bf16_t*)(ws + WS_C(i)))
#define D1P ((bf16_t*)ap->out)
#define YSP ((bf16_t*)((unsigned char*)ap->out + CH))
#define X2P ((float*)(ws + WS_C(2)))
#define ATTOP CB(2)
#define OGP YSP
#if MK_MULTI
    const int lo = args.ph_lo, hi = args.ph_hi; int ph = 0;
#define SEAM() do { ++ph; } while (0)
#define SEAM0() SEAM()
#define IN() (lo <= ph && ph < hi)
#else
    cg::grid_group grid = cg::this_grid();
    unsigned* const barw = (unsigned*)args.ws;
    volatile LAS unsigned* const bst = (volatile LAS unsigned*)((LAS unsigned char*)lds + LDS_BYTES - 64);
    { const int t0 = KTID(wv); if (t0 < 2) bst[t0] = 0u; if (bid == 0) for (int i = t0; i < XCD_BAR_WORDS; i += NT) barw[i] = 0u; }
    __syncthreads();
#define XB_MAKE(xb_) XcdBarrier xb_; { ArgP ap_ = (ArgP)__builtin_amdgcn_kernarg_segment_ptr(); asm volatile("" : "+s"(ap_)); xb_.bar = (unsigned*)ap_->ws; xb_.x = xb_xcc_id(); \
        xb_.st = (volatile LAS unsigned*)((LAS unsigned char*)lds + LDS_BYTES - 64); }
#define SEAM0() do { __threadfence(); grid.sync(); XB_MAKE(xb0_); if (KTID(wv) == 0) (void)xb_add(&xb0_.bar[XB_XCNT(xb0_.x)], 1u); } while (0)
#define SEAM() do { XB_MAKE(xb1_); xcd_barrier(xb1_, wv); } while (0)
#define IN() true
#endif
#define PHASE(p) for (int rep_ = 0; IN() && rep_ < 1 + (int)((PROBE_MASK >> (p)) & 1u); ++rep_)

    PHASE(0) {
        PH_ARGS();
        float* scr = (float*)(lds + wave * 16896);
        tr_job(INP(I_F1G), INP(I_F1U), FF, D, WB(WS_WGU1), D, 2 * FF, 1, 0, 0, scr, gw, NGW, lane);
        tr_job(INP(I_F1D), nullptr, D, FF, WB(WS_WD1), FF, D, 0, 0, D, scr, gw, NGW, lane);
        tr_job(INP(I_F2G), INP(I_F2U), FF, D, WB(WS_WGU2), D, 2 * FF, 1, 0, 0, scr, gw, NGW, lane);
        tr_job(INP(I_F2D), nullptr, D, FF, WB(WS_WD2), FF, D, 0, 0, D, scr, gw, NGW, lane);
        tr_job(INP(I_WIN), nullptr, INC, D, WB(WS_WIN), D, 5888, 0, 0, 5664, scr, gw, NGW, lane);
        tr_job(INP(I_WIN), nullptr, INC, D, WB(WS_WIN) + (size_t)5888 * D, D, 2048, 0, 5664, INC, scr, gw, NGW, lane);
        tr_job(INP(I_AUP), nullptr, D, 256, WB(WS_WUP), 256, D, 0, 0, D, scr, gw, NGW, lane);
        tr_job(INP(I_WOUT), nullptr, D, D, WB(WS_WOUT), D, D, 0, 0, D, scr, gw, NGW, lane);
        tr_job(INP(I_WO), nullptr, D, D, WB(WS_WO), D, D, 0, 0, D, scr, gw, NGW, lane);
        tr_job(INP(I_W2), nullptr, D, 64, WB(WS_LW), 128, D, 0, 0, D, scr, gw, NGW, lane);
        tr_job(INP(I_A2), nullptr, D, 64, WB(WS_LA2), 128, D, 0, 0, D, scr, gw, NGW, lane);
        tr_job(INP(I_G2), nullptr, D, 160, WB(WS_LG), 256, D, 0, 0, D, scr, gw, NGW, lane);
        for (int i = bid * NT + tid; i < SEQ * 8; i += G * NT) {
            const int pos = i >> 3, j = i & 7;
            const float invf = powf(500000.0f, -(float)j * 0.125f);
            const float ang = (float)pos * invf;
            double rev = (double)ang * 0.15915494309189535; rev -= rint(rev);
            const float rf = (float)rev;
            ((float*)(ws + WS_ROPE))[pos * 16 + j] = __builtin_amdgcn_cosf(rf); ((float*)(ws + WS_ROPE))[pos * 16 + 8 + j] = __builtin_amdgcn_sinf(rf);
        }
        for (int m = gw; m < M; m += NGW) norm_row(INP(I_X) + (size_t)m * D, nullptr, INP(I_F1N), CB(0) + (size_t)m * D, nullptr, lane);
        for (int i = bid * NT + tid; i < M; i += G * NT) { ((float*)(ws + WS_SS1))[i] = 0.f; ((float*)(ws + WS_SS2))[i] = 0.f; }
    }
    SEAM0();
    PHASE(1) {
        PH_ARGS();
        pg8::Gemm g{CB(0), WB(WS_WGU1), M, 2 * FF, D, D, D}; pg8::StaticOrder S; S.init(M, 2 * FF, G, bid);
        pg8::EpiOp<OpGateUp> E{{CB(1), nullptr}};
        pg8::gemm_phase(glds, g, S, E, wv);
    }
    SEAM();
    PHASE(2) {
        PH_ARGS();
        pg8::Gemm g{CB(1), WB(WS_WD1), M, D, FF, FF, FF}; pg8::StaticOrder S; S.init(M, D, G, bid);
        pg8::EpiOp<OpRes> E{{INP(I_X), nullptr, nullptr, 0.5f, D1P, CB(0), INP(I_MN), ((float*)(ws + WS_SS1))}};
        pg8::gemm_phase(glds, g, S, E, wv);
    }
    SEAM();
    PHASE(4) {
        PH_ARGS();
        { pg8::Gemm g{CB(0), WB(WS_WIN), M, 2304, D, D, D}; pg8::StaticOrder S; S.init(M, 2304, G, bid);
          pg8::EpiOp<OpAttnQKV> E{{CB(1), CB(2), CB(3), ((float*)(ws + WS_ROPE)), ((float*)(ws + WS_SS1))}};
          pg8::gemm_phase(glds, g, S, E, wv); }
        { pg8::Gemm g{CB(0), WB(WS_WIN) + (size_t)2304 * D, M, 3584, D, D, D}; pg8::StaticOrder S; S.init(M, 3584, G, bid);
          pg8::EpiOp<OpRwkvZ> E{{CB(4), CB(5), CB(6), WB(WS_LA), ((float*)(ws + WS_SS1)), WB(WS_HALOLA)}};
          pg8::gemm_phase(glds, g, S, E, wv); }
    }
    SEAM();
    PHASE(5) {
        PH_ARGS(); attn_phase(lds, CB(1), CB(2), CB(3), OGP, (float*)(ws + WS_LSE), G, bid, wv);
        const float* mu = INP(I_MU) + 3072;
        for (int grp = gw; grp < M / 32; grp += NGW) {
            if (lane < 48) {
                const int c0 = lane * 8; bf16_t* base = WB(WS_LA) + (size_t)grp * 32 * LAW + c0;
                if (lane >= 36) { for (int rr = 0; rr < 32; ++rr) *(u32x4*)(base + (size_t)rr * LAW) = (u32x4){0u, 0u, 0u, 0u}; }
                else {
                    float mv[8];
#pragma unroll
                    for (int i = 0; i < 8; ++i) mv[i] = mu[c0 + i];
                    float prev[8];
                    if ((grp & 255) == 0) {
#pragma unroll
                        for (int i = 0; i < 8; ++i) prev[i] = 0.f; }
                    else unpack8(*(const u32x4*)(WB(WS_HALOLA) + (size_t)(grp - 1) * LAW + c0), prev);
                    for (int r8 = 0; r8 < 32; r8 += 8) {
                        u32x4 raw[8];
#pragma unroll
                        for (int j = 0; j < 8; ++j) raw[j] = *(const u32x4*)(base + (size_t)(r8 + j) * LAW);
#pragma unroll
                        for (int j = 0; j < 8; ++j) {
                            float cur[8], o[8]; unpack8(raw[j], cur);
#pragma unroll
                            for (int i = 0; i < 8; ++i) { const float z = cur[i] + (prev[i] - cur[i]) * mv[i];
                                o[i] = c0 < 64 ? (1.f - 2.f * __builtin_amdgcn_rcpf(1.f + __expf(2.f * z))) : (c0 < 128 ? z : sigm(z)); prev[i] = cur[i]; }
                            *(u32x4*)(base + (size_t)(r8 + j) * LAW) = pack8(o);
                        }
                    }
                }
            }
        }
    }
    SEAM();
    PHASE(7) {
        PH_ARGS();
        for (int it = gw; it < M / 2; it += NGW) {
            const int row = it * 2 + (lane >> 5), pc = lane & 31, hg = pc >> 3;
            const float l0 = ((float*)(ws + WS_LSE))[((size_t)0 * M + row) * 4 + hg], l1 = ((float*)(ws + WS_LSE))[((size_t)1 * M + row) * 4 + hg], l2 = ((float*)(ws + WS_LSE))[((size_t)2 * M + row) * 4 + hg];
            const float mx = fmaxf(l0, fmaxf(l1, l2)); float w0 = __expf(l0 - mx), w1 = __expf(l1 - mx), w2 = __expf(l2 - mx);
            const float iw = 1.f / (w0 + w1 + w2); w0 *= iw; w1 *= iw; w2 *= iw;
            float a[8], bb[8], c[8], o[8];
            unpack8(*(const u32x4*)(OGP + ((size_t)0 * M + row) * 256 + pc * 8), a); unpack8(*(const u32x4*)(OGP + ((size_t)1 * M + row) * 256 + pc * 8), bb);
            unpack8(*(const u32x4*)(OGP + ((size_t)2 * M + row) * 256 + pc * 8), c);
#pragma unroll
            for (int i = 0; i < 8; ++i) o[i] = w0 * a[i] + w1 * bb[i] + w2 * c[i];
            *(u32x4*)(ATTOP + (size_t)row * 256 + pc * 8) = pack8(o);
        }
        { pg8::Gemm g{WB(WS_LA), WB(WS_LW), M, D, 128, LAW, 128}; pg8::StaticOrder S; S.init(M, D, G, bid);
          pg8::EpiOp<OpLora<0>> E{{CB(1), INP(I_W0)}};
          pg8::gemm_phase(glds, g, S, E, wv); }
        { pg8::Gemm g{WB(WS_LA) + 64, WB(WS_LA2), M, D, 128, LAW, 128}; pg8::StaticOrder S; S.init(M, D, G, bid);
          pg8::EpiOp<OpLora<1>> E{{CB(3), INP(I_A0)}};
          pg8::gemm_phase(glds, g, S, E, wv); }
    }
    SEAM();
    PHASE(9) { PH_ARGS(); scan_phase(lds, CB(4), CB(1), CB(5), CB(6), CB(3), INP(I_MU), INP(I_KK), INP(I_KA), INP(I_RK), (float*)(ws + WS_BC), YSP, G, bid, wv); }
    SEAM();
    PHASE(10) {
        PH_ARGS();
        { pg8::Gemm g{WB(WS_LA) + 128, WB(WS_LG), M, D, 256, LAW, 256}; pg8::StaticOrder S; S.init(M, D, G, bid);
          pg8::EpiOp<OpStoreBf16> E{{CB(1), D, 1.0f}};
          pg8::gemm_phase(glds, g, S, E, wv); }
    }
    SEAM();
    PHASE(11) {
        PH_ARGS();
        const int r8 = lane >> 3, seg = lane & 7;
        for (int it = gw; it < (M / 8) * 16; it += NGW) {
            const int h = it & 15; const size_t row = (size_t)(it >> 4) * 8 + r8; const int c0 = h * 64 + seg * 8; const size_t off = row * D + c0;
            float yv[8], vv[8], gv[8], o[8];
            unpack8(*(const u32x4*)(YSP + off), yv); unpack8(*(const u32x4*)(CB(6) + off), vv); unpack8(*(const u32x4*)(CB(1) + off), gv);
            { float vp[8]; const u32x4 z4 = (u32x4){0u, 0u, 0u, 0u}; unpack8((row & (SEQ - 1)) == 0 ? z4 : *(const u32x4*)(CB(6) + off - D), vp);
#pragma unroll
              for (int i = 0; i < 8; ++i) vv[i] += (vp[i] - vv[i]) * INP(I_MU)[2048 + c0 + i]; }
            const float bc = ((float*)(ws + WS_BC))[row * 16 + h];
            float s = 0.f;
#pragma unroll
            for (int i = 0; i < 8; ++i) s += yv[i];
            s += __shfl_xor(s, 1); s += __shfl_xor(s, 2); s += __shfl_xor(s, 4);
            const float mean = s * (1.f / 64.f); float q = 0.f;
#pragma unroll
            for (int i = 0; i < 8; ++i) { yv[i] -= mean; q += yv[i] * yv[i]; }
            q += __shfl_xor(q, 1); q += __shfl_xor(q, 2); q += __shfl_xor(q, 4);
            const float rstd = rsqrtf(q * (1.f / 64.f) + GN_EPS);
#pragma unroll
            for (int i = 0; i < 8; ++i) o[i] = (yv[i] * rstd * INP(I_LNW)[c0 + i] + INP(I_LNB)[c0 + i] + bc * vv[i]) * gv[i];
            *(u32x4*)(CB(3) + off) = pack8(o);
        }
    }
    SEAM();
    PHASE(12) {
        PH_ARGS();
        { pg8::Gemm g{CB(0), WB(WS_WIN) + (size_t)5888 * D, M, 2048, D, D, D}; pg8::StaticOrder S; S.init(M, 2048, G, bid);
          pg8::EpiOp<OpGates> E{{CB(4), CB(5), INP(I_GB), ((float*)(ws + WS_SS1))}};
          pg8::gemm_phase(glds, g, S, E, wv); }
        { pg8::Gemm g{ATTOP, WB(WS_WUP), M, D, 256, 256, 256}; pg8::StaticOrder S; S.init(M, D, G, bid);
          pg8::EpiOp<OpStoreBf16> E{{CB(6), D, 1.0f}};
          pg8::gemm_phase(glds, g, S, E, wv); }
    }
    SEAM();
    PHASE(13) {
        PH_ARGS();
        pg8::Gemm g{CB(3), WB(WS_WOUT), M, D, D, D, D}; pg8::StaticOrder S; S.init(M, D, G, bid);
        pg8::EpiOp<OpMerge> E{{CB(4), CB(6), CB(5), CB(1)}};
        pg8::gemm_phase(glds, g, S, E, wv);
    }
    SEAM();
    PHASE(14) {
        PH_ARGS();
        pg8::Gemm g{CB(1), WB(WS_WO), M, D, D, D, D}; pg8::StaticOrder S; S.init(M, D, G, bid);
        pg8::EpiOp<OpRes> E{{INP(I_X), D1P, X2P, 1.0f, nullptr, CB(0), INP(I_F2N), ((float*)(ws + WS_SS2))}};
        pg8::gemm_phase(glds, g, S, E, wv);
    }
    SEAM();
    PHASE(16) {
        PH_ARGS();
        pg8::Gemm g{CB(0), WB(WS_WGU2), M, 2 * FF, D, D, D}; pg8::StaticOrder S; S.init(M, 2 * FF, G, bid);
        pg8::EpiOp<OpGateUp> E{{CB(4), ((float*)(ws + WS_SS2))}};
        pg8::gemm_phase(glds, g, S, E, wv);
    }
    SEAM();
    PHASE(17) {
        PH_ARGS();
        pg8::Gemm g{CB(4), WB(WS_WD2), M, D, FF, FF, FF}; pg8::StaticOrder S; S.init(M, D, G, bid);
        pg8::EpiOp<OpRes> E{{X2P, nullptr, ap->out, 0.5f, nullptr, nullptr, nullptr, nullptr}};
        pg8::gemm_phase(glds, g, S, E, wv);
    }
    SEAM();
    PHASE(18) {
        PH_ARGS();
        for (int m = gw; m < M; m += NGW) norm_row(ap->out + (size_t)m * D, nullptr, INP(I_FN), nullptr, ap->out + (size_t)m * D, lane);
    }
}
constexpr int N_PHASES = 19;

extern "C" void kernel_launch(void* const* d_in, const int* in_sizes, int n_in, void* d_out, int out_size, void* d_ws, size_t ws_size, hipStream_t stream) {
    static int grid = 0;
    if (grid == 0) {
        if (n_in != 27 || in_sizes[0] != M * D || out_size != M * D || ws_size < WS_END) { fprintf(stderr, "kernel_launch: unexpected shapes (n_in %d, in0 %d, out %d, ws %zu)\n", n_in, n_in > 0 ? in_sizes[0] : -1, out_size, ws_size); grid = -1; return; }
        int dev = 0, cus = 0, per_cu = 0;
        hipGetDevice(&dev); hipDeviceGetAttribute(&cus, hipDeviceAttributeMultiprocessorCount, dev);
        if (hipFuncSetAttribute((const void*)mk_fwd, hipFuncAttributeMaxDynamicSharedMemorySize, LDS_BYTES) != hipSuccess) { fprintf(stderr, "kernel_launch: hipFuncSetAttribute failed\n"); grid = -1; return; }
        if (hipOccupancyMaxActiveBlocksPerMultiprocessor(&per_cu, (const void*)mk_fwd, NT, LDS_BYTES) != hipSuccess || per_cu < 1) { fprintf(stderr, "kernel_launch: occupancy query says %d\n", per_cu); per_cu = 1; }
        (void)hipGetLastError();
        grid = cus;
    }
    if (grid < 0) return;
    Args a{};
    for (int i = 0; i < 27; ++i) a.in[i] = (const float*)d_in[i];
    a.out = (float*)d_out; a.ws = (unsigned char*)d_ws;
#if MK_MULTI
    for (int p = 0; p < N_PHASES; ++p) { a.ph_lo = p; a.ph_hi = p + 1; hipLaunchKernelGGL(mk_fwd, dim3(grid), dim3(NT), LDS_BYTES, stream, a); }
#else
    a.ph_lo = 0; a.ph_hi = N_PHASES;
    void* kargs[] = {&a};
    hipError_t e = hipLaunchCooperativeKernel((const void*)mk_fwd, dim3(grid), dim3(NT), kargs, LDS_BYTES, stream);
    if (e != hipSuccess) fprintf(stderr, "kernel_launch: cooperative launch failed: %s (grid %d)\n", hipGetErrorString(e), grid);
#endif
}
```

```cpp
#include <hip/hip_runtime.h>
#include <hip/hip_cooperative_groups.h>
#include <cstdio>
#include <cstdint>
namespace cg = cooperative_groups;

#ifndef MK_MULTI
#define MK_MULTI 0
#endif
#ifndef ATT_REP
#define ATT_REP 1
#endif
#ifndef PROBE_MASK
#define PROBE_MASK 0u
#endif

__device__ __forceinline__ int lane_id_fresh() { int l; asm volatile("v_mbcnt_lo_u32_b32 %0, -1, 0\n\tv_mbcnt_hi_u32_b32 %0, -1, %0" : "=v"(l)); return l; }
#define KTID(wv) ((wv) * 64 + lane_id_fresh())
namespace pg8 {
#define PG8_LAS __attribute__((address_space(3)))
typedef unsigned short bf16_t;
typedef short bf16x8 __attribute__((ext_vector_type(8)));
typedef float f32x4 __attribute__((ext_vector_type(4)));
typedef unsigned u32x4 __attribute__((ext_vector_type(4)));
constexpr int BM = 256, BK = 64, HALF = 128, HTB = HALF * BK * 2, STAGE_BYTES = 8 * HTB, NXCD = 8, WGM = 8;

__host__ __device__ __forceinline__ int lds_byte(int r, int c) { const int st = (r >> 4) * 2 + (c >> 5), rr = r & 15, cc = c & 31, ob = rr * 64 + cc * 2; return st * 1024 + (ob ^ (((ob >> 9) & 1) << 5)); }
__host__ __device__ __forceinline__ void stage_rc(int b, int& R, int& C) { const int st = b / 1024, sb = b % 1024, swz = sb ^ (((sb >> 9) & 1) << 5); R = (st >> 1) * 16 + swz / 64; C = (st & 1) * 32 + (swz % 64) / 2; }
__host__ __device__ __forceinline__ int perm32(int rho) { const int n = rho >> 4, i = rho & 15; return 8 * (i >> 2) + 4 * n + (i & 3); }

struct Unit { int pm, pn; };
struct Gemm { const bf16_t* A; const bf16_t* Bt; int M, N, K, lda, ldb; };

struct StaticOrder {
    int nM, nN, nwg, G, c;
    __host__ __device__ void init(int M, int N, int G_, int c_) { nM = M / BM; nN = N / BM; nwg = nM * nN; G = G_; c = c_; }
    __host__ __device__ bool next(int i, Unit& u) const {
        const long L = (long)i * G + c; if (L >= nwg) return false;
        int wgid = (int)L; { const int q = nwg / NXCD, r = nwg % NXCD, xcd = wgid % NXCD, off = wgid / NXCD; wgid = (xcd < r ? xcd * (q + 1) : r * (q + 1) + (xcd - r) * q) + off; }
        const int nig = WGM * nN, gid = wgid / nig, fm = gid * WGM, gsz = (nM - fm) < WGM ? (nM - fm) : WGM;
        u.pm = fm + ((wgid % nig) % gsz); u.pn = (wgid % nig) / gsz; return true;
    }
};

__device__ __forceinline__ unsigned cvt_pk_bf16(float lo, float hi) { unsigned r; asm volatile("v_cvt_pk_bf16_f32 %0, %1, %2" : "=v"(r) : "v"(lo), "v"(hi)); return r; }

template <class Op> struct EpiOp {
    Op op;
    __device__ __forceinline__ void operator()(const f32x4 (&acc)[2][2][4][2], const Unit& u, int wr, int wc, int fr, int fq) const {
#pragma unroll
        for (int ai = 0; ai < 2; ++ai)
#pragma unroll
            for (int m = 0; m < 4; ++m) {
                const int row = u.pm * BM + ai * HALF + wr * 64 + m * 16 + fr;
                op(acc[ai][0][m][0], acc[ai][0][m][1], acc[ai][1][m][0], acc[ai][1][m][1], row, u.pn, wc, fq);
                asm volatile("" ::: "memory");
            }
    }
};

template <class Epi, class Sched>
__device__ __forceinline__ void gemm_phase(PG8_LAS unsigned char* lds, const Gemm g, const Sched& S, const Epi& E, const int wv) {
    int tid_ = KTID(wv);
    const int tid = tid_, wid = __builtin_amdgcn_readfirstlane(tid >> 6), lane = tid & 63, wr = wid >> 2, wc = wid & 3, fr = lane & 15, fq = lane >> 4;
    const int K = g.K, nt = K / BK;
    unsigned voffA[2], voffB[2];
#pragma unroll
    for (int i = 0; i < 2; ++i) { int R, C; stage_rc(tid * 16 + i * 8192, R, C); const int Rb = (R & ~31) + perm32(R & 31);
        voffA[i] = (unsigned)(R * g.lda + C) * 2u; voffB[i] = (unsigned)(Rb * g.ldb + C) * 2u; }
    const size_t kstep = (size_t)(BK * 2);
    const size_t hstepA = (size_t)HALF * g.lda * 2, hstepB = (size_t)HALF * g.ldb * 2;
    const size_t tstepA = 2 * hstepA, tstepB = 2 * hstepB;
    const unsigned ldsw = (unsigned)wid * 1024u;
    const int aoff = lds_byte(wr * 64 + fr, fq * 8), boff = lds_byte(wc * 32 + fr, fq * 8);
#define PG8_SA(b, h) (((b) * 2 + (h)) * HTB)
#define PG8_SB(b, h) ((4 + (b) * 2 + (h)) * HTB)
#define PG8_STAGE(bufoff, gbase, voff) do { _Pragma("unroll") for (int _i = 0; _i < 2; ++_i) \
        __builtin_amdgcn_global_load_lds((const unsigned*)((const char*)(gbase) + (voff)[_i]), (PG8_LAS unsigned*)(lds + (bufoff) + ldsw + _i * 8192), 16, 0, 0); } while (0)
#define PG8_LDA(dst, b, h) do { _Pragma("unroll") for (int m = 0; m < 4; ++m) _Pragma("unroll") for (int k = 0; k < 2; ++k) dst[m][k] = *(const PG8_LAS bf16x8*)(lds + PG8_SA(b, h) + aoff + m * 2048 + k * 1024); } while (0)
#define PG8_LDB(dst, b, h) do { _Pragma("unroll") for (int n = 0; n < 2; ++n) _Pragma("unroll") for (int k = 0; k < 2; ++k) dst[n][k] = *(const PG8_LAS bf16x8*)(lds + PG8_SB(b, h) + boff + n * 2048 + k * 1024); } while (0)
#define PG8_MMA(ai, bj, At, Bt) do { __builtin_amdgcn_s_setprio(1); _Pragma("unroll") for (int m = 0; m < 4; ++m) _Pragma("unroll") for (int n = 0; n < 2; ++n) _Pragma("unroll") for (int k = 0; k < 2; ++k) \
        acc[ai][bj][m][n] = __builtin_amdgcn_mfma_f32_16x16x32_bf16(Bt[n][k], At[m][k], acc[ai][bj][m][n], 0, 0, 0); __builtin_amdgcn_s_setprio(0); } while (0)
#define PG8_WAIT_V(n) asm volatile("s_waitcnt vmcnt(" #n ")" ::: "memory")
#define PG8_WAIT_L(n) asm volatile("s_waitcnt lgkmcnt(" #n ")" ::: "memory")
#define PG8_BAR __builtin_amdgcn_s_barrier()
#define PG8_SCHED __builtin_amdgcn_sched_barrier(0)
    Unit cur, nxt; int ui = 0;
    if (!S.next(0, cur)) return;
    f32x4 acc[2][2][4][2];
#pragma unroll
    for (int a = 0; a < 2; ++a)
#pragma unroll
        for (int b = 0; b < 2; ++b)
#pragma unroll
            for (int m = 0; m < 4; ++m)
#pragma unroll
                for (int n = 0; n < 2; ++n) acc[a][b][m][n] = (f32x4){0.f, 0.f, 0.f, 0.f};
    bf16x8 At[4][2], B0[2][2], B1[2][2];
    const char* cA = (const char*)g.A + (size_t)cur.pm * tstepA; const char* cB = (const char*)g.Bt + (size_t)cur.pn * tstepB;
    PG8_STAGE(PG8_SB(0, 0), cB, voffB); PG8_STAGE(PG8_SB(0, 1), cB + hstepB, voffB); PG8_STAGE(PG8_SA(0, 0), cA, voffA); PG8_STAGE(PG8_SA(0, 1), cA + hstepA, voffA);
    if (wr == 1) PG8_BAR;
    PG8_WAIT_V(2); PG8_BAR;
    PG8_STAGE(PG8_SB(1, 0), cB + kstep, voffB); PG8_STAGE(PG8_SA(1, 0), cA + kstep, voffA); PG8_STAGE(PG8_SB(1, 1), cB + hstepB + kstep, voffB);
    PG8_WAIT_V(6); PG8_BAR;
    for (;;) {
        const bool has_next = S.next(ui + 1, nxt);
        const char* nA = has_next ? (const char*)g.A + (size_t)nxt.pm * tstepA : cA; const char* nB = has_next ? (const char*)g.Bt + (size_t)nxt.pn * tstepB : cB;
        for (int t = 0; t < nt; t += 2) {
            const bool last = (t == nt - 2);
            const char* a1 = cA + (size_t)(t + 1) * kstep;
            const char* a2 = last ? nA : cA + (size_t)(t + 2) * kstep; const char* b2 = last ? nB : cB + (size_t)(t + 2) * kstep;
            const char* a3 = a2 + kstep; const char* b3 = b2 + kstep;
            PG8_LDB(B0, 0, 0); PG8_LDB(B1, 0, 1); PG8_SCHED; PG8_LDA(At, 0, 0); PG8_STAGE(PG8_SA(1, 1), a1 + hstepA, voffA);
            PG8_WAIT_V(8); PG8_WAIT_L(0); PG8_BAR; PG8_MMA(0, 0, At, B0); PG8_MMA(0, 1, At, B1); PG8_BAR; PG8_SCHED;
            PG8_LDA(At, 0, 1); PG8_STAGE(PG8_SB(0, 0), b2, voffB); PG8_STAGE(PG8_SB(0, 1), b2 + hstepB, voffB); PG8_STAGE(PG8_SA(0, 0), a2, voffA);
            PG8_WAIT_V(8); PG8_WAIT_L(0); PG8_BAR; PG8_MMA(1, 0, At, B0); PG8_MMA(1, 1, At, B1); PG8_BAR; PG8_SCHED;
            PG8_LDB(B0, 1, 0); PG8_LDB(B1, 1, 1); PG8_SCHED; PG8_LDA(At, 1, 0); PG8_STAGE(PG8_SA(0, 1), a2 + hstepA, voffA);
            PG8_WAIT_V(8); PG8_WAIT_L(0); PG8_BAR; PG8_MMA(0, 0, At, B0); PG8_MMA(0, 1, At, B1); PG8_BAR; PG8_SCHED;
            PG8_LDA(At, 1, 1); PG8_STAGE(PG8_SB(1, 0), b3, voffB); PG8_STAGE(PG8_SB(1, 1), b3 + hstepB, voffB); PG8_STAGE(PG8_SA(1, 0), a3, voffA);
            PG8_WAIT_V(8); PG8_WAIT_L(0); PG8_BAR; PG8_MMA(1, 0, At, B0); PG8_MMA(1, 1, At, B1); PG8_BAR; PG8_SCHED;
        }
        if (wr == 0) PG8_BAR;
        { const int le_ = lane_id_fresh(); E(acc, cur, wr, wc, le_ & 15, le_ >> 4); }
        if (!has_next) break;
#pragma unroll
        for (int a = 0; a < 2; ++a)
#pragma unroll
            for (int b = 0; b < 2; ++b)
#pragma unroll
                for (int m = 0; m < 4; ++m)
#pragma unroll
                    for (int n = 0; n < 2; ++n) acc[a][b][m][n] = (f32x4){0.f, 0.f, 0.f, 0.f};
        cur = nxt; cA = nA; cB = nB; ++ui;
        if (wr == 1) PG8_BAR;
    }
    PG8_WAIT_V(0);
    PG8_BAR;
#undef PG8_SA
#undef PG8_SB
#undef PG8_STAGE
#undef PG8_LDA
#undef PG8_LDB
#undef PG8_MMA
#undef PG8_WAIT_V
#undef PG8_WAIT_L
#undef PG8_BAR
#undef PG8_SCHED
}
}

using pg8::bf16_t; using pg8::f32x4; using pg8::u32x4; using pg8::bf16x8;
typedef unsigned u32x2 __attribute__((ext_vector_type(2)));
#define LAS __attribute__((address_space(3)))

constexpr int BATCH = 8, SEQ = 8192, D = 1024, FF = 2816, M = BATCH * SEQ;
constexpr int AW = 768, RS = 3360, INC = 7712;
constexpr int LAW = 384;
constexpr int NWAVES = 8, NT = 512;
constexpr float NORM_EPS = 1e-6f, GN_EPS = 64e-5f;

constexpr size_t MiB = 1u << 20;
constexpr size_t WS_WGU1 = 1 * MiB;
constexpr size_t WS_WD1 = WS_WGU1 + 11 * MiB;
constexpr size_t WS_WGU2 = WS_WD1 + 5 * MiB + MiB / 2;
constexpr size_t WS_WD2 = WS_WGU2 + 11 * MiB;
constexpr size_t WS_WIN = WS_WD2 + 5 * MiB + MiB / 2;
constexpr size_t WS_WUP = WS_WIN + 15 * MiB + MiB / 2;
constexpr size_t WS_WOUT = WS_WUP + MiB / 2;
constexpr size_t WS_WO = WS_WOUT + 2 * MiB;
constexpr size_t WS_LW = WS_WO + 2 * MiB;
constexpr size_t WS_LA2 = WS_LW + MiB / 4;
constexpr size_t WS_LG = WS_LA2 + MiB / 4;
constexpr size_t WS_ROPE = WS_LG + MiB / 2;
static_assert(WS_ROPE + MiB / 2 <= 56 * MiB, "weights region");
constexpr size_t WS_LA = 56 * MiB;
constexpr size_t WS_HALO = 104 * MiB;
constexpr size_t WS_HALOLA = 104 * MiB;
constexpr size_t WS_BC = 111 * MiB;
constexpr size_t WS_LSE = 115 * MiB;
constexpr size_t WS_BRKR = 118 * MiB;
constexpr size_t WS_SS1 = 118 * MiB, WS_SS2 = WS_SS1 + MiB;
constexpr size_t CH = 128 * MiB;
constexpr size_t WS_C0 = 128 * MiB;
#define WS_C(i) (WS_C0 + (size_t)(i) * CH)
constexpr size_t WS_END = 1024 * MiB;
constexpr int LDS_BYTES = 147456;

__device__ __forceinline__ float bf2f(unsigned short h) { return __uint_as_float(((unsigned)h) << 16); }
__device__ __forceinline__ float bflo(unsigned w) { return __uint_as_float(w << 16); }
__device__ __forceinline__ float bfhi(unsigned w) { return __uint_as_float(w & 0xffff0000u); }
__device__ __forceinline__ unsigned pk2(float lo, float hi) { return pg8::cvt_pk_bf16(lo, hi); }
__device__ __forceinline__ void unpack8(const u32x4 w, float (&f)[8]) { f[0] = bflo(w.x); f[1] = bfhi(w.x); f[2] = bflo(w.y); f[3] = bfhi(w.y); f[4] = bflo(w.z); f[5] = bfhi(w.z); f[6] = bflo(w.w); f[7] = bfhi(w.w); }
__device__ __forceinline__ u32x4 pack8(const float (&f)[8]) { u32x4 w; w.x = pk2(f[0], f[1]); w.y = pk2(f[2], f[3]); w.z = pk2(f[4], f[5]); w.w = pk2(f[6], f[7]); return w; }
__device__ __forceinline__ float sigm(float x) { return __builtin_amdgcn_rcpf(1.f + __expf(-x)); }
__device__ __forceinline__ float wave_sum(float v) {
#pragma unroll
    for (int o = 1; o < 64; o <<= 1) v += __shfl_xor(v, o);
    return v;
}

__device__ __forceinline__ float row_rs(const float* ss, int row) { return rsqrtf(ss[row] * (1.f / D) + NORM_EPS); }
struct OpGateUp {
    bf16_t* H; const float* ss;
    __device__ __forceinline__ void operator()(const f32x4 g0_, const f32x4 g1_, const f32x4 u0_, const f32x4 u1_, int row, int pn, int wc, int fq) const {
        const int col = pn * 128 + wc * 32 + 8 * fq; float o[8];
        const float sc = ss ? row_rs(ss, row) : 1.f; const f32x4 g0 = g0_ * sc, g1 = g1_ * sc, u0 = u0_ * sc, u1 = u1_ * sc;
#pragma unroll
        for (int i = 0; i < 4; ++i) { o[i] = g0[i] * sigm(g0[i]) * u0[i]; o[4 + i] = g1[i] * sigm(g1[i]) * u1[i]; }
        *(u32x4*)(H + (size_t)row * FF + col) = pack8(o);
    }
};
struct OpStoreBf16 {
    bf16_t* O; int ld; float scale;
    __device__ __forceinline__ void operator()(const f32x4 a0, const f32x4 a1, const f32x4 b0, const f32x4 b1, int row, int pn, int wc, int fq) const {
        const int col = pn * 256 + wc * 32 + 8 * fq; float o[8];
#pragma unroll
        for (int i = 0; i < 4; ++i) { o[i] = a0[i] * scale; o[4 + i] = a1[i] * scale; }
        *(u32x4*)(O + (size_t)row * ld + col) = pack8(o);
#pragma unroll
        for (int i = 0; i < 4; ++i) { o[i] = b0[i] * scale; o[4 + i] = b1[i] * scale; }
        *(u32x4*)(O + (size_t)row * ld + col + 128) = pack8(o);
    }
};
struct OpRes {
    const float* base; const bf16_t* dlt; float* out; float scale; bf16_t* dout; bf16_t* xg; const float* gain; float* ss;
    __device__ __forceinline__ float half(const f32x4 a0, const f32x4 a1, size_t off, int col) const {
        const float sc_ = scale; f32x4 r0, r1;
#pragma unroll
        for (int i = 0; i < 4; ++i) { r0[i] = a0[i] * sc_; r1[i] = a1[i] * sc_; }
        if (dout) { u32x4 w; w.x = pk2(r0[0], r0[1]); w.y = pk2(r0[2], r0[3]); w.z = pk2(r1[0], r1[1]); w.w = pk2(r1[2], r1[3]); *(u32x4*)(dout + off) = w; }
        if (base) { r0 += *(const f32x4*)(base + off); r1 += *(const f32x4*)(base + off + 4); }
        if (dlt) { float d[8]; unpack8(*(const u32x4*)(dlt + off), d); r0 += (f32x4){d[0], d[1], d[2], d[3]}; r1 += (f32x4){d[4], d[5], d[6], d[7]}; }
        if (out) { *(f32x4*)(out + off) = r0; *(f32x4*)(out + off + 4) = r1; }
        float q = 0.f;
        if (xg) { f32x4 y0 = r0, y1 = r1; if (gain) { y0 *= *(const f32x4*)(gain + col); y1 *= *(const f32x4*)(gain + col + 4); }
            u32x4 w; w.x = pk2(y0[0], y0[1]); w.y = pk2(y0[2], y0[3]); w.z = pk2(y1[0], y1[1]); w.w = pk2(y1[2], y1[3]); *(u32x4*)(xg + off) = w;
            q = (r0[0] * r0[0] + r0[1] * r0[1]) + (r0[2] * r0[2] + r0[3] * r0[3]) + (r1[0] * r1[0] + r1[1] * r1[1]) + (r1[2] * r1[2] + r1[3] * r1[3]); }
        return q;
    }
    __device__ __forceinline__ void operator()(const f32x4 a0, const f32x4 a1, const f32x4 b0, const f32x4 b1, int row, int pn, int wc, int fq) const {
        const int col = pn * 256 + wc * 32 + 8 * fq; const size_t off = (size_t)row * D + col;
        float q = half(a0, a1, off, col) + half(b0, b1, off + 128, col + 128);
        if (xg) { q += __shfl_xor(q, 16); q += __shfl_xor(q, 32); if (fq == 0) atomicAdd(ss + row, q); }
    }
};
struct OpAttnQKV {
    bf16_t* q; bf16_t* k; bf16_t* v; const float* rope; const float* ss;
    __device__ __forceinline__ void half(const f32x4 a0, const f32x4 a1, bf16_t* dst, int row, int wc, int fq, int which) const {
        float o[8];
#pragma unroll
        for (int i = 0; i < 4; ++i) { o[i] = a0[i]; o[4 + i] = a1[i]; }
        if (which < 2 && (wc & 1) == 0) {
            float p[8];
#pragma unroll
            for (int i = 0; i < 8; ++i) p[i] = __shfl_xor(o[i], 16);
            if (fq < 2) {
                const float* cs = rope + (size_t)(row & (SEQ - 1)) * 16;
                const f32x4 c0 = *(const f32x4*)(cs), c1 = *(const f32x4*)(cs + 4), s0 = *(const f32x4*)(cs + 8), s1 = *(const f32x4*)(cs + 12);
                const float sg = fq == 0 ? -1.f : 1.f;
#pragma unroll
                for (int i = 0; i < 4; ++i) { o[i] = o[i] * c0[i] + sg * p[i] * s0[i]; o[4 + i] = o[4 + i] * c1[i] + sg * p[4 + i] * s1[i]; }
            }
        }
        if (which == 0) {
#pragma unroll
            for (int i = 0; i < 8; ++i) o[i] *= 0.125f;
        }
        *(u32x4*)dst = pack8(o);
    }
    __device__ __forceinline__ void operator()(const f32x4 a0, const f32x4 a1, const f32x4 b0, const f32x4 b1, int row, int pn, int wc, int fq) const {
        const int which = pn / 3, col = (pn - which * 3) * 256 + wc * 32 + 8 * fq;
        bf16_t* base = q + (size_t)which * (CH / 2) + (size_t)row * AW + col;
        const float sc = row_rs(ss, row);
        half(a0 * sc, a1 * sc, base, row, wc, fq, which); half(b0 * sc, b1 * sc, base + 128, row, wc, fq, which);
    }
};
struct OpRwkvZ {
    bf16_t* r; bf16_t* k; bf16_t* v; bf16_t* la; const float* ss; bf16_t* halola;
    __device__ __forceinline__ void operator()(const f32x4 a0, const f32x4 a1, const f32x4 b0, const f32x4 b1, int row, int pn, int wc, int fq) const {
        float o0[8], o1[8]; const float sc = row_rs(ss, row);
#pragma unroll
        for (int i = 0; i < 4; ++i) { o0[i] = a0[i] * sc; o0[4 + i] = a1[i] * sc; o1[i] = b0[i] * sc; o1[4 + i] = b1[i] * sc; }
        const u32x4 w0 = pack8(o0), w1 = pack8(o1);
        const bool hrow = (row & 31) == 31;
        if (pn < 12) {
            const int s = pn >> 2, col = (pn & 3) * 256 + wc * 32 + 8 * fq;
            bf16_t* dst = r + (size_t)s * (CH / 2) + (size_t)row * D + col;
            *(u32x4*)dst = w0; *(u32x4*)(dst + 128) = w1;
        } else {
            const int col = (pn - 12) * 256 + wc * 32 + 8 * fq;
            if (col < 288) { *(u32x4*)(la + (size_t)row * LAW + col) = w0; if (hrow) *(u32x4*)(halola + (size_t)(row >> 5) * LAW + col) = w0; }
            if (col + 128 < 288) { *(u32x4*)(la + (size_t)row * LAW + col + 128) = w1; if (hrow) *(u32x4*)(halola + (size_t)(row >> 5) * LAW + col + 128) = w1; }
        }
    }
};
struct OpGates {
    unsigned char* g8; const float* bias; const float* ss;
    __device__ __forceinline__ u32x2 q8(const f32x4 a0, const f32x4 a1, const float* bp, float sc) const {
        const f32x4 c0 = *(const f32x4*)bp, c1 = *(const f32x4*)(bp + 4); unsigned b[8];
#pragma unroll
        for (int i = 0; i < 4; ++i) { b[i] = (unsigned)(sigm(a0[i] * sc + c0[i]) * 255.f + 0.5f); b[4 + i] = (unsigned)(sigm(a1[i] * sc + c1[i]) * 255.f + 0.5f); }
        u32x2 w; w.x = b[0] | (b[1] << 8) | (b[2] << 16) | (b[3] << 24); w.y = b[4] | (b[5] << 8) | (b[6] << 16) | (b[7] << 24); return w;
    }
    __device__ __forceinline__ void operator()(const f32x4 a0, const f32x4 a1, const f32x4 b0, const f32x4 b1, int row, int pn, int wc, int fq) const {
        const int s = pn >> 2, col = (pn & 3) * 256 + wc * 32 + 8 * fq; const float* bp = bias + s * 1024 + col;
        unsigned char* dst = g8 + (size_t)s * ((size_t)M * D) + (size_t)row * D + col; const float sc = row_rs(ss, row);
        *(u32x2*)dst = q8(a0, a1, bp, sc); *(u32x2*)(dst + 128) = q8(b0, b1, bp + 128, sc);
    }
};
template <int MODE> struct OpLora {
    bf16_t* O; const float* p0;
    __device__ __forceinline__ float f(float x) const { const float s = sigm(x); return MODE == 0 ? 1.f - __expf(-0.60653065971f * s) : s; }
    __device__ __forceinline__ void operator()(const f32x4 a0, const f32x4 a1, const f32x4 b0, const f32x4 b1, int row, int pn, int wc, int fq) const {
        const int col = pn * 256 + wc * 32 + 8 * fq; const float* bp = p0 + col; bf16_t* dst = O + (size_t)row * D + col; float o[8];
        { const f32x4 c0 = *(const f32x4*)bp, c1 = *(const f32x4*)(bp + 4);
#pragma unroll
          for (int i = 0; i < 4; ++i) { o[i] = f(a0[i] + c0[i]); o[4 + i] = f(a1[i] + c1[i]); }
          *(u32x4*)dst = pack8(o); }
        { const f32x4 c0 = *(const f32x4*)(bp + 128), c1 = *(const f32x4*)(bp + 132);
#pragma unroll
          for (int i = 0; i < 4; ++i) { o[i] = f(b0[i] + c0[i]); o[4 + i] = f(b1[i] + c1[i]); }
          *(u32x4*)(dst + 128) = pack8(o); }
    }
};
struct OpMerge {
    const unsigned char* g8; const bf16_t* ya; bf16_t* out;
    __device__ __forceinline__ void half(const f32x4 a0, const f32x4 a1, size_t off) const {
        const u32x2 ga = *(const u32x2*)(g8 + off), gr = *(const u32x2*)(g8 + (size_t)M * D + off);
        float Y[8], o[8]; unpack8(*(const u32x4*)(ya + off), Y);
        const float k = 1.f / 255.f;
#pragma unroll
        for (int i = 0; i < 4; ++i) {
            const float A0 = (float)((ga.x >> (8 * i)) & 0xffu) * k, A1 = (float)((ga.y >> (8 * i)) & 0xffu) * k;
            const float R0 = (float)((gr.x >> (8 * i)) & 0xffu) * k, R1 = (float)((gr.y >> (8 * i)) & 0xffu) * k;
            o[i] = A0 * Y[i] + R0 * a0[i]; o[4 + i] = A1 * Y[4 + i] + R1 * a1[i];
        }
        *(u32x4*)(out + off) = pack8(o);
    }
    __device__ __forceinline__ void operator()(const f32x4 a0, const f32x4 a1, const f32x4 b0, const f32x4 b1, int row, int pn, int wc, int fq) const {
        const size_t off = (size_t)row * D + pn * 256 + wc * 32 + 8 * fq;
        half(a0, a1, off); half(b0, b1, off + 128);
    }
};

struct Args {
    const float* in[27]; float* out; unsigned char* ws; int ph_lo, ph_hi;
};
enum { I_X = 0, I_F1N, I_F1G, I_F1U, I_F1D, I_MN, I_WIN, I_GB, I_AUP, I_MU, I_W0, I_W2, I_A0, I_A2, I_G2, I_KK, I_KA, I_RK, I_LNW, I_LNB, I_WOUT, I_WO, I_F2N, I_F2G, I_F2U, I_F2D, I_FN };

__device__ __forceinline__ void tr_job(const float* W0, const float* W1, int ldw, int Ksrc, bf16_t* WT, int ldt, int nrows, int mode, int coff, int climit,
                                       float* scr, int gw, int NGW, int lane, const float* ksc = nullptr) {
    const int nblk = nrows / 64, nitems = (ldt / 64) * nblk;
    for (int it = gw; it < nitems; it += NGW) {
        const int kb = it / nblk, nb = it % nblk, k0 = 64 * kb;
        const float* Wh[2]; int ch[2]; bool vh[2];
#pragma unroll
        for (int hh = 0; hh < 2; ++hh) {
            const int nb32 = 2 * nb + hh;
            if (mode == 0) { ch[hh] = coff + 32 * nb32; vh[hh] = ch[hh] < climit; Wh[hh] = W0; }
            else { const int tile = nb32 >> 3, j0 = (nb32 & 7) * 32; Wh[hh] = j0 < 128 ? W0 : W1; ch[hh] = tile * 128 + (j0 & 127); vh[hh] = true; }
        }
        const int r4 = lane >> 4, pc = lane & 15, hsel = pc >> 3;
        const float* Wsel = hsel ? Wh[1] : Wh[0]; const int csel = (hsel ? ch[1] : ch[0]) + (pc & 7) * 4; const bool vsel = hsel ? vh[1] : vh[0];
        f32x4 v[16];
#pragma unroll
        for (int i = 0; i < 16; ++i) { const int k = k0 + 4 * i + r4; v[i] = (vsel && k < Ksrc) ? *(const f32x4*)(Wsel + (size_t)k * ldw + csel) : (f32x4){0.f, 0.f, 0.f, 0.f}; if (ksc && k < Ksrc) v[i] *= ksc[k]; }
#pragma unroll
        for (int i = 0; i < 16; ++i) { float* d = scr + (4 * i + r4) * 65 + pc * 4; d[0] = v[i].x; d[1] = v[i].y; d[2] = v[i].z; d[3] = v[i].w; }
        __builtin_amdgcn_s_waitcnt(0); asm volatile("" ::: "memory");
        const int c = lane & 7;
#pragma unroll
        for (int j = 0; j < 8; ++j) { const int n = (lane >> 3) + 8 * j; const float* sp = scr + (8 * c) * 65 + n;
            u32x4 o; o.x = pk2(sp[0 * 65], sp[1 * 65]); o.y = pk2(sp[2 * 65], sp[3 * 65]); o.z = pk2(sp[4 * 65], sp[5 * 65]); o.w = pk2(sp[6 * 65], sp[7 * 65]);
            *(u32x4*)(WT + (size_t)(64 * nb + n) * ldt + k0 + 8 * c) = o; }
        __builtin_amdgcn_s_waitcnt(0); asm volatile("" ::: "memory");
    }
}
__device__ __forceinline__ void norm_row(const float* xrow, const bf16_t* drow, const float* gain, bf16_t* orow, float* frow, int lane) {
    f32x4 v[4]; float s = 0.f;
#pragma unroll
    for (int j = 0; j < 4; ++j) {
        v[j] = *((const f32x4*)xrow + lane + 64 * j);
        if (drow) { const u32x2 w = *((const u32x2*)drow + lane + 64 * j); v[j] += (f32x4){bflo(w.x), bfhi(w.x), bflo(w.y), bfhi(w.y)}; }
        s += (v[j].x * v[j].x + v[j].y * v[j].y) + (v[j].z * v[j].z + v[j].w * v[j].w);
    }
    const float inv = rsqrtf(wave_sum(s) * (1.f / D) + NORM_EPS);
#pragma unroll
    for (int j = 0; j < 4; ++j) {
        const f32x4 gn = *((const f32x4*)gain + lane + 64 * j); const f32x4 o = v[j] * inv * gn;
        if (orow) { u32x2 w; w.x = pk2(o.x, o.y); w.y = pk2(o.z, o.w); *((u32x2*)orow + lane + 64 * j) = w; }
        else *((f32x4*)frow + lane + 64 * j) = o;
    }
}

__device__ __forceinline__ void norm_row2(const float* xb, const float* gain, bf16_t* ob, float* fb, int m0, int m1, int lane) {
    f32x4 v0[4], v1[4]; float s0 = 0.f, s1 = 0.f; const bool two = m1 < M;
#pragma unroll
    for (int j = 0; j < 4; ++j) { v0[j] = *((const f32x4*)(xb + (size_t)m0 * D) + lane + 64 * j); v1[j] = two ? *((const f32x4*)(xb + (size_t)m1 * D) + lane + 64 * j) : (f32x4){0.f, 0.f, 0.f, 0.f}; }
#pragma unroll
    for (int j = 0; j < 4; ++j) { s0 += (v0[j].x * v0[j].x + v0[j].y * v0[j].y) + (v0[j].z * v0[j].z + v0[j].w * v0[j].w); s1 += (v1[j].x * v1[j].x + v1[j].y * v1[j].y) + (v1[j].z * v1[j].z + v1[j].w * v1[j].w); }
#pragma unroll
    for (int o = 1; o < 64; o <<= 1) { s0 += __shfl_xor(s0, o); s1 += __shfl_xor(s1, o); }
    const float i0 = rsqrtf(s0 * (1.f / D) + NORM_EPS), i1 = rsqrtf(s1 * (1.f / D) + NORM_EPS);
#pragma unroll
    for (int j = 0; j < 4; ++j) {
        const f32x4 gn = *((const f32x4*)gain + lane + 64 * j); const f32x4 o0 = v0[j] * i0 * gn, o1 = v1[j] * i1 * gn;
        if (ob) { u32x2 w0; w0.x = pk2(o0.x, o0.y); w0.y = pk2(o0.z, o0.w); *((u32x2*)(ob + (size_t)m0 * D) + lane + 64 * j) = w0;
                  if (two) { u32x2 w1; w1.x = pk2(o1.x, o1.y); w1.y = pk2(o1.z, o1.w); *((u32x2*)(ob + (size_t)m1 * D) + lane + 64 * j) = w1; } }
        else { *((f32x4*)(fb + (size_t)m0 * D) + lane + 64 * j) = o0; if (two) *((f32x4*)(fb + (size_t)m1 * D) + lane + 64 * j) = o1; }
    }
}
struct AttnUnit { int b, h, g, hg, d, r, i; };
__device__ __forceinline__ AttnUnit attn_decode(int u) {
    AttnUnit a; const int rb = u & 63, bh = u >> 6; a.h = bh % 12; a.b = bh / 12; a.g = a.h >> 2; a.hg = a.h & 3;
    const int dsh = 2 * a.g, nb = 64 >> dsh; a.d = 1 << dsh; a.r = rb / nb; a.i = rb % nb; return a;
}
__device__ __forceinline__ void attn_unit_compute(const bf16_t* Ks, const bf16_t* Vt, const bf16x8 (&qf)[2], bf16_t* Og, float* lse, const size_t rowq, const int g, const int hg, const int i, const int w, const int fr, const int fq) {
        f32x4 s[9];
#pragma unroll
        for (int tt = 0; tt < 9; ++tt) {
            const int T = w + tt;
            f32x4 a = (f32x4){0.f, 0.f, 0.f, 0.f};
            if (i > 0 || T >= 8) {
                const bf16x8 k0 = *(const bf16x8*)(Ks + (16 * T + fr) * 72 + fq * 8), k1 = *(const bf16x8*)(Ks + (16 * T + fr) * 72 + 32 + fq * 8);
                a = __builtin_amdgcn_mfma_f32_16x16x32_bf16(k0, qf[0], a, 0, 0, 0);
                a = __builtin_amdgcn_mfma_f32_16x16x32_bf16(k1, qf[1], a, 0, 0, 0);
            }
            s[tt] = a;
        }
        const int le = 4 * fq - fr; float mx = -INFINITY;
#pragma unroll
        for (int tt = 0; tt < 9; ++tt) {
            const bool tile_ok = (i > 0) || (w + tt >= 8);
#pragma unroll
            for (int e = 0; e < 4; ++e) {
                bool valid = tile_ok;
                if (tt == 0) valid = valid && (le + e >= 0);
                if (tt == 8) valid = valid && (le + e <= 0);
                s[tt][e] = valid ? s[tt][e] : -INFINITY; mx = fmaxf(mx, s[tt][e]);
            }
        }
        mx = fmaxf(mx, __shfl_xor(mx, 16)); mx = fmaxf(mx, __shfl_xor(mx, 32));
        float l = 0.f;
#pragma unroll
        for (int tt = 0; tt < 9; ++tt)
#pragma unroll
            for (int e = 0; e < 4; ++e) { const float p = __expf(s[tt][e] - mx); s[tt][e] = p; l += p; }
        l += __shfl_xor(l, 16); l += __shfl_xor(l, 32);
        f32x4 o[4];
#pragma unroll
        for (int dt = 0; dt < 4; ++dt) o[dt] = (f32x4){0.f, 0.f, 0.f, 0.f};
#pragma unroll
        for (int s2 = 0; s2 < 5; ++s2) {
            const int T0 = w + 2 * s2, T1 = s2 < 4 ? T0 + 1 : T0;
            if (i == 0 && s2 < 4 && T1 < 8) continue;
            union { bf16x8 v; unsigned u[4]; } pf;
            pf.u[0] = pk2(s[2 * s2][0], s[2 * s2][1]); pf.u[1] = pk2(s[2 * s2][2], s[2 * s2][3]);
            if (s2 < 4) { pf.u[2] = pk2(s[2 * s2 + 1][0], s[2 * s2 + 1][1]); pf.u[3] = pk2(s[2 * s2 + 1][2], s[2 * s2 + 1][3]); } else { pf.u[2] = 0u; pf.u[3] = 0u; }
#pragma unroll
            for (int dt = 0; dt < 4; ++dt) {
                union { bf16x8 v; u32x2 h[2]; } vf;
                vf.h[0] = *(const u32x2*)(Vt + (16 * dt + fr) * 264 + 16 * T0 + 4 * fq);
                vf.h[1] = *(const u32x2*)(Vt + (16 * dt + fr) * 264 + 16 * T1 + 4 * fq);
                o[dt] = __builtin_amdgcn_mfma_f32_16x16x32_bf16(vf.v, pf.v, o[dt], 0, 0, 0);
            }
        }
        const float il = 1.f / l;
        bf16_t* op = Og + ((size_t)g * M + rowq) * 256 + hg * 64 + 4 * fq;
#pragma unroll
        for (int dt = 0; dt < 4; ++dt) { u32x2 wv; wv.x = pk2(o[dt][0] * il, o[dt][1] * il); wv.y = pk2(o[dt][2] * il, o[dt][3] * il); *(u32x2*)(op + 16 * dt) = wv; }
        if (fq == 0) lse[((size_t)g * M + rowq) * 4 + hg] = mx + __logf(l);
}
__device__ __forceinline__ void attn_phase(unsigned char* lds, const bf16_t* Q, const bf16_t* K, const bf16_t* V, bf16_t* Og, float* lse, int G, int bid, const int wv) {
    bf16_t* Ks = (bf16_t*)lds;
    bf16_t* Vt = (bf16_t*)(lds + 36864);
    int tid_ = KTID(wv);
    const int tid = tid_, w = tid >> 6, lane = tid & 63, fr = lane & 15, fq = lane >> 4;
    constexpr int NU = ATT_REP * BATCH * 12 * 64;
    u32x4 kA[4], vA[4], kB[4], vB[4]; bf16x8 qA[2], qB[2];
#define ATT_LOAD(kr_, vr_, qr_, uu) do { const AttnUnit n_ = attn_decode((uu) % (BATCH * 12 * 64)); const size_t br_ = (size_t)n_.b * SEQ; \
        _Pragma("unroll") for (int c_ = 0; c_ < 4; ++c_) { const int p_ = tid + 512 * c_; \
            { const int key_ = p_ >> 3, seg_ = p_ & 7, l_ = 128 * (n_.i - 1) + key_; kr_[c_] = (u32x4){0u, 0u, 0u, 0u}; \
              if (l_ >= 0) kr_[c_] = *(const u32x4*)(K + (br_ + (size_t)l_ * n_.d + n_.r) * AW + n_.h * 64 + seg_ * 8); } \
            { const int seg_ = p_ >> 8, key_ = p_ & 255, l_ = 128 * (n_.i - 1) + key_; vr_[c_] = (u32x4){0u, 0u, 0u, 0u}; \
              if (l_ >= 0) vr_[c_] = *(const u32x4*)(V + (br_ + (size_t)l_ * n_.d + n_.r) * AW + n_.h * 64 + seg_ * 8); } } \
        { const size_t rq_ = br_ + (size_t)(128 * n_.i + 16 * w + fr) * n_.d + n_.r; \
          _Pragma("unroll") for (int ks_ = 0; ks_ < 2; ++ks_) qr_[ks_] = *(const bf16x8*)(Q + rq_ * AW + n_.h * 64 + ks_ * 32 + fq * 8); } } while (0)
#define ATT_BODY(kr_, vr_, qr_, ucur, unext) do { \
        const AttnUnit U = attn_decode((ucur) % (BATCH * 12 * 64)); \
        const int g = U.g, hg = U.hg, d = U.d, r = U.r, i = U.i; const size_t brow = (size_t)U.b * SEQ; \
        __syncthreads(); \
        _Pragma("unroll") for (int c = 0; c < 4; ++c) { const int p = tid + 512 * c; \
            *(u32x4*)(Ks + (p >> 3) * 72 + (p & 7) * 8) = kr_[c]; \
            const u32x4 val = vr_[c]; bf16_t* vp = Vt + ((p >> 8) * 8) * 264 + (p & 255); \
            vp[0 * 264] = (bf16_t)(val.x & 0xffffu); vp[1 * 264] = (bf16_t)(val.x >> 16); vp[2 * 264] = (bf16_t)(val.y & 0xffffu); vp[3 * 264] = (bf16_t)(val.y >> 16); \
            vp[4 * 264] = (bf16_t)(val.z & 0xffffu); vp[5 * 264] = (bf16_t)(val.z >> 16); vp[6 * 264] = (bf16_t)(val.w & 0xffffu); vp[7 * 264] = (bf16_t)(val.w >> 16); } \
        const size_t rowq = brow + (size_t)(128 * i + 16 * w + fr) * d + r; \
        bf16x8 qf[2]; qf[0] = qr_[0]; qf[1] = qr_[1]; \
        if ((unext) < NU) ATT_LOAD(kr_, vr_, qr_, (unext)); \
        __syncthreads(); \
        attn_unit_compute(Ks, Vt, qf, Og, lse, rowq, g, hg, i, w, fr, fq); } while (0)
    if (bid < NU) ATT_LOAD(kA, vA, qA, bid);
    if (bid + G < NU) ATT_LOAD(kB, vB, qB, bid + G);
    for (int u_ = bid; u_ < NU; u_ += 2 * G) {
        ATT_BODY(kA, vA, qA, u_, u_ + 2 * G);
        if (u_ + G < NU) ATT_BODY(kB, vB, qB, u_ + G, u_ + 3 * G);
    }
    __syncthreads();
}

template <int CTRL> __device__ __forceinline__ float dpp_f(float x) { return __builtin_bit_cast(float, __builtin_amdgcn_update_dpp(0, __builtin_bit_cast(int, x), CTRL, 0xf, 0xf, true)); }
__device__ __forceinline__ float row16_sum(float x) { x += dpp_f<0x128>(x); x += dpp_f<0x124>(x); x += dpp_f<0x122>(x); x += dpp_f<0x121>(x); return x; }
constexpr int TC = 32;
constexpr int SC_BUF = TC * 4 * 64 * 4 + 256;
constexpr int SC_V = TC * 32 * 4;
typedef float f32x2 __attribute__((ext_vector_type(2)));
struct ScanOps { f32x4 a0, a1, q0, q1, b0, b1, k0, k1; float kr, v; };
__device__ __forceinline__ void scan_phase(unsigned char* lds, const bf16_t* Rz, const bf16_t* LAp, const bf16_t* Kz, const bf16_t* Vz, const bf16_t* Lwp, const bf16_t* Lap, const float* w0p, const float* a0p, const float* mu, const float* pkk, const float* pka, const float* prk, float* BCo, bf16_t* Y, int G, int bid, const int wv) {
    int tid_ = KTID(wv);
    const int tid = tid_, w = __builtin_amdgcn_readfirstlane(tid >> 6), lane = tid & 63, kq = lane & 15, rw = lane >> 4;
    float* const kb0 = (float*)lds; float* const vb0 = (float*)(lds + 2 * SC_BUF); float* const yb0 = (float*)(lds + 2 * SC_BUF + 2 * SC_V);
    float* const bb0 = (float*)(lds + 2 * SC_BUF + 4 * SC_V);
    float* const xb0 = (float*)(lds + 2 * SC_BUF + 4 * SC_V + 2 * TC * 8);
#define KB(bi) (kb0 + (bi) * (SC_BUF / 4))
#define VB(bi) (vb0 + (bi) * (SC_V / 4))
#define YB(bi) (yb0 + (bi) * (SC_V / 4))
#define BB(bi) (bb0 + (bi) * (TC * 2))
#define XB(bi, m) (xb0 + ((bi) * 2 + (m)) * (TC * 68))
    constexpr int NCH = SEQ / TC;
    for (int u = bid; u < BATCH * 16 * 2; u += G) {
        const int half = u & 1, h = (u >> 1) & 15, b = u >> 5;
        const size_t row0 = (size_t)b * SEQ;
        __syncthreads();
        if (w >= 4) {
            const int hw = w - 4, fr = lane & 15, fq = lane >> 4;
            bf16x8 Bw[2], Ba[2];
#pragma unroll
            for (int ks = 0; ks < 2; ++ks) { Bw[ks] = *(const bf16x8*)(Lwp + (size_t)(h * 64 + 16 * hw + fr) * 128 + 32 * ks + 8 * fq); Ba[ks] = *(const bf16x8*)(Lap + (size_t)(h * 64 + 16 * hw + fr) * 128 + 32 * ks + 8 * fq); }
            const float bw0 = w0p[h * 64 + 16 * hw + fr], ba0 = a0p[h * 64 + 16 * hw + fr];
            const int ht = tid - 256, st = ht >> 3, sg = ht & 7;
            const size_t goff = (row0 + st) * D + h * 64 + sg * 8;
            const int lo = st * 256 + sg * 8;
            const bool hv = ht < 128;
            const size_t voff = (row0 + (ht >> 2)) * D + h * 64 + half * 32 + (ht & 3) * 8; const int lov = (ht >> 2) * 32 + (ht & 3) * 8;
            bf16_t* yo = Y + voff;
            const int cc0 = h * 64 + sg * 8, cv0 = 2048 + h * 64 + half * 32 + (ht & 3) * 8;
            struct HReg { u32x4 rc, rp, kc, kp, vc, vp; };
            HReg P, Q; P.vc = (u32x4){0u, 0u, 0u, 0u}; P.vp = P.vc; Q.vc = P.vc; Q.vp = P.vc;
            const u32x4 z4 = (u32x4){0u, 0u, 0u, 0u};
#define SC_ISSUE(X, c) do { const size_t o_ = (size_t)(c) * TC * D; const bool first_ = ((c) == 0 && st == 0); \
                X.rc = *(const u32x4*)(Rz + goff + o_); X.kc = *(const u32x4*)(Kz + goff + o_); \
                X.rp = first_ ? z4 : *(const u32x4*)(Rz + goff + o_ - D); X.kp = first_ ? z4 : *(const u32x4*)(Kz + goff + o_ - D); \
                if (hv) { X.vc = *(const u32x4*)(Vz + voff + o_); X.vp = ((c) == 0 && ht < 4) ? z4 : *(const u32x4*)(Vz + voff + o_ - D); } } while (0)
#define SC_ST8(dst, f) do { *(f32x4*)(dst) = (f32x4){f[0], f[1], f[2], f[3]}; *(f32x4*)((dst) + 4) = (f32x4){f[4], f[5], f[6], f[7]}; } while (0)
#define SC_COMMIT(X, bi, c) do { float rc_[8], rp_[8], kc_[8], kp_[8], pt_[8], pp_[8], av_[8]; float* kb_ = KB(bi) + lo; \
                int ci_ = cc0; asm volatile("" : "+v"(ci_));     \
                float mur[8], muk[8], kkp[8], kap[8], rkp[8]; \
                { const f32x4 a_ = *(const f32x4*)(mu + ci_), b_ = *(const f32x4*)(mu + ci_ + 4); mur[0] = a_.x; mur[1] = a_.y; mur[2] = a_.z; mur[3] = a_.w; mur[4] = b_.x; mur[5] = b_.y; mur[6] = b_.z; mur[7] = b_.w; } \
                { const f32x4 a_ = *(const f32x4*)(mu + 1024 + ci_), b_ = *(const f32x4*)(mu + 1024 + ci_ + 4); muk[0] = a_.x; muk[1] = a_.y; muk[2] = a_.z; muk[3] = a_.w; muk[4] = b_.x; muk[5] = b_.y; muk[6] = b_.z; muk[7] = b_.w; } \
                { const f32x4 a_ = *(const f32x4*)(pkk + ci_), b_ = *(const f32x4*)(pkk + ci_ + 4); kkp[0] = a_.x; kkp[1] = a_.y; kkp[2] = a_.z; kkp[3] = a_.w; kkp[4] = b_.x; kkp[5] = b_.y; kkp[6] = b_.z; kkp[7] = b_.w; } \
                { const f32x4 a_ = *(const f32x4*)(pka + ci_), b_ = *(const f32x4*)(pka + ci_ + 4); kap[0] = a_.x; kap[1] = a_.y; kap[2] = a_.z; kap[3] = a_.w; kap[4] = b_.x; kap[5] = b_.y; kap[6] = b_.z; kap[7] = b_.w; } \
                { const f32x4 a_ = *(const f32x4*)(prk + ci_), b_ = *(const f32x4*)(prk + ci_ + 4); rkp[0] = a_.x; rkp[1] = a_.y; rkp[2] = a_.z; rkp[3] = a_.w; rkp[4] = b_.x; rkp[5] = b_.y; rkp[6] = b_.z; rkp[7] = b_.w; } \
                unpack8(X.rc, rc_); unpack8(X.rp, rp_); unpack8(X.kc, kc_); unpack8(X.kp, kp_); \
                { const float* x0_ = XB(bi, 0) + st * 68 + sg * 8; const float* x1_ = XB(bi, 1) + st * 68 + sg * 8; const f32x4 p0_ = *(const f32x4*)x0_, p1_ = *(const f32x4*)(x0_ + 4), q0_ = *(const f32x4*)x1_, q1_ = *(const f32x4*)(x1_ + 4); \
                  pt_[0] = p0_.x; pt_[1] = p0_.y; pt_[2] = p0_.z; pt_[3] = p0_.w; pt_[4] = p1_.x; pt_[5] = p1_.y; pt_[6] = p1_.z; pt_[7] = p1_.w; \
                  av_[0] = q0_.x; av_[1] = q0_.y; av_[2] = q0_.z; av_[3] = q0_.w; av_[4] = q1_.x; av_[5] = q1_.y; av_[6] = q1_.z; av_[7] = q1_.w; \
                  if (st > 0) { const f32x4 r0_ = *(const f32x4*)(x0_ - 68), r1_ = *(const f32x4*)(x0_ - 64); pp_[0] = r0_.x; pp_[1] = r0_.y; pp_[2] = r0_.z; pp_[3] = r0_.w; pp_[4] = r1_.x; pp_[5] = r1_.y; pp_[6] = r1_.z; pp_[7] = r1_.w; } \
                  else { _Pragma("unroll") for (int i_ = 0; i_ < 8; ++i_) pp_[i_] = 1.f; } } \
                float kk_[8], ko_[8], bo_[8], qq_[8]; float ss_ = 0.f, bs_ = 0.f, sbr_ = 0.f, skr_ = 0.f; \
                _Pragma("unroll") for (int i_ = 0; i_ < 8; ++i_) { const float r_ = rc_[i_] + (rp_[i_] - rc_[i_]) * mur[i_]; const float kz_ = kc_[i_] + (kp_[i_] - kc_[i_]) * muk[i_]; \
                    kk_[i_] = kz_ * kkp[i_]; ss_ += kk_[i_] * kk_[i_]; ko_[i_] = kz_ * (1.f + (av_[i_] - 1.f) * kap[i_]); bs_ += r_ * ko_[i_] * rkp[i_]; skr_ += ko_[i_] * r_; rc_[i_] = r_; } \
                ss_ += dpp_f<0x141>(ss_); ss_ += dpp_f<0xB1>(ss_); ss_ += dpp_f<0x4E>(ss_); \
                const float inv_ = __builtin_amdgcn_rsqf(fmaxf(ss_, 1e-24f)); \
                _Pragma("unroll") for (int i_ = 0; i_ < 8; ++i_) { const float k2_ = kk_[i_] * inv_; bo_[i_] = k2_ * av_[i_]; sbr_ += bo_[i_] * rc_[i_]; kk_[i_] = -k2_ * pp_[i_]; }     \
                bs_ += dpp_f<0x141>(bs_); sbr_ += dpp_f<0x141>(sbr_); skr_ += dpp_f<0x141>(skr_); bs_ += dpp_f<0xB1>(bs_); sbr_ += dpp_f<0xB1>(sbr_); skr_ += dpp_f<0xB1>(skr_); \
                bs_ += dpp_f<0x4E>(bs_); sbr_ += dpp_f<0x4E>(sbr_); skr_ += dpp_f<0x4E>(skr_); \
                  \
                _Pragma("unroll") for (int i_ = 0; i_ < 8; ++i_) { qq_[i_] = pt_[i_] * rc_[i_] + sbr_ * kk_[i_]; const float ip_ = __builtin_amdgcn_rcpf(pt_[i_]); bo_[i_] *= ip_; ko_[i_] *= ip_; } \
                SC_ST8(kb_, kk_); SC_ST8(kb_ + 64, qq_); SC_ST8(kb_ + 128, bo_); SC_ST8(kb_ + 192, ko_); \
                if (st == TC - 1) { float* pe_ = KB(bi) + TC * 256 + sg * 8; SC_ST8(pe_, pt_); }     \
                if (sg == 0) { BB(bi)[st] = skr_; if (half == 0) BCo[(row0 + (size_t)(c) * TC + st) * 16 + h] = bs_; } \
                if (hv) { float vc_[8], vp_[8], muv[8]; { int cv_ = cv0; asm volatile("" : "+v"(cv_)); const f32x4 a_ = *(const f32x4*)(mu + cv_), b_ = *(const f32x4*)(mu + cv_ + 4); muv[0] = a_.x; muv[1] = a_.y; muv[2] = a_.z; muv[3] = a_.w; muv[4] = b_.x; muv[5] = b_.y; muv[6] = b_.z; muv[7] = b_.w; } unpack8(X.vc, vc_); unpack8(X.vp, vp_); _Pragma("unroll") for (int i_ = 0; i_ < 8; ++i_) vc_[i_] += (vp_[i_] - vc_[i_]) * muv[i_]; float* d_ = VB(bi) + lov; SC_ST8(d_, vc_); } } while (0)
#define SC_YOUT(c) do { if (hv) { const float* yp_ = YB((c) & 1) + lov; const f32x4 y0_ = *(const f32x4*)yp_, y1_ = *(const f32x4*)(yp_ + 4); \
                u32x4 o_; o_.x = pk2(y0_.x, y0_.y); o_.y = pk2(y0_.z, y0_.w); o_.z = pk2(y1_.x, y1_.y); o_.w = pk2(y1_.z, y1_.w); *(u32x4*)(yo + (size_t)(c) * TC * D) = o_; } } while (0)
#define SC_MM(c) do { const bf16_t* la_ = LAp + (row0 + (size_t)(c) * TC + fr) * LAW + 8 * fq; float* xw_ = XB((c) & 1, 0) + (4 * fq) * 68 + 16 * hw + fr; float* xa_ = XB((c) & 1, 1) + (4 * fq) * 68 + 16 * hw + fr; \
                float run_ = 1.f;     \
                _Pragma("unroll") for (int mt_ = 0; mt_ < 2; ++mt_) { \
                    const bf16x8 aw0_ = *(const bf16x8*)(la_ + (size_t)(16 * mt_) * LAW), aw1_ = *(const bf16x8*)(la_ + (size_t)(16 * mt_) * LAW + 32), \
                                 aa0_ = *(const bf16x8*)(la_ + (size_t)(16 * mt_) * LAW + 64), aa1_ = *(const bf16x8*)(la_ + (size_t)(16 * mt_) * LAW + 96); \
                    f32x4 dw_ = (f32x4){0.f, 0.f, 0.f, 0.f}, da_ = dw_; \
                    dw_ = __builtin_amdgcn_mfma_f32_16x16x32_bf16(aw0_, Bw[0], dw_, 0, 0, 0); dw_ = __builtin_amdgcn_mfma_f32_16x16x32_bf16(aw1_, Bw[1], dw_, 0, 0, 0); \
                    da_ = __builtin_amdgcn_mfma_f32_16x16x32_bf16(aa0_, Ba[0], da_, 0, 0, 0); da_ = __builtin_amdgcn_mfma_f32_16x16x32_bf16(aa1_, Ba[1], da_, 0, 0, 0); \
                      \
                    float p_[4]; \
                    _Pragma("unroll") for (int i_ = 0; i_ < 4; ++i_) { const float w_ = __expf(-0.60653065971f * sigm(dw_[i_] + bw0)); p_[i_] = i_ ? p_[i_ - 1] * w_ : w_; } \
                      \
                    float x_ = p_[3]; { const float y_ = __shfl_up(x_, 16); if (fq >= 1) x_ *= y_; } { const float y_ = __shfl_up(x_, 32); if (fq >= 2) x_ *= y_; } \
                    float ex_ = __shfl_up(x_, 16); if (fq == 0) ex_ = 1.f; ex_ *= run_; \
                    _Pragma("unroll") for (int i_ = 0; i_ < 4; ++i_) { xw_[(16 * mt_ + i_) * 68] = p_[i_] * ex_; xa_[(16 * mt_ + i_) * 68] = sigm(da_[i_] + ba0); } \
                    run_ *= __shfl(x_, 48 + fr);     } } while (0)
            SC_ISSUE(P, 0); SC_ISSUE(Q, 1); SC_MM(0); SC_MM(1);
            __syncthreads();
            SC_COMMIT(P, 0, 0);
            __syncthreads();
            for (int c = 0; c < NCH; c += 2) {
                if (c + 2 < NCH) SC_ISSUE(P, c + 2);
                if (c > 0) SC_YOUT(c - 1);
                if (c + 2 < NCH) SC_MM(c + 2);
                SC_COMMIT(Q, 1, c + 1);
                __syncthreads();
                if (c + 3 < NCH) SC_ISSUE(Q, c + 3);
                SC_YOUT(c);
                if (c + 3 < NCH) SC_MM(c + 3);
                if (c + 2 < NCH) SC_COMMIT(P, 0, c + 2);
                __syncthreads();
            }
            SC_YOUT(NCH - 1);
        } else {
            const int kq8 = lane & 7, rowA = w * 8 + (lane >> 3);
            __syncthreads();
            __syncthreads();
            f32x2 S0 = (f32x2){0.f, 0.f}, S1 = S0, S2 = S0, S3 = S0;
            for (int c = 0; c < NCH; ++c) {
                const int bi = c & 1;
                const float* kbp = KB(bi) + kq8 * 8; const float* vbp = VB(bi) + rowA; const float* bbp = BB(bi); float* ybp = YB(bi) + rowA;
#define SC_LOAD(dst, t) do { const float* q_ = kbp + (t) * 256; dst.a0 = *(const f32x4*)q_; dst.a1 = *(const f32x4*)(q_ + 4); dst.q0 = *(const f32x4*)(q_ + 64); dst.q1 = *(const f32x4*)(q_ + 68); \
                dst.b0 = *(const f32x4*)(q_ + 128); dst.b1 = *(const f32x4*)(q_ + 132); dst.k0 = *(const f32x4*)(q_ + 192); dst.k1 = *(const f32x4*)(q_ + 196); \
                dst.v = vbp[(t) * 32]; dst.kr = bbp[(t)]; } while (0)
#define LO2(V_) ((f32x2){(V_).x, (V_).y})
#define HI2(V_) ((f32x2){(V_).z, (V_).w})
                ScanOps o0, o1, o2; SC_LOAD(o0, 0); SC_LOAD(o1, 1);
                float yr = 0.f;
#pragma unroll
                for (int t = 0; t < TC; ++t) {
                    if (t + 2 < TC) SC_LOAD(o2, t + 2);
                    f32x2 pa = S0 * LO2(o0.a0), py = S0 * LO2(o0.q0);
                    pa = __builtin_elementwise_fma(S1, HI2(o0.a0), pa); py = __builtin_elementwise_fma(S1, HI2(o0.q0), py);
                    pa = __builtin_elementwise_fma(S2, LO2(o0.a1), pa); py = __builtin_elementwise_fma(S2, LO2(o0.q1), py);
                    pa = __builtin_elementwise_fma(S3, HI2(o0.a1), pa); py = __builtin_elementwise_fma(S3, HI2(o0.q1), py);
                    float sa = pa.x + pa.y, ys = py.x + py.y;
                    sa += dpp_f<0x141>(sa); ys += dpp_f<0x141>(ys);
                    sa += dpp_f<0xB1>(sa); ys += dpp_f<0xB1>(ys);
                    sa += dpp_f<0x4E>(sa); ys += dpp_f<0x4E>(ys);
                    const f32x2 sa2 = (f32x2){sa, sa}, v2 = (f32x2){o0.v, o0.v};
                    S0 = __builtin_elementwise_fma(LO2(o0.k0), v2, S0); S1 = __builtin_elementwise_fma(HI2(o0.k0), v2, S1);
                    S2 = __builtin_elementwise_fma(LO2(o0.k1), v2, S2); S3 = __builtin_elementwise_fma(HI2(o0.k1), v2, S3);
                    S0 = __builtin_elementwise_fma(LO2(o0.b0), sa2, S0); S1 = __builtin_elementwise_fma(HI2(o0.b0), sa2, S1);
                    S2 = __builtin_elementwise_fma(LO2(o0.b1), sa2, S2); S3 = __builtin_elementwise_fma(HI2(o0.b1), sa2, S3);
                    const float y = ys + o0.v * o0.kr;
                    yr = (kq8 == (t & 7)) ? y : yr;
                    if ((t & 7) == 7) ybp[(t - 7 + kq8) * 32] = yr;
                    o0 = o1; o1 = o2;
                }
                { const float* pe = KB(bi) + TC * 256 + kq8 * 8; const f32x4 e0 = *(const f32x4*)pe, e1 = *(const f32x4*)(pe + 4);
                  S0 *= LO2(e0); S1 *= HI2(e0); S2 *= LO2(e1); S3 *= HI2(e1); }
                __syncthreads();
            }
        }
    }
    __syncthreads();
}

#define RLX_AGENT __ATOMIC_RELAXED, __HIP_MEMORY_SCOPE_AGENT
#define XB_TMO      128
#define XB_XCNT(j)  (256  + 64 * (j))
#define XB_XSUB(j)  (1280 + 64 * (j))
#define XB_XGEN(j)  (2304 + 64 * (j))
#define XB_TOP      3328
#define XB_TOPGEN   3392
#define XCD_BAR_WORDS 3456
#define XB_SPIN_CAP (1u << 18)

__device__ __forceinline__ unsigned xb_ld(unsigned* p)              { return __hip_atomic_load(p, __ATOMIC_RELAXED, __HIP_MEMORY_SCOPE_AGENT); }
__device__ __forceinline__ unsigned xb_add(unsigned* p, unsigned v) { return __hip_atomic_fetch_add(p, v, __ATOMIC_RELAXED, __HIP_MEMORY_SCOPE_AGENT); }
__device__ __forceinline__ unsigned xb_xcc_id() { return (unsigned)__builtin_amdgcn_s_getreg((3 << 11) | 20) & 0xFu; }
#define XB_SPIN(cond, bar) do { unsigned _sp = 0; while (cond) { __builtin_amdgcn_s_sleep(1); \
    if ((++_sp & 255u) == 0u) { if (xb_ld(&(bar)[XB_TMO])) break; if (_sp > XB_SPIN_CAP) { atomicAdd(&(bar)[XB_TMO], 1u); break; } } } } while (0)

struct XcdBarrier {
    unsigned* bar; unsigned x;
    volatile LAS unsigned* st;
};

__device__ __forceinline__ XcdBarrier xcd_barrier_post(unsigned* bar, volatile LAS unsigned* st) {
    XcdBarrier b; b.bar = bar; b.x = xb_xcc_id(); b.st = st;
    if (threadIdx.x == 0) (void)xb_add(&bar[XB_XCNT(b.x)], 1u);
    return b;
}
__device__ __forceinline__ void xcd_barrier_complete(unsigned* bar, unsigned x, unsigned& nloc, unsigned& nx) {
    const unsigned G = gridDim.x * gridDim.y * gridDim.z;
    unsigned sum, cnt, mine, sp = 0u;
    for (;;) {
        sum = 0u; cnt = 0u; mine = 0u;
#pragma unroll
        for (unsigned j = 0; j < 16; ++j) { const unsigned c = xb_ld(&bar[XB_XCNT(j)]); sum += c; cnt += (c > 0u) ? 1u : 0u; mine = (j == x) ? c : mine; }
        if (sum == G) break;
        __builtin_amdgcn_s_sleep(1);
        if ((++sp & 255u) == 0u) { if (xb_ld(&bar[XB_TMO])) break; if (sp > XB_SPIN_CAP) { atomicAdd(&bar[XB_TMO], 1u); break; } }
    }
    nloc = mine > 0u ? mine : 1u; nx = cnt > 0u ? cnt : 1u;
}

__device__ __forceinline__ void xcd_barrier(const XcdBarrier& b, const int wv) {
    asm volatile("s_waitcnt vmcnt(0)" ::: "memory");
    __syncthreads();
    if (KTID(wv) == 0) {
        unsigned* bar = b.bar;
        __builtin_amdgcn_s_waitcnt(0);
        unsigned nloc = b.st[0], nx = b.st[1];
        if (nloc == 0u) { xcd_barrier_complete(bar, b.x, nloc, nx); b.st[0] = nloc; b.st[1] = nx; }
        const unsigned old = xb_add(&bar[XB_XSUB(b.x)], 1u);
        const unsigned gen = old / nloc;
        if (old + 1u == (gen + 1u) * nloc) {
            __builtin_amdgcn_fence(__ATOMIC_RELEASE, "agent");
            asm volatile("s_waitcnt vmcnt(0)" ::: "memory");
            const unsigned og = xb_add(&bar[XB_TOP], 1u);
            const unsigned tg = og / nx;
            if (og + 1u == (tg + 1u) * nx) xb_add(&bar[XB_TOPGEN], 1u);
            else XB_SPIN(xb_ld(&bar[XB_TOPGEN]) == tg, bar);
            __builtin_amdgcn_fence(__ATOMIC_ACQUIRE, "agent");
            xb_add(&bar[XB_XGEN(b.x)], 1u);
            asm volatile("s_waitcnt vmcnt(0)" ::: "memory");
        } else {
            XB_SPIN(xb_ld(&bar[XB_XGEN(b.x)]) == gen, bar);
            __builtin_amdgcn_fence(__ATOMIC_ACQUIRE, "agent");
            asm volatile("s_waitcnt vmcnt(0)" ::: "memory");
        }
    }
    __syncthreads();
}


__global__ void __launch_bounds__(NT, 2) mk_fwd(Args args) {
    extern __shared__ __attribute__((aligned(16))) unsigned char lds[];
    const int wv = __builtin_amdgcn_readfirstlane((int)threadIdx.x >> 6);
    const int G = gridDim.x, bid = blockIdx.x, NGW = G * NWAVES;
    PG8_LAS unsigned char* glds = (PG8_LAS unsigned char*)lds;
    typedef const __attribute__((address_space(4))) Args* ArgP;
#define PH_ARGS() ArgP ap = (ArgP)__builtin_amdgcn_kernarg_segment_ptr(); asm volatile("" : "+s"(ap)); unsigned char* const ws = ap->ws; (void)ws; \
    const int tid = KTID(wv), lane = tid & 63, wave = wv, gw = bid * NWAVES + wave; (void)lane; (void)gw
#define INP(i) (ap->in[i])
#define WB(off) ((bf16_t*)(ws + (off)))
#define CB(i) ((bf16_t*)(ws + WS_C(i)))
#define D1P ((bf16_t*)ap->out)
#define YSP ((bf16_t*)((unsigned char*)ap->out + CH))
#define X2P ((float*)(ws + WS_C(1)))
#define ATTOP CB(2)
#define OGP YSP
#if MK_MULTI
    const int lo = args.ph_lo, hi = args.ph_hi; int ph = 0;
#define SEAM() do { ++ph; } while (0)
#define SEAM0() SEAM()
#define IN() (lo <= ph && ph < hi)
#else
    cg::grid_group grid = cg::this_grid();
    unsigned* const barw = (unsigned*)args.ws;
    volatile LAS unsigned* const bst = (volatile LAS unsigned*)((LAS unsigned char*)lds + LDS_BYTES - 64);
    { const int t0 = KTID(wv); if (t0 < 2) bst[t0] = 0u; if (bid == 0) for (int i = t0; i < XCD_BAR_WORDS; i += NT) barw[i] = 0u; }
    __syncthreads();
#define XB_MAKE(xb_) XcdBarrier xb_; { ArgP ap_ = (ArgP)__builtin_amdgcn_kernarg_segment_ptr(); asm volatile("" : "+s"(ap_)); xb_.bar = (unsigned*)ap_->ws; xb_.x = xb_xcc_id(); \
        xb_.st = (volatile LAS unsigned*)((LAS unsigned char*)lds + LDS_BYTES - 64); }
#define SEAM0() do { __threadfence(); grid.sync(); XB_MAKE(xb0_); if (KTID(wv) == 0) (void)xb_add(&xb0_.bar[XB_XCNT(xb0_.x)], 1u); } while (0)
#define SEAM() do { XB_MAKE(xb1_); xcd_barrier(xb1_, wv); } while (0)
#define IN() true
#endif
#define PHASE(p) for (int rep_ = 0; IN() && rep_ < 1 + (int)((PROBE_MASK >> (p)) & 1u); ++rep_)

    PHASE(0) {
        PH_ARGS();
        float* scr = (float*)(lds + wave * 16896);
        tr_job(INP(I_F1G), INP(I_F1U), FF, D, WB(WS_WGU1), D, 2 * FF, 1, 0, 0, scr, gw, NGW, lane);
        tr_job(INP(I_F1D), nullptr, D, FF, WB(WS_WD1), FF, D, 0, 0, D, scr, gw, NGW, lane);
        tr_job(INP(I_F2G), INP(I_F2U), FF, D, WB(WS_WGU2), D, 2 * FF, 1, 0, 0, scr, gw, NGW, lane, INP(I_F2N));
        tr_job(INP(I_F2D), nullptr, D, FF, WB(WS_WD2), FF, D, 0, 0, D, scr, gw, NGW, lane);
        tr_job(INP(I_WIN), nullptr, INC, D, WB(WS_WIN), D, 5888, 0, 0, 5664, scr, gw, NGW, lane, INP(I_MN));
        tr_job(INP(I_WIN), nullptr, INC, D, WB(WS_WIN) + (size_t)5888 * D, D, 2048, 0, 5664, INC, scr, gw, NGW, lane, INP(I_MN));
        tr_job(INP(I_AUP), nullptr, D, 256, WB(WS_WUP), 256, D, 0, 0, D, scr, gw, NGW, lane);
        tr_job(INP(I_WOUT), nullptr, D, D, WB(WS_WOUT), D, D, 0, 0, D, scr, gw, NGW, lane);
        tr_job(INP(I_WO), nullptr, D, D, WB(WS_WO), D, D, 0, 0, D, scr, gw, NGW, lane);
        tr_job(INP(I_W2), nullptr, D, 64, WB(WS_LW), 128, D, 0, 0, D, scr, gw, NGW, lane);
        tr_job(INP(I_A2), nullptr, D, 64, WB(WS_LA2), 128, D, 0, 0, D, scr, gw, NGW, lane);
        tr_job(INP(I_G2), nullptr, D, 160, WB(WS_LG), 256, D, 0, 0, D, scr, gw, NGW, lane);
        for (int i = bid * NT + tid; i < SEQ * 8; i += G * NT) {
            const int pos = i >> 3, j = i & 7;
            const float invf = powf(500000.0f, -(float)j * 0.125f);
            const float ang = (float)pos * invf;
            double rev = (double)ang * 0.15915494309189535; rev -= rint(rev);
            const float rf = (float)rev;
            ((float*)(ws + WS_ROPE))[pos * 16 + j] = __builtin_amdgcn_cosf(rf); ((float*)(ws + WS_ROPE))[pos * 16 + 8 + j] = __builtin_amdgcn_sinf(rf);
        }
        for (int m = gw; m < M; m += 2 * NGW) norm_row2(INP(I_X), INP(I_F1N), CB(0), nullptr, m, m + NGW, lane);
        for (int i = bid * NT + tid; i < M; i += G * NT) { ((float*)(ws + WS_SS1))[i] = 0.f; ((float*)(ws + WS_SS2))[i] = 0.f; }
    }
    SEAM0();
    PHASE(1) {
        PH_ARGS();
        pg8::Gemm g{CB(0), WB(WS_WGU1), M, 2 * FF, D, D, D}; pg8::StaticOrder S; S.init(M, 2 * FF, G, bid);
        pg8::EpiOp<OpGateUp> E{{CB(1), nullptr}};
        pg8::gemm_phase(glds, g, S, E, wv);
    }
    SEAM();
    PHASE(2) {
        PH_ARGS();
        pg8::Gemm g{CB(1), WB(WS_WD1), M, D, FF, FF, FF}; pg8::StaticOrder S; S.init(M, D, G, bid);
        pg8::EpiOp<OpRes> E{{INP(I_X), nullptr, nullptr, 0.5f, nullptr, CB(0), nullptr, ((float*)(ws + WS_SS1))}};
        pg8::gemm_phase(glds, g, S, E, wv);
    }
    SEAM();
    PHASE(4) {
        PH_ARGS();
        { pg8::Gemm g{CB(0), WB(WS_WIN), M, 2304, D, D, D}; pg8::StaticOrder S; S.init(M, 2304, G, bid);
          pg8::EpiOp<OpAttnQKV> E{{CB(1), CB(2), CB(3), ((float*)(ws + WS_ROPE)), ((float*)(ws + WS_SS1))}};
          pg8::gemm_phase(glds, g, S, E, wv); }
        { pg8::Gemm g{CB(0), WB(WS_WIN) + (size_t)2304 * D, M, 3584, D, D, D}; pg8::StaticOrder S; S.init(M, 3584, G, bid);
          pg8::EpiOp<OpRwkvZ> E{{CB(4), CB(5), CB(6), WB(WS_LA), ((float*)(ws + WS_SS1)), WB(WS_HALOLA)}};
          pg8::gemm_phase(glds, g, S, E, wv); }
    }
    SEAM();
    PHASE(5) {
        PH_ARGS(); attn_phase(lds, CB(1), CB(2), CB(3), OGP, (float*)(ws + WS_LSE), G, bid, wv);
        const float* mu = INP(I_MU) + 3072;
        for (int grp = gw; grp < M / 32; grp += NGW) {
            if (lane < 48) {
                const int c0 = lane * 8; bf16_t* base = WB(WS_LA) + (size_t)grp * 32 * LAW + c0;
                if (lane >= 36) { for (int rr = 0; rr < 32; ++rr) *(u32x4*)(base + (size_t)rr * LAW) = (u32x4){0u, 0u, 0u, 0u}; }
                else {
                    float mv[8];
#pragma unroll
                    for (int i = 0; i < 8; ++i) mv[i] = mu[c0 + i];
                    float prev[8];
                    if ((grp & 255) == 0) {
#pragma unroll
                        for (int i = 0; i < 8; ++i) prev[i] = 0.f; }
                    else unpack8(*(const u32x4*)(WB(WS_HALOLA) + (size_t)(grp - 1) * LAW + c0), prev);
                    for (int r8 = 0; r8 < 32; r8 += 8) {
                        u32x4 raw[8];
#pragma unroll
                        for (int j = 0; j < 8; ++j) raw[j] = *(const u32x4*)(base + (size_t)(r8 + j) * LAW);
#pragma unroll
                        for (int j = 0; j < 8; ++j) {
                            float cur[8], o[8]; unpack8(raw[j], cur);
#pragma unroll
                            for (int i = 0; i < 8; ++i) { const float z = cur[i] + (prev[i] - cur[i]) * mv[i];
                                o[i] = c0 < 64 ? (1.f - 2.f * __builtin_amdgcn_rcpf(1.f + __expf(2.f * z))) : (c0 < 128 ? z : sigm(z)); prev[i] = cur[i]; }
                            *(u32x4*)(base + (size_t)(r8 + j) * LAW) = pack8(o);
                        }
                    }
                }
            }
        }
    }
    SEAM();
    PHASE(9) { PH_ARGS(); scan_phase(lds, CB(4), WB(WS_LA), CB(5), CB(6), WB(WS_LW), WB(WS_LA2), INP(I_W0), INP(I_A0), INP(I_MU), INP(I_KK), INP(I_KA), INP(I_RK), (float*)(ws + WS_BC), CB(1), G, bid, wv); }
    PHASE(10) {
        PH_ARGS();
        for (int it = gw; it < M / 2; it += NGW) {
            const int row = it * 2 + (lane >> 5), pc = lane & 31, hg = pc >> 3;
            const float l0 = ((float*)(ws + WS_LSE))[((size_t)0 * M + row) * 4 + hg], l1 = ((float*)(ws + WS_LSE))[((size_t)1 * M + row) * 4 + hg], l2 = ((float*)(ws + WS_LSE))[((size_t)2 * M + row) * 4 + hg];
            const float mx = fmaxf(l0, fmaxf(l1, l2)); float w0 = __expf(l0 - mx), w1 = __expf(l1 - mx), w2 = __expf(l2 - mx);
            const float iw = 1.f / (w0 + w1 + w2); w0 *= iw; w1 *= iw; w2 *= iw;
            float a[8], bb[8], c[8], o[8];
            unpack8(*(const u32x4*)(OGP + ((size_t)0 * M + row) * 256 + pc * 8), a); unpack8(*(const u32x4*)(OGP + ((size_t)1 * M + row) * 256 + pc * 8), bb);
            unpack8(*(const u32x4*)(OGP + ((size_t)2 * M + row) * 256 + pc * 8), c);
#pragma unroll
            for (int i = 0; i < 8; ++i) o[i] = w0 * a[i] + w1 * bb[i] + w2 * c[i];
            *(u32x4*)(ATTOP + (size_t)row * 256 + pc * 8) = pack8(o);
        }
        { pg8::Gemm g{WB(WS_LA) + 128, WB(WS_LG), M, D, 256, LAW, 256}; pg8::StaticOrder S; S.init(M, D, G, bid);
          pg8::EpiOp<OpStoreBf16> E{{CB(3), D, 1.0f}};
          pg8::gemm_phase(glds, g, S, E, wv); }
    }
    SEAM();
    PHASE(11) {
        PH_ARGS();
        const int r8 = lane >> 3, seg = lane & 7;
        for (int it = gw; it < (M / 8) * 16; it += NGW) {
            const int h = it & 15; const size_t row = (size_t)(it >> 4) * 8 + r8; const int c0 = h * 64 + seg * 8; const size_t off = row * D + c0;
            float yv[8], vv[8], gv[8], o[8];
            unpack8(*(const u32x4*)(CB(1) + off), yv); unpack8(*(const u32x4*)(CB(6) + off), vv); unpack8(*(const u32x4*)(CB(3) + off), gv);
            { float vp[8]; const u32x4 z4 = (u32x4){0u, 0u, 0u, 0u}; unpack8((row & (SEQ - 1)) == 0 ? z4 : *(const u32x4*)(CB(6) + off - D), vp);
#pragma unroll
              for (int i = 0; i < 8; ++i) vv[i] += (vp[i] - vv[i]) * INP(I_MU)[2048 + c0 + i]; }
            const float bc = ((float*)(ws + WS_BC))[row * 16 + h];
            float s = 0.f;
#pragma unroll
            for (int i = 0; i < 8; ++i) s += yv[i];
            s += __shfl_xor(s, 1); s += __shfl_xor(s, 2); s += __shfl_xor(s, 4);
            const float mean = s * (1.f / 64.f); float q = 0.f;
#pragma unroll
            for (int i = 0; i < 8; ++i) { yv[i] -= mean; q += yv[i] * yv[i]; }
            q += __shfl_xor(q, 1); q += __shfl_xor(q, 2); q += __shfl_xor(q, 4);
            const float rstd = rsqrtf(q * (1.f / 64.f) + GN_EPS);
#pragma unroll
            for (int i = 0; i < 8; ++i) o[i] = (yv[i] * rstd * INP(I_LNW)[c0 + i] + INP(I_LNB)[c0 + i] + bc * vv[i]) * gv[i];
            *(u32x4*)(CB(4) + off) = pack8(o);
        }
    }
    PHASE(12) {
        PH_ARGS();
        { pg8::Gemm g{CB(0), WB(WS_WIN) + (size_t)5888 * D, M, 2048, D, D, D}; pg8::StaticOrder S; S.init(M, 2048, G, bid);
          pg8::EpiOp<OpGates> E{{(unsigned char*)CB(5), INP(I_GB), ((float*)(ws + WS_SS1))}};
          pg8::gemm_phase(glds, g, S, E, wv); }
        { pg8::Gemm g{ATTOP, WB(WS_WUP), M, D, 256, 256, 256}; pg8::StaticOrder S; S.init(M, D, G, bid);
          pg8::EpiOp<OpStoreBf16> E{{YSP, D, 1.0f}};
          pg8::gemm_phase(glds, g, S, E, wv); }
    }
    SEAM();
    PHASE(13) {
        PH_ARGS();
        pg8::Gemm g{CB(4), WB(WS_WOUT), M, D, D, D, D}; pg8::StaticOrder S; S.init(M, D, G, bid);
        pg8::EpiOp<OpMerge> E{{(const unsigned char*)CB(5), YSP, CB(3)}};
        pg8::gemm_phase(glds, g, S, E, wv);
    }
    SEAM();
    PHASE(14) {
        PH_ARGS();
        pg8::Gemm g{CB(3), WB(WS_WO), M, D, D, D, D}; pg8::StaticOrder S; S.init(M, D, G, bid);
        pg8::EpiOp<OpRes> E{{nullptr, CB(0), nullptr, 1.0f, nullptr, CB(0), nullptr, ((float*)(ws + WS_SS2))}};
        pg8::gemm_phase(glds, g, S, E, wv);
    }
    SEAM();
    PHASE(16) {
        PH_ARGS();
        pg8::Gemm g{CB(0), WB(WS_WGU2), M, 2 * FF, D, D, D}; pg8::StaticOrder S; S.init(M, 2 * FF, G, bid);
        pg8::EpiOp<OpGateUp> E{{CB(4), ((float*)(ws + WS_SS2))}};
        pg8::gemm_phase(glds, g, S, E, wv);
    }
    SEAM();
    PHASE(17) {
        PH_ARGS();
        pg8::Gemm g{CB(4), WB(WS_WD2), M, D, FF, FF, FF}; pg8::StaticOrder S; S.init(M, D, G, bid);
        pg8::EpiOp<OpRes> E{{nullptr, CB(0), ap->out, 0.5f, nullptr, nullptr, nullptr, nullptr}};
        pg8::gemm_phase(glds, g, S, E, wv);
    }
    SEAM();
    PHASE(18) {
        PH_ARGS();
        for (int m = gw; m < M; m += 2 * NGW) norm_row2(ap->out, INP(I_FN), nullptr, ap->out, m, m + NGW, lane);
    }
}
constexpr int N_PHASES = 19;

extern "C" void kernel_launch(void* const* d_in, const int* in_sizes, int n_in, void* d_out, int out_size, void* d_ws, size_t ws_size, hipStream_t stream) {
    static int grid = 0;
    if (grid == 0) {
        if (n_in != 27 || in_sizes[0] != M * D || out_size != M * D || ws_size < WS_END) { fprintf(stderr, "kernel_launch: unexpected shapes (n_in %d, in0 %d, out %d, ws %zu)\n", n_in, n_in > 0 ? in_sizes[0] : -1, out_size, ws_size); grid = -1; return; }
        int dev = 0, cus = 0, per_cu = 0;
        hipGetDevice(&dev); hipDeviceGetAttribute(&cus, hipDeviceAttributeMultiprocessorCount, dev);
        if (hipFuncSetAttribute((const void*)mk_fwd, hipFuncAttributeMaxDynamicSharedMemorySize, LDS_BYTES) != hipSuccess) { fprintf(stderr, "kernel_launch: hipFuncSetAttribute failed\n"); grid = -1; return; }
        if (hipOccupancyMaxActiveBlocksPerMultiprocessor(&per_cu, (const void*)mk_fwd, NT, LDS_BYTES) != hipSuccess || per_cu < 1) { fprintf(stderr, "kernel_launch: occupancy query says %d\n", per_cu); per_cu = 1; }
        (void)hipGetLastError();
        grid = cus;
    }
    if (grid < 0) return;
    Args a{};
    for (int i = 0; i < 27; ++i) a.in[i] = (const float*)d_in[i];
    a.out = (float*)d_out; a.ws = (unsigned char*)d_ws;
#if MK_MULTI
    for (int p = 0; p < N_PHASES; ++p) { a.ph_lo = p; a.ph_hi = p + 1; hipLaunchKernelGGL(mk_fwd, dim3(grid), dim3(NT), LDS_BYTES, stream, a); }
#else
    a.ph_lo = 0; a.ph_hi = N_PHASES;
    void* kargs[] = {&a};
    hipError_t e = hipLaunchCooperativeKernel((const void*)mk_fwd, dim3(grid), dim3(NT), kargs, LDS_BYTES, stream);
    if (e != hipSuccess) fprintf(stderr, "kernel_launch: cooperative launch failed: %s (grid %d)\n", hipGetErrorString(e), grid);
#endif
}
```

```cpp
#include <hip/hip_runtime.h>
#include <hip/hip_cooperative_groups.h>
#include <cstdio>
#include <cstdint>
namespace cg = cooperative_groups;

#ifndef MK_MULTI
#define MK_MULTI 0
#endif
#ifndef ATT_REP
#define ATT_REP 1
#endif
#ifndef PROBE_MASK
#define PROBE_MASK 0u
#endif

__device__ __forceinline__ int lane_id_fresh() { int l; asm volatile("v_mbcnt_lo_u32_b32 %0, -1, 0\n\tv_mbcnt_hi_u32_b32 %0, -1, %0" : "=v"(l)); return l; }
#define KTID(wv) ((wv) * 64 + lane_id_fresh())
namespace pg8 {
#define PG8_LAS __attribute__((address_space(3)))
typedef unsigned short bf16_t;
typedef short bf16x8 __attribute__((ext_vector_type(8)));
typedef float f32x4 __attribute__((ext_vector_type(4)));
typedef unsigned u32x4 __attribute__((ext_vector_type(4)));
constexpr int BM = 256, BK = 64, HALF = 128, HTB = HALF * BK * 2, STAGE_BYTES = 8 * HTB, NXCD = 8, WGM = 8;

__host__ __device__ __forceinline__ int lds_byte(int r, int c) { const int st = (r >> 4) * 2 + (c >> 5), rr = r & 15, cc = c & 31, ob = rr * 64 + cc * 2; return st * 1024 + (ob ^ (((ob >> 9) & 1) << 5)); }
__host__ __device__ __forceinline__ void stage_rc(int b, int& R, int& C) { const int st = b / 1024, sb = b % 1024, swz = sb ^ (((sb >> 9) & 1) << 5); R = (st >> 1) * 16 + swz / 64; C = (st & 1) * 32 + (swz % 64) / 2; }
__host__ __device__ __forceinline__ int perm32(int rho) { const int n = rho >> 4, i = rho & 15; return 8 * (i >> 2) + 4 * n + (i & 3); }

struct Unit { int pm, pn; };
struct Gemm { const bf16_t* A; const bf16_t* Bt; int M, N, K, lda, ldb; };

struct StaticOrder {
    int nM, nN, nwg, G, c;
    __host__ __device__ void init(int M, int N, int G_, int c_) { nM = M / BM; nN = N / BM; nwg = nM * nN; G = G_; c = c_; }
    __host__ __device__ bool next(int i, Unit& u) const {
        const long L = (long)i * G + c; if (L >= nwg) return false;
        int wgid = (int)L; { const int q = nwg / NXCD, r = nwg % NXCD, xcd = wgid % NXCD, off = wgid / NXCD; wgid = (xcd < r ? xcd * (q + 1) : r * (q + 1) + (xcd - r) * q) + off; }
        const int nig = WGM * nN, gid = wgid / nig, fm = gid * WGM, gsz = (nM - fm) < WGM ? (nM - fm) : WGM;
        u.pm = fm + ((wgid % nig) % gsz); u.pn = (wgid % nig) / gsz; return true;
    }
};

__device__ __forceinline__ unsigned cvt_pk_bf16(float lo, float hi) { unsigned r; asm volatile("v_cvt_pk_bf16_f32 %0, %1, %2" : "=v"(r) : "v"(lo), "v"(hi)); return r; }

template <class Op> struct EpiOp {
    Op op;
    __device__ __forceinline__ void operator()(const f32x4 (&acc)[2][2][4][2], const Unit& u, int wr, int wc, int fr, int fq) const {
#pragma unroll
        for (int ai = 0; ai < 2; ++ai)
#pragma unroll
            for (int m = 0; m < 4; ++m) {
                const int row = u.pm * BM + ai * HALF + wr * 64 + m * 16 + fr;
                op(acc[ai][0][m][0], acc[ai][0][m][1], acc[ai][1][m][0], acc[ai][1][m][1], row, u.pn, wc, fq);
                asm volatile("" ::: "memory");
            }
    }
};

template <class Epi, class Sched>
__device__ __forceinline__ void gemm_phase(PG8_LAS unsigned char* lds, const Gemm g, const Sched& S, const Epi& E, const int wv) {
    int tid_ = KTID(wv);
    const int tid = tid_, wid = __builtin_amdgcn_readfirstlane(tid >> 6), lane = tid & 63, wr = wid >> 2, wc = wid & 3, fr = lane & 15, fq = lane >> 4;
    const int K = g.K, nt = K / BK;
    unsigned voffA[2], voffB[2];
#pragma unroll
    for (int i = 0; i < 2; ++i) { int R, C; stage_rc(tid * 16 + i * 8192, R, C); const int Rb = (R & ~31) + perm32(R & 31);
        voffA[i] = (unsigned)(R * g.lda + C) * 2u; voffB[i] = (unsigned)(Rb * g.ldb + C) * 2u; }
    const size_t kstep = (size_t)(BK * 2);
    const size_t hstepA = (size_t)HALF * g.lda * 2, hstepB = (size_t)HALF * g.ldb * 2;
    const size_t tstepA = 2 * hstepA, tstepB = 2 * hstepB;
    const unsigned ldsw = (unsigned)wid * 1024u;
    const int aoff = lds_byte(wr * 64 + fr, fq * 8), boff = lds_byte(wc * 32 + fr, fq * 8);
#define PG8_SA(b, h) (((b) * 2 + (h)) * HTB)
#define PG8_SB(b, h) ((4 + (b) * 2 + (h)) * HTB)
#define PG8_STAGE(bufoff, gbase, voff) do { _Pragma("unroll") for (int _i = 0; _i < 2; ++_i) \
        __builtin_amdgcn_global_load_lds((const unsigned*)((const char*)(gbase) + (voff)[_i]), (PG8_LAS unsigned*)(lds + (bufoff) + ldsw + _i * 8192), 16, 0, 0); } while (0)
#define PG8_LDA(dst, b, h) do { _Pragma("unroll") for (int m = 0; m < 4; ++m) _Pragma("unroll") for (int k = 0; k < 2; ++k) dst[m][k] = *(const PG8_LAS bf16x8*)(lds + PG8_SA(b, h) + aoff + m * 2048 + k * 1024); } while (0)
#define PG8_LDB(dst, b, h) do { _Pragma("unroll") for (int n = 0; n < 2; ++n) _Pragma("unroll") for (int k = 0; k < 2; ++k) dst[n][k] = *(const PG8_LAS bf16x8*)(lds + PG8_SB(b, h) + boff + n * 2048 + k * 1024); } while (0)
#define PG8_MMA(ai, bj, At, Bt) do { __builtin_amdgcn_s_setprio(1); _Pragma("unroll") for (int m = 0; m < 4; ++m) _Pragma("unroll") for (int n = 0; n < 2; ++n) _Pragma("unroll") for (int k = 0; k < 2; ++k) \
        acc[ai][bj][m][n] = __builtin_amdgcn_mfma_f32_16x16x32_bf16(Bt[n][k], At[m][k], acc[ai][bj][m][n], 0, 0, 0); __builtin_amdgcn_s_setprio(0); } while (0)
#define PG8_WAIT_V(n) asm volatile("s_waitcnt vmcnt(" #n ")" ::: "memory")
#define PG8_WAIT_L(n) asm volatile("s_waitcnt lgkmcnt(" #n ")" ::: "memory")
#define PG8_BAR __builtin_amdgcn_s_barrier()
#define PG8_SCHED __builtin_amdgcn_sched_barrier(0)
    Unit cur, nxt; int ui = 0;
    if (!S.next(0, cur)) return;
    f32x4 acc[2][2][4][2];
#pragma unroll
    for (int a = 0; a < 2; ++a)
#pragma unroll
        for (int b = 0; b < 2; ++b)
#pragma unroll
            for (int m = 0; m < 4; ++m)
#pragma unroll
                for (int n = 0; n < 2; ++n) acc[a][b][m][n] = (f32x4){0.f, 0.f, 0.f, 0.f};
    bf16x8 At[4][2], B0[2][2], B1[2][2];
    const char* cA = (const char*)g.A + (size_t)cur.pm * tstepA; const char* cB = (const char*)g.Bt + (size_t)cur.pn * tstepB;
    PG8_STAGE(PG8_SB(0, 0), cB, voffB); PG8_STAGE(PG8_SB(0, 1), cB + hstepB, voffB); PG8_STAGE(PG8_SA(0, 0), cA, voffA); PG8_STAGE(PG8_SA(0, 1), cA + hstepA, voffA);
    if (wr == 1) PG8_BAR;
    PG8_WAIT_V(2); PG8_BAR;
    PG8_STAGE(PG8_SB(1, 0), cB + kstep, voffB); PG8_STAGE(PG8_SA(1, 0), cA + kstep, voffA); PG8_STAGE(PG8_SB(1, 1), cB + hstepB + kstep, voffB);
    PG8_WAIT_V(6); PG8_BAR;
    for (;;) {
        const bool has_next = S.next(ui + 1, nxt);
        const char* nA = has_next ? (const char*)g.A + (size_t)nxt.pm * tstepA : cA; const char* nB = has_next ? (const char*)g.Bt + (size_t)nxt.pn * tstepB : cB;
        for (int t = 0; t < nt; t += 2) {
            const bool last = (t == nt - 2);
            const char* a1 = cA + (size_t)(t + 1) * kstep;
            const char* a2 = last ? nA : cA + (size_t)(t + 2) * kstep; const char* b2 = last ? nB : cB + (size_t)(t + 2) * kstep;
            const char* a3 = a2 + kstep; const char* b3 = b2 + kstep;
            PG8_LDB(B0, 0, 0); PG8_LDB(B1, 0, 1); PG8_SCHED; PG8_LDA(At, 0, 0); PG8_STAGE(PG8_SA(1, 1), a1 + hstepA, voffA);
            PG8_WAIT_V(8); PG8_WAIT_L(0); PG8_BAR; PG8_MMA(0, 0, At, B0); PG8_MMA(0, 1, At, B1); PG8_BAR; PG8_SCHED;
            PG8_LDA(At, 0, 1); PG8_STAGE(PG8_SB(0, 0), b2, voffB); PG8_STAGE(PG8_SB(0, 1), b2 + hstepB, voffB); PG8_STAGE(PG8_SA(0, 0), a2, voffA);
            PG8_WAIT_V(8); PG8_WAIT_L(0); PG8_BAR; PG8_MMA(1, 0, At, B0); PG8_MMA(1, 1, At, B1); PG8_BAR; PG8_SCHED;
            PG8_LDB(B0, 1, 0); PG8_LDB(B1, 1, 1); PG8_SCHED; PG8_LDA(At, 1, 0); PG8_STAGE(PG8_SA(0, 1), a2 + hstepA, voffA);
            PG8_WAIT_V(8); PG8_WAIT_L(0); PG8_BAR; PG8_MMA(0, 0, At, B0); PG8_MMA(0, 1, At, B1); PG8_BAR; PG8_SCHED;
            PG8_LDA(At, 1, 1); PG8_STAGE(PG8_SB(1, 0), b3, voffB); PG8_STAGE(PG8_SB(1, 1), b3 + hstepB, voffB); PG8_STAGE(PG8_SA(1, 0), a3, voffA);
            PG8_WAIT_V(8); PG8_WAIT_L(0); PG8_BAR; PG8_MMA(1, 0, At, B0); PG8_MMA(1, 1, At, B1); PG8_BAR; PG8_SCHED;
        }
        if (wr == 0) PG8_BAR;
        { const int le_ = lane_id_fresh(); E(acc, cur, wr, wc, le_ & 15, le_ >> 4); }
        if (!has_next) break;
#pragma unroll
        for (int a = 0; a < 2; ++a)
#pragma unroll
            for (int b = 0; b < 2; ++b)
#pragma unroll
                for (int m = 0; m < 4; ++m)
#pragma unroll
                    for (int n = 0; n < 2; ++n) acc[a][b][m][n] = (f32x4){0.f, 0.f, 0.f, 0.f};
        cur = nxt; cA = nA; cB = nB; ++ui;
        if (wr == 1) PG8_BAR;
    }
    PG8_WAIT_V(0);
    PG8_BAR;
#undef PG8_SA
#undef PG8_SB
#undef PG8_STAGE
#undef PG8_LDA
#undef PG8_LDB
#undef PG8_MMA
#undef PG8_WAIT_V
#undef PG8_WAIT_L
#undef PG8_BAR
#undef PG8_SCHED
}
}

using pg8::bf16_t; using pg8::f32x4; using pg8::u32x4; using pg8::bf16x8;
typedef unsigned u32x2 __attribute__((ext_vector_type(2)));
#define LAS __attribute__((address_space(3)))

constexpr int BATCH = 8, SEQ = 8192, D = 1024, FF = 2816, M = BATCH * SEQ;
constexpr int AW = 768, RS = 3360, INC = 7712;
constexpr int LAW = 384;
constexpr int NWAVES = 8, NT = 512;
constexpr float NORM_EPS = 1e-6f, GN_EPS = 64e-5f;

constexpr size_t MiB = 1u << 20;
constexpr size_t WS_WGU1 = 1 * MiB;
constexpr size_t WS_WD1 = WS_WGU1 + 11 * MiB;
constexpr size_t WS_WGU2 = WS_WD1 + 5 * MiB + MiB / 2;
constexpr size_t WS_WD2 = WS_WGU2 + 11 * MiB;
constexpr size_t WS_WIN = WS_WD2 + 5 * MiB + MiB / 2;
constexpr size_t WS_WUP = WS_WIN + 15 * MiB + MiB / 2;
constexpr size_t WS_WOUT = WS_WUP + MiB / 2;
constexpr size_t WS_WO = WS_WOUT + 2 * MiB;
constexpr size_t WS_LW = WS_WO + 2 * MiB;
constexpr size_t WS_LA2 = WS_LW + MiB / 4;
constexpr size_t WS_LG = WS_LA2 + MiB / 4;
constexpr size_t WS_ROPE = WS_LG + MiB / 2;
static_assert(WS_ROPE + MiB / 2 <= 56 * MiB, "weights region");
constexpr size_t WS_LA = 56 * MiB;
constexpr size_t WS_HALO = 104 * MiB;
constexpr size_t WS_HALOLA = 104 * MiB;
constexpr size_t WS_BC = 111 * MiB;
constexpr size_t WS_LSE = 115 * MiB;
constexpr size_t WS_BRKR = 118 * MiB;
constexpr size_t WS_SS1 = 118 * MiB, WS_SS2 = WS_SS1 + MiB;
constexpr size_t CH = 128 * MiB;
constexpr size_t WS_C0 = 128 * MiB;
#define WS_C(i) (WS_C0 + (size_t)(i) * CH)
constexpr size_t WS_END = 1024 * MiB;
constexpr int LDS_BYTES = 147456;

__device__ __forceinline__ float bf2f(unsigned short h) { return __uint_as_float(((unsigned)h) << 16); }
__device__ __forceinline__ float bflo(unsigned w) { return __uint_as_float(w << 16); }
__device__ __forceinline__ float bfhi(unsigned w) { return __uint_as_float(w & 0xffff0000u); }
__device__ __forceinline__ unsigned pk2(float lo, float hi) { return pg8::cvt_pk_bf16(lo, hi); }
__device__ __forceinline__ void unpack8(const u32x4 w, float (&f)[8]) { f[0] = bflo(w.x); f[1] = bfhi(w.x); f[2] = bflo(w.y); f[3] = bfhi(w.y); f[4] = bflo(w.z); f[5] = bfhi(w.z); f[6] = bflo(w.w); f[7] = bfhi(w.w); }
__device__ __forceinline__ u32x4 pack8(const float (&f)[8]) { u32x4 w; w.x = pk2(f[0], f[1]); w.y = pk2(f[2], f[3]); w.z = pk2(f[4], f[5]); w.w = pk2(f[6], f[7]); return w; }
__device__ __forceinline__ float sigm(float x) { return __builtin_amdgcn_rcpf(1.f + __expf(-x)); }
__device__ __forceinline__ float wave_sum(float v) {
#pragma unroll
    for (int o = 1; o < 64; o <<= 1) v += __shfl_xor(v, o);
    return v;
}

__device__ __forceinline__ float row_rs(const float* ss, int row) { return rsqrtf(ss[row] * (1.f / D) + NORM_EPS); }
struct OpGateUp {
    bf16_t* H; const float* ss;
    __device__ __forceinline__ void operator()(const f32x4 g0_, const f32x4 g1_, const f32x4 u0_, const f32x4 u1_, int row, int pn, int wc, int fq) const {
        const int col = pn * 128 + wc * 32 + 8 * fq; float o[8];
        const float sc = ss ? row_rs(ss, row) : 1.f; const f32x4 g0 = g0_ * sc, g1 = g1_ * sc, u0 = u0_ * sc, u1 = u1_ * sc;
#pragma unroll
        for (int i = 0; i < 4; ++i) { o[i] = g0[i] * sigm(g0[i]) * u0[i]; o[4 + i] = g1[i] * sigm(g1[i]) * u1[i]; }
        *(u32x4*)(H + (size_t)row * FF + col) = pack8(o);
    }
};
struct OpStoreBf16 {
    bf16_t* O; int ld; float scale;
    __device__ __forceinline__ void operator()(const f32x4 a0, const f32x4 a1, const f32x4 b0, const f32x4 b1, int row, int pn, int wc, int fq) const {
        const int col = pn * 256 + wc * 32 + 8 * fq; float o[8];
#pragma unroll
        for (int i = 0; i < 4; ++i) { o[i] = a0[i] * scale; o[4 + i] = a1[i] * scale; }
        *(u32x4*)(O + (size_t)row * ld + col) = pack8(o);
#pragma unroll
        for (int i = 0; i < 4; ++i) { o[i] = b0[i] * scale; o[4 + i] = b1[i] * scale; }
        *(u32x4*)(O + (size_t)row * ld + col + 128) = pack8(o);
    }
};
struct OpRes {
    const float* base; const bf16_t* dlt; float* out; float scale; bf16_t* dout; bf16_t* xg; const float* gain; float* ss;
    __device__ __forceinline__ float half(const f32x4 a0, const f32x4 a1, size_t off, int col) const {
        const float sc_ = scale; f32x4 r0, r1;
#pragma unroll
        for (int i = 0; i < 4; ++i) { r0[i] = a0[i] * sc_; r1[i] = a1[i] * sc_; }
        if (dout) { u32x4 w; w.x = pk2(r0[0], r0[1]); w.y = pk2(r0[2], r0[3]); w.z = pk2(r1[0], r1[1]); w.w = pk2(r1[2], r1[3]); *(u32x4*)(dout + off) = w; }
        if (base) { r0 += *(const f32x4*)(base + off); r1 += *(const f32x4*)(base + off + 4); }
        if (dlt) { float d[8]; unpack8(*(const u32x4*)(dlt + off), d); r0 += (f32x4){d[0], d[1], d[2], d[3]}; r1 += (f32x4){d[4], d[5], d[6], d[7]}; }
        if (out) { *(f32x4*)(out + off) = r0; *(f32x4*)(out + off + 4) = r1; }
        float q = 0.f;
        if (xg) { f32x4 y0 = r0, y1 = r1; if (gain) { y0 *= *(const f32x4*)(gain + col); y1 *= *(const f32x4*)(gain + col + 4); }
            u32x4 w; w.x = pk2(y0[0], y0[1]); w.y = pk2(y0[2], y0[3]); w.z = pk2(y1[0], y1[1]); w.w = pk2(y1[2], y1[3]); *(u32x4*)(xg + off) = w;
            q = (r0[0] * r0[0] + r0[1] * r0[1]) + (r0[2] * r0[2] + r0[3] * r0[3]) + (r1[0] * r1[0] + r1[1] * r1[1]) + (r1[2] * r1[2] + r1[3] * r1[3]); }
        return q;
    }
    __device__ __forceinline__ void operator()(const f32x4 a0, const f32x4 a1, const f32x4 b0, const f32x4 b1, int row, int pn, int wc, int fq) const {
        const int col = pn * 256 + wc * 32 + 8 * fq; const size_t off = (size_t)row * D + col;
        float q = half(a0, a1, off, col) + half(b0, b1, off + 128, col + 128);
        if (xg) { q += __shfl_xor(q, 16); q += __shfl_xor(q, 32); if (fq == 0) atomicAdd(ss + row, q); }
    }
};
struct OpAttnQKV {
    bf16_t* q; bf16_t* k; bf16_t* v; const float* rope; const float* ss;
    __device__ __forceinline__ void half(const f32x4 a0, const f32x4 a1, bf16_t* dst, int row, int wc, int fq, int which) const {
        float o[8];
#pragma unroll
        for (int i = 0; i < 4; ++i) { o[i] = a0[i]; o[4 + i] = a1[i]; }
        if (which < 2 && (wc & 1) == 0) {
            float p[8];
#pragma unroll
            for (int i = 0; i < 8; ++i) p[i] = __shfl_xor(o[i], 16);
            if (fq < 2) {
                const float* cs = rope + (size_t)(row & (SEQ - 1)) * 16;
                const f32x4 c0 = *(const f32x4*)(cs), c1 = *(const f32x4*)(cs + 4), s0 = *(const f32x4*)(cs + 8), s1 = *(const f32x4*)(cs + 12);
                const float sg = fq == 0 ? -1.f : 1.f;
#pragma unroll
                for (int i = 0; i < 4; ++i) { o[i] = o[i] * c0[i] + sg * p[i] * s0[i]; o[4 + i] = o[4 + i] * c1[i] + sg * p[4 + i] * s1[i]; }
            }
        }
        if (which == 0) {
#pragma unroll
            for (int i = 0; i < 8; ++i) o[i] *= 0.125f;
        }
        *(u32x4*)dst = pack8(o);
    }
    __device__ __forceinline__ void operator()(const f32x4 a0, const f32x4 a1, const f32x4 b0, const f32x4 b1, int row, int pn, int wc, int fq) const {
        const int which = pn / 3, col = (pn - which * 3) * 256 + wc * 32 + 8 * fq;
        bf16_t* base = q + (size_t)which * (CH / 2) + (size_t)row * AW + col;
        const float sc = row_rs(ss, row);
        half(a0 * sc, a1 * sc, base, row, wc, fq, which); half(b0 * sc, b1 * sc, base + 128, row, wc, fq, which);
    }
};
struct OpRwkvZ {
    bf16_t* r; bf16_t* k; bf16_t* v; bf16_t* la; const float* ss; bf16_t* halola;
    __device__ __forceinline__ void operator()(const f32x4 a0, const f32x4 a1, const f32x4 b0, const f32x4 b1, int row, int pn, int wc, int fq) const {
        float o0[8], o1[8]; const float sc = row_rs(ss, row);
#pragma unroll
        for (int i = 0; i < 4; ++i) { o0[i] = a0[i] * sc; o0[4 + i] = a1[i] * sc; o1[i] = b0[i] * sc; o1[4 + i] = b1[i] * sc; }
        const u32x4 w0 = pack8(o0), w1 = pack8(o1);
        const bool hrow = (row & 31) == 31;
        if (pn < 12) {
            const int s = pn >> 2, col = (pn & 3) * 256 + wc * 32 + 8 * fq;
            bf16_t* dst = r + (size_t)s * (CH / 2) + (size_t)row * D + col;
            *(u32x4*)dst = w0; *(u32x4*)(dst + 128) = w1;
        } else {
            const int col = (pn - 12) * 256 + wc * 32 + 8 * fq;
            if (col < 288) { *(u32x4*)(la + (size_t)row * LAW + col) = w0; if (hrow) *(u32x4*)(halola + (size_t)(row >> 5) * LAW + col) = w0; }
            if (col + 128 < 288) { *(u32x4*)(la + (size_t)row * LAW + col + 128) = w1; if (hrow) *(u32x4*)(halola + (size_t)(row >> 5) * LAW + col + 128) = w1; }
        }
    }
};
struct OpGates {
    unsigned char* g8; const float* bias; const float* ss;
    __device__ __forceinline__ u32x2 q8(const f32x4 a0, const f32x4 a1, const float* bp, float sc) const {
        const f32x4 c0 = *(const f32x4*)bp, c1 = *(const f32x4*)(bp + 4); unsigned b[8];
#pragma unroll
        for (int i = 0; i < 4; ++i) { b[i] = (unsigned)(sigm(a0[i] * sc + c0[i]) * 255.f + 0.5f); b[4 + i] = (unsigned)(sigm(a1[i] * sc + c1[i]) * 255.f + 0.5f); }
        u32x2 w; w.x = b[0] | (b[1] << 8) | (b[2] << 16) | (b[3] << 24); w.y = b[4] | (b[5] << 8) | (b[6] << 16) | (b[7] << 24); return w;
    }
    __device__ __forceinline__ void operator()(const f32x4 a0, const f32x4 a1, const f32x4 b0, const f32x4 b1, int row, int pn, int wc, int fq) const {
        const int s = pn >> 2, col = (pn & 3) * 256 + wc * 32 + 8 * fq; const float* bp = bias + s * 1024 + col;
        unsigned char* dst = g8 + (size_t)s * ((size_t)M * D) + (size_t)row * D + col; const float sc = row_rs(ss, row);
        *(u32x2*)dst = q8(a0, a1, bp, sc); *(u32x2*)(dst + 128) = q8(b0, b1, bp + 128, sc);
    }
};
template <int MODE> struct OpLora {
    bf16_t* O; const float* p0;
    __device__ __forceinline__ float f(float x) const { const float s = sigm(x); return MODE == 0 ? 1.f - __expf(-0.60653065971f * s) : s; }
    __device__ __forceinline__ void operator()(const f32x4 a0, const f32x4 a1, const f32x4 b0, const f32x4 b1, int row, int pn, int wc, int fq) const {
        const int col = pn * 256 + wc * 32 + 8 * fq; const float* bp = p0 + col; bf16_t* dst = O + (size_t)row * D + col; float o[8];
        { const f32x4 c0 = *(const f32x4*)bp, c1 = *(const f32x4*)(bp + 4);
#pragma unroll
          for (int i = 0; i < 4; ++i) { o[i] = f(a0[i] + c0[i]); o[4 + i] = f(a1[i] + c1[i]); }
          *(u32x4*)dst = pack8(o); }
        { const f32x4 c0 = *(const f32x4*)(bp + 128), c1 = *(const f32x4*)(bp + 132);
#pragma unroll
          for (int i = 0; i < 4; ++i) { o[i] = f(b0[i] + c0[i]); o[4 + i] = f(b1[i] + c1[i]); }
          *(u32x4*)(dst + 128) = pack8(o); }
    }
};
struct OpMerge {
    const unsigned char* g8; const bf16_t* ya; bf16_t* out;
    __device__ __forceinline__ void half(const f32x4 a0, const f32x4 a1, size_t off) const {
        const u32x2 ga = *(const u32x2*)(g8 + off), gr = *(const u32x2*)(g8 + (size_t)M * D + off);
        float Y[8], o[8]; unpack8(*(const u32x4*)(ya + off), Y);
        const float k = 1.f / 255.f;
#pragma unroll
        for (int i = 0; i < 4; ++i) {
            const float A0 = (float)((ga.x >> (8 * i)) & 0xffu) * k, A1 = (float)((ga.y >> (8 * i)) & 0xffu) * k;
            const float R0 = (float)((gr.x >> (8 * i)) & 0xffu) * k, R1 = (float)((gr.y >> (8 * i)) & 0xffu) * k;
            o[i] = A0 * Y[i] + R0 * a0[i]; o[4 + i] = A1 * Y[4 + i] + R1 * a1[i];
        }
        *(u32x4*)(out + off) = pack8(o);
    }
    __device__ __forceinline__ void operator()(const f32x4 a0, const f32x4 a1, const f32x4 b0, const f32x4 b1, int row, int pn, int wc, int fq) const {
        const size_t off = (size_t)row * D + pn * 256 + wc * 32 + 8 * fq;
        half(a0, a1, off); half(b0, b1, off + 128);
    }
};

struct Args {
    const float* in[27]; float* out; unsigned char* ws; int ph_lo, ph_hi;
};
enum { I_X = 0, I_F1N, I_F1G, I_F1U, I_F1D, I_MN, I_WIN, I_GB, I_AUP, I_MU, I_W0, I_W2, I_A0, I_A2, I_G2, I_KK, I_KA, I_RK, I_LNW, I_LNB, I_WOUT, I_WO, I_F2N, I_F2G, I_F2U, I_F2D, I_FN };

__device__ __forceinline__ void tr_job(const float* W0, const float* W1, int ldw, int Ksrc, bf16_t* WT, int ldt, int nrows, int mode, int coff, int climit,
                                       float* scr, int gw, int NGW, int lane, const float* ksc = nullptr) {
    const int nblk = nrows / 64, nitems = (ldt / 64) * nblk;
    for (int it = gw; it < nitems; it += NGW) {
        const int kb = it / nblk, nb = it % nblk, k0 = 64 * kb;
        const float* Wh[2]; int ch[2]; bool vh[2];
#pragma unroll
        for (int hh = 0; hh < 2; ++hh) {
            const int nb32 = 2 * nb + hh;
            if (mode == 0) { ch[hh] = coff + 32 * nb32; vh[hh] = ch[hh] < climit; Wh[hh] = W0; }
            else { const int tile = nb32 >> 3, j0 = (nb32 & 7) * 32; Wh[hh] = j0 < 128 ? W0 : W1; ch[hh] = tile * 128 + (j0 & 127); vh[hh] = true; }
        }
        const int r4 = lane >> 4, pc = lane & 15, hsel = pc >> 3;
        const float* Wsel = hsel ? Wh[1] : Wh[0]; const int csel = (hsel ? ch[1] : ch[0]) + (pc & 7) * 4; const bool vsel = hsel ? vh[1] : vh[0];
        f32x4 v[16];
#pragma unroll
        for (int i = 0; i < 16; ++i) { const int k = k0 + 4 * i + r4; v[i] = (vsel && k < Ksrc) ? *(const f32x4*)(Wsel + (size_t)k * ldw + csel) : (f32x4){0.f, 0.f, 0.f, 0.f}; if (ksc && k < Ksrc) v[i] *= ksc[k]; }
#pragma unroll
        for (int i = 0; i < 16; ++i) { float* d = scr + (4 * i + r4) * 65 + pc * 4; d[0] = v[i].x; d[1] = v[i].y; d[2] = v[i].z; d[3] = v[i].w; }
        __builtin_amdgcn_s_waitcnt(0); asm volatile("" ::: "memory");
        const int c = lane & 7;
#pragma unroll
        for (int j = 0; j < 8; ++j) { const int n = (lane >> 3) + 8 * j; const float* sp = scr + (8 * c) * 65 + n;
            u32x4 o; o.x = pk2(sp[0 * 65], sp[1 * 65]); o.y = pk2(sp[2 * 65], sp[3 * 65]); o.z = pk2(sp[4 * 65], sp[5 * 65]); o.w = pk2(sp[6 * 65], sp[7 * 65]);
            *(u32x4*)(WT + (size_t)(64 * nb + n) * ldt + k0 + 8 * c) = o; }
        __builtin_amdgcn_s_waitcnt(0); asm volatile("" ::: "memory");
    }
}
__device__ __forceinline__ void norm_row(const float* xrow, const bf16_t* drow, const float* gain, bf16_t* orow, float* frow, int lane) {
    f32x4 v[4]; float s = 0.f;
#pragma unroll
    for (int j = 0; j < 4; ++j) {
        v[j] = *((const f32x4*)xrow + lane + 64 * j);
        if (drow) { const u32x2 w = *((const u32x2*)drow + lane + 64 * j); v[j] += (f32x4){bflo(w.x), bfhi(w.x), bflo(w.y), bfhi(w.y)}; }
        s += (v[j].x * v[j].x + v[j].y * v[j].y) + (v[j].z * v[j].z + v[j].w * v[j].w);
    }
    const float inv = rsqrtf(wave_sum(s) * (1.f / D) + NORM_EPS);
#pragma unroll
    for (int j = 0; j < 4; ++j) {
        const f32x4 gn = *((const f32x4*)gain + lane + 64 * j); const f32x4 o = v[j] * inv * gn;
        if (orow) { u32x2 w; w.x = pk2(o.x, o.y); w.y = pk2(o.z, o.w); *((u32x2*)orow + lane + 64 * j) = w; }
        else *((f32x4*)frow + lane + 64 * j) = o;
    }
}

__device__ __forceinline__ void norm_row2(const float* xb, const float* gain, bf16_t* ob, float* fb, int m0, int m1, int lane) {
    f32x4 v0[4], v1[4]; float s0 = 0.f, s1 = 0.f; const bool two = m1 < M;
#pragma unroll
    for (int j = 0; j < 4; ++j) { v0[j] = *((const f32x4*)(xb + (size_t)m0 * D) + lane + 64 * j); v1[j] = two ? *((const f32x4*)(xb + (size_t)m1 * D) + lane + 64 * j) : (f32x4){0.f, 0.f, 0.f, 0.f}; }
#pragma unroll
    for (int j = 0; j < 4; ++j) { s0 += (v0[j].x * v0[j].x + v0[j].y * v0[j].y) + (v0[j].z * v0[j].z + v0[j].w * v0[j].w); s1 += (v1[j].x * v1[j].x + v1[j].y * v1[j].y) + (v1[j].z * v1[j].z + v1[j].w * v1[j].w); }
#pragma unroll
    for (int o = 1; o < 64; o <<= 1) { s0 += __shfl_xor(s0, o); s1 += __shfl_xor(s1, o); }
    const float i0 = rsqrtf(s0 * (1.f / D) + NORM_EPS), i1 = rsqrtf(s1 * (1.f / D) + NORM_EPS);
#pragma unroll
    for (int j = 0; j < 4; ++j) {
        const f32x4 gn = *((const f32x4*)gain + lane + 64 * j); const f32x4 o0 = v0[j] * i0 * gn, o1 = v1[j] * i1 * gn;
        if (ob) { u32x2 w0; w0.x = pk2(o0.x, o0.y); w0.y = pk2(o0.z, o0.w); *((u32x2*)(ob + (size_t)m0 * D) + lane + 64 * j) = w0;
                  if (two) { u32x2 w1; w1.x = pk2(o1.x, o1.y); w1.y = pk2(o1.z, o1.w); *((u32x2*)(ob + (size_t)m1 * D) + lane + 64 * j) = w1; } }
        else { *((f32x4*)(fb + (size_t)m0 * D) + lane + 64 * j) = o0; if (two) *((f32x4*)(fb + (size_t)m1 * D) + lane + 64 * j) = o1; }
    }
}
struct AttnUnit { int b, h, g, hg, d, r, i; };
__device__ __forceinline__ AttnUnit attn_decode(int u) {
    AttnUnit a; const int rb = u & 63, bh = u >> 6; a.h = bh % 12; a.b = bh / 12; a.g = a.h >> 2; a.hg = a.h & 3;
    const int dsh = 2 * a.g, nb = 64 >> dsh; a.d = 1 << dsh; a.r = rb / nb; a.i = rb % nb; return a;
}
__device__ __forceinline__ void attn_unit_compute(const bf16_t* Ks, const bf16_t* Vt, const bf16x8 (&qf)[2], bf16_t* Og, float* lse, const size_t rowq, const int g, const int hg, const int i, const int w, const int fr, const int fq) {
        f32x4 s[9];
#pragma unroll
        for (int tt = 0; tt < 9; ++tt) {
            const int T = w + tt;
            const bf16x8 k0 = *(const bf16x8*)(Ks + (16 * T + fr) * 72 + fq * 8), k1 = *(const bf16x8*)(Ks + (16 * T + fr) * 72 + 32 + fq * 8);
            f32x4 a = (f32x4){0.f, 0.f, 0.f, 0.f};
            a = __builtin_amdgcn_mfma_f32_16x16x32_bf16(k0, qf[0], a, 0, 0, 0);
            a = __builtin_amdgcn_mfma_f32_16x16x32_bf16(k1, qf[1], a, 0, 0, 0);
            s[tt] = a;
        }
        const int le = 4 * fq - fr; float mx = -INFINITY;
#pragma unroll
        for (int tt = 0; tt < 9; ++tt) {
            const bool tile_ok = (i > 0) || (w + tt >= 8);
#pragma unroll
            for (int e = 0; e < 4; ++e) {
                bool valid = tile_ok;
                if (tt == 0) valid = valid && (le + e >= 0);
                if (tt == 8) valid = valid && (le + e <= 0);
                s[tt][e] = valid ? s[tt][e] : -INFINITY; mx = fmaxf(mx, s[tt][e]);
            }
        }
        mx = fmaxf(mx, __shfl_xor(mx, 16)); mx = fmaxf(mx, __shfl_xor(mx, 32));
        float l = 0.f;
#pragma unroll
        for (int tt = 0; tt < 9; ++tt)
#pragma unroll
            for (int e = 0; e < 4; ++e) { const float p = __expf(s[tt][e] - mx); s[tt][e] = p; l += p; }
        l += __shfl_xor(l, 16); l += __shfl_xor(l, 32);
        f32x4 o[4];
#pragma unroll
        for (int dt = 0; dt < 4; ++dt) o[dt] = (f32x4){0.f, 0.f, 0.f, 0.f};
#pragma unroll
        for (int s2 = 0; s2 < 5; ++s2) {
            const int T0 = w + 2 * s2, T1 = s2 < 4 ? T0 + 1 : T0;
            union { bf16x8 v; unsigned u[4]; } pf;
            pf.u[0] = pk2(s[2 * s2][0], s[2 * s2][1]); pf.u[1] = pk2(s[2 * s2][2], s[2 * s2][3]);
            if (s2 < 4) { pf.u[2] = pk2(s[2 * s2 + 1][0], s[2 * s2 + 1][1]); pf.u[3] = pk2(s[2 * s2 + 1][2], s[2 * s2 + 1][3]); } else { pf.u[2] = 0u; pf.u[3] = 0u; }
#pragma unroll
            for (int dt = 0; dt < 4; ++dt) {
                union { bf16x8 v; u32x2 h[2]; } vf;
                vf.h[0] = *(const u32x2*)(Vt + (16 * dt + fr) * 264 + 16 * T0 + 4 * fq);
                vf.h[1] = *(const u32x2*)(Vt + (16 * dt + fr) * 264 + 16 * T1 + 4 * fq);
                o[dt] = __builtin_amdgcn_mfma_f32_16x16x32_bf16(vf.v, pf.v, o[dt], 0, 0, 0);
            }
        }
        const float il = 1.f / l;
        bf16_t* op = Og + ((size_t)g * M + rowq) * 256 + hg * 64 + 4 * fq;
#pragma unroll
        for (int dt = 0; dt < 4; ++dt) { u32x2 wv; wv.x = pk2(o[dt][0] * il, o[dt][1] * il); wv.y = pk2(o[dt][2] * il, o[dt][3] * il); *(u32x2*)(op + 16 * dt) = wv; }
        if (fq == 0) lse[((size_t)g * M + rowq) * 4 + hg] = mx + __logf(l);
}
__device__ __forceinline__ void attn_phase(unsigned char* lds, const bf16_t* Q, const bf16_t* K, const bf16_t* V, bf16_t* Og, float* lse, int G, int bid, const int wv) {
    bf16_t* Ks = (bf16_t*)lds;
    bf16_t* Vt = (bf16_t*)(lds + 36864);
    int tid_ = KTID(wv);
    const int tid = tid_, w = tid >> 6, lane = tid & 63, fr = lane & 15, fq = lane >> 4;
    constexpr int NU = ATT_REP * BATCH * 12 * 64;
    u32x4 kA[4], vA[4], kB[4], vB[4]; bf16x8 qA[2], qB[2];
#define ATT_LOAD(kr_, vr_, qr_, uu) do { const AttnUnit n_ = attn_decode((uu) % (BATCH * 12 * 64)); const size_t br_ = (size_t)n_.b * SEQ; \
        _Pragma("unroll") for (int c_ = 0; c_ < 4; ++c_) { const int p_ = tid + 512 * c_; \
            { const int key_ = p_ >> 3, seg_ = p_ & 7, l_ = 128 * (n_.i - 1) + key_; kr_[c_] = (u32x4){0u, 0u, 0u, 0u}; \
              if (l_ >= 0) kr_[c_] = *(const u32x4*)(K + (br_ + (size_t)l_ * n_.d + n_.r) * AW + n_.h * 64 + seg_ * 8); } \
            { const int seg_ = p_ >> 8, key_ = p_ & 255, l_ = 128 * (n_.i - 1) + key_; vr_[c_] = (u32x4){0u, 0u, 0u, 0u}; \
              if (l_ >= 0) vr_[c_] = *(const u32x4*)(V + (br_ + (size_t)l_ * n_.d + n_.r) * AW + n_.h * 64 + seg_ * 8); } } \
        { const size_t rq_ = br_ + (size_t)(128 * n_.i + 16 * w + fr) * n_.d + n_.r; \
          _Pragma("unroll") for (int ks_ = 0; ks_ < 2; ++ks_) qr_[ks_] = *(const bf16x8*)(Q + rq_ * AW + n_.h * 64 + ks_ * 32 + fq * 8); } } while (0)
#define ATT_BODY(kr_, vr_, qr_, ucur, unext) do { \
        const AttnUnit U = attn_decode((ucur) % (BATCH * 12 * 64)); \
        const int g = U.g, hg = U.hg, d = U.d, r = U.r, i = U.i; const size_t brow = (size_t)U.b * SEQ; \
        __syncthreads(); \
        _Pragma("unroll") for (int c = 0; c < 4; ++c) { const int p = tid + 512 * c; \
            *(u32x4*)(Ks + (p >> 3) * 72 + (p & 7) * 8) = kr_[c]; \
            const u32x4 val = vr_[c]; bf16_t* vp = Vt + ((p >> 8) * 8) * 264 + (p & 255); \
            vp[0 * 264] = (bf16_t)(val.x & 0xffffu); vp[1 * 264] = (bf16_t)(val.x >> 16); vp[2 * 264] = (bf16_t)(val.y & 0xffffu); vp[3 * 264] = (bf16_t)(val.y >> 16); \
            vp[4 * 264] = (bf16_t)(val.z & 0xffffu); vp[5 * 264] = (bf16_t)(val.z >> 16); vp[6 * 264] = (bf16_t)(val.w & 0xffffu); vp[7 * 264] = (bf16_t)(val.w >> 16); } \
        const size_t rowq = brow + (size_t)(128 * i + 16 * w + fr) * d + r; \
        bf16x8 qf[2]; qf[0] = qr_[0]; qf[1] = qr_[1]; \
        if ((unext) < NU) ATT_LOAD(kr_, vr_, qr_, (unext)); \
        __syncthreads(); \
        attn_unit_compute(Ks, Vt, qf, Og, lse, rowq, g, hg, i, w, fr, fq); } while (0)
    if (bid < NU) ATT_LOAD(kA, vA, qA, bid);
    if (bid + G < NU) ATT_LOAD(kB, vB, qB, bid + G);
    for (int u_ = bid; u_ < NU; u_ += 2 * G) {
        ATT_BODY(kA, vA, qA, u_, u_ + 2 * G);
        if (u_ + G < NU) ATT_BODY(kB, vB, qB, u_ + G, u_ + 3 * G);
    }
    __syncthreads();
}

template <int CTRL> __device__ __forceinline__ float dpp_f(float x) { return __builtin_bit_cast(float, __builtin_amdgcn_update_dpp(0, __builtin_bit_cast(int, x), CTRL, 0xf, 0xf, true)); }
__device__ __forceinline__ float row16_sum(float x) { x += dpp_f<0x128>(x); x += dpp_f<0x124>(x); x += dpp_f<0x122>(x); x += dpp_f<0x121>(x); return x; }
constexpr int TC = 32;
constexpr int SC_BUF = TC * 4 * 64 * 4 + 256;
constexpr int SC_V = TC * 32 * 4;
typedef float f32x2 __attribute__((ext_vector_type(2)));
struct ScanOps { f32x4 a0, a1, q0, q1, b0, b1, k0, k1; float kr, v; };
__device__ __forceinline__ void scan_phase(unsigned char* lds, const bf16_t* Rz, const bf16_t* LAp, const bf16_t* Kz, const bf16_t* Vz, const bf16_t* Lwp, const bf16_t* Lap, const float* w0p, const float* a0p, const float* mu, const float* pkk, const float* pka, const float* prk, float* BCo, bf16_t* Y, int G, int bid, const int wv) {
    int tid_ = KTID(wv);
    const int tid = tid_, w = __builtin_amdgcn_readfirstlane(tid >> 6), lane = tid & 63, kq = lane & 15, rw = lane >> 4;
    float* const kb0 = (float*)lds; float* const vb0 = (float*)(lds + 2 * SC_BUF); float* const yb0 = (float*)(lds + 2 * SC_BUF + 2 * SC_V);
    float* const bb0 = (float*)(lds + 2 * SC_BUF + 4 * SC_V);
    float* const xb0 = (float*)(lds + 2 * SC_BUF + 4 * SC_V + 2 * TC * 8);
#define KB(bi) (kb0 + (bi) * (SC_BUF / 4))
#define VB(bi) (vb0 + (bi) * (SC_V / 4))
#define YB(bi) (yb0 + (bi) * (SC_V / 4))
#define BB(bi) (bb0 + (bi) * (TC * 2))
#define XB(bi, m) (xb0 + ((bi) * 2 + (m)) * (TC * 68))
    constexpr int NCH = SEQ / TC;
    for (int u = bid; u < BATCH * 16 * 2; u += G) {
        const int half = u & 1, h = (u >> 1) & 15, b = u >> 5;
        const size_t row0 = (size_t)b * SEQ;
        __syncthreads();
        if (w >= 4) {
            const int hw = w - 4, fr = lane & 15, fq = lane >> 4;
            bf16x8 Bw[2], Ba[2];
#pragma unroll
            for (int ks = 0; ks < 2; ++ks) { Bw[ks] = *(const bf16x8*)(Lwp + (size_t)(h * 64 + 16 * hw + fr) * 128 + 32 * ks + 8 * fq); Ba[ks] = *(const bf16x8*)(Lap + (size_t)(h * 64 + 16 * hw + fr) * 128 + 32 * ks + 8 * fq); }
            const float bw0 = w0p[h * 64 + 16 * hw + fr], ba0 = a0p[h * 64 + 16 * hw + fr];
            const int ht = tid - 256, st = ht >> 3, sg = ht & 7;
            const size_t goff = (row0 + st) * D + h * 64 + sg * 8;
            const int lo = st * 256 + sg * 8;
            const bool hv = ht < 128;
            const size_t voff = (row0 + (ht >> 2)) * D + h * 64 + half * 32 + (ht & 3) * 8; const int lov = (ht >> 2) * 32 + (ht & 3) * 8;
            bf16_t* yo = Y + voff;
            const int cc0 = h * 64 + sg * 8, cv0 = 2048 + h * 64 + half * 32 + (ht & 3) * 8;
            struct HReg { u32x4 rc, rp, kc, kp, vc, vp; };
            HReg P, Q; P.vc = (u32x4){0u, 0u, 0u, 0u}; P.vp = P.vc; Q.vc = P.vc; Q.vp = P.vc;
            const u32x4 z4 = (u32x4){0u, 0u, 0u, 0u};
#define SC_ISSUE(X, c) do { const size_t o_ = (size_t)(c) * TC * D; const bool first_ = ((c) == 0 && st == 0); \
                X.rc = *(const u32x4*)(Rz + goff + o_); X.kc = *(const u32x4*)(Kz + goff + o_); \
                X.rp = first_ ? z4 : *(const u32x4*)(Rz + goff + o_ - D); X.kp = first_ ? z4 : *(const u32x4*)(Kz + goff + o_ - D); \
                if (hv) { X.vc = *(const u32x4*)(Vz + voff + o_); X.vp = ((c) == 0 && ht < 4) ? z4 : *(const u32x4*)(Vz + voff + o_ - D); } } while (0)
#define SC_ST8(dst, f) do { *(f32x4*)(dst) = (f32x4){f[0], f[1], f[2], f[3]}; *(f32x4*)((dst) + 4) = (f32x4){f[4], f[5], f[6], f[7]}; } while (0)
#define SC_COMMIT(X, bi, c) do { float rc_[8], rp_[8], kc_[8], kp_[8], pt_[8], pp_[8], av_[8]; float* kb_ = KB(bi) + lo; \
                int ci_ = cc0; asm volatile("" : "+v"(ci_));     \
                float mur[8], muk[8], kkp[8], kap[8], rkp[8]; \
                { const f32x4 a_ = *(const f32x4*)(mu + ci_), b_ = *(const f32x4*)(mu + ci_ + 4); mur[0] = a_.x; mur[1] = a_.y; mur[2] = a_.z; mur[3] = a_.w; mur[4] = b_.x; mur[5] = b_.y; mur[6] = b_.z; mur[7] = b_.w; } \
                { const f32x4 a_ = *(const f32x4*)(mu + 1024 + ci_), b_ = *(const f32x4*)(mu + 1024 + ci_ + 4); muk[0] = a_.x; muk[1] = a_.y; muk[2] = a_.z; muk[3] = a_.w; muk[4] = b_.x; muk[5] = b_.y; muk[6] = b_.z; muk[7] = b_.w; } \
                { const f32x4 a_ = *(const f32x4*)(pkk + ci_), b_ = *(const f32x4*)(pkk + ci_ + 4); kkp[0] = a_.x; kkp[1] = a_.y; kkp[2] = a_.z; kkp[3] = a_.w; kkp[4] = b_.x; kkp[5] = b_.y; kkp[6] = b_.z; kkp[7] = b_.w; } \
                { const f32x4 a_ = *(const f32x4*)(pka + ci_), b_ = *(const f32x4*)(pka + ci_ + 4); kap[0] = a_.x; kap[1] = a_.y; kap[2] = a_.z; kap[3] = a_.w; kap[4] = b_.x; kap[5] = b_.y; kap[6] = b_.z; kap[7] = b_.w; } \
                { const f32x4 a_ = *(const f32x4*)(prk + ci_), b_ = *(const f32x4*)(prk + ci_ + 4); rkp[0] = a_.x; rkp[1] = a_.y; rkp[2] = a_.z; rkp[3] = a_.w; rkp[4] = b_.x; rkp[5] = b_.y; rkp[6] = b_.z; rkp[7] = b_.w; } \
                unpack8(X.rc, rc_); unpack8(X.rp, rp_); unpack8(X.kc, kc_); unpack8(X.kp, kp_); \
                { const float* x0_ = XB(bi, 0) + st * 68 + sg * 8; const float* x1_ = XB(bi, 1) + st * 68 + sg * 8; const f32x4 p0_ = *(const f32x4*)x0_, p1_ = *(const f32x4*)(x0_ + 4), q0_ = *(const f32x4*)x1_, q1_ = *(const f32x4*)(x1_ + 4); \
                  pt_[0] = p0_.x; pt_[1] = p0_.y; pt_[2] = p0_.z; pt_[3] = p0_.w; pt_[4] = p1_.x; pt_[5] = p1_.y; pt_[6] = p1_.z; pt_[7] = p1_.w; \
                  av_[0] = q0_.x; av_[1] = q0_.y; av_[2] = q0_.z; av_[3] = q0_.w; av_[4] = q1_.x; av_[5] = q1_.y; av_[6] = q1_.z; av_[7] = q1_.w; \
                  if (st > 0) { const f32x4 r0_ = *(const f32x4*)(x0_ - 68), r1_ = *(const f32x4*)(x0_ - 64); pp_[0] = r0_.x; pp_[1] = r0_.y; pp_[2] = r0_.z; pp_[3] = r0_.w; pp_[4] = r1_.x; pp_[5] = r1_.y; pp_[6] = r1_.z; pp_[7] = r1_.w; } \
                  else { _Pragma("unroll") for (int i_ = 0; i_ < 8; ++i_) pp_[i_] = 1.f; } } \
                float kk_[8], ko_[8], bo_[8], qq_[8]; float ss_ = 0.f, bs_ = 0.f, sbr_ = 0.f, skr_ = 0.f; \
                _Pragma("unroll") for (int i_ = 0; i_ < 8; ++i_) { const float r_ = rc_[i_] + (rp_[i_] - rc_[i_]) * mur[i_]; const float kz_ = kc_[i_] + (kp_[i_] - kc_[i_]) * muk[i_]; \
                    kk_[i_] = kz_ * kkp[i_]; ss_ += kk_[i_] * kk_[i_]; ko_[i_] = kz_ * (1.f + (av_[i_] - 1.f) * kap[i_]); bs_ += r_ * ko_[i_] * rkp[i_]; skr_ += ko_[i_] * r_; rc_[i_] = r_; } \
                ss_ += dpp_f<0x141>(ss_); ss_ += dpp_f<0xB1>(ss_); ss_ += dpp_f<0x4E>(ss_); \
                const float inv_ = __builtin_amdgcn_rsqf(fmaxf(ss_, 1e-24f)); \
                _Pragma("unroll") for (int i_ = 0; i_ < 8; ++i_) { const float k2_ = kk_[i_] * inv_; bo_[i_] = k2_ * av_[i_]; sbr_ += bo_[i_] * rc_[i_]; kk_[i_] = -k2_ * pp_[i_]; }     \
                bs_ += dpp_f<0x141>(bs_); sbr_ += dpp_f<0x141>(sbr_); skr_ += dpp_f<0x141>(skr_); bs_ += dpp_f<0xB1>(bs_); sbr_ += dpp_f<0xB1>(sbr_); skr_ += dpp_f<0xB1>(skr_); \
                bs_ += dpp_f<0x4E>(bs_); sbr_ += dpp_f<0x4E>(sbr_); skr_ += dpp_f<0x4E>(skr_); \
                  \
                _Pragma("unroll") for (int i_ = 0; i_ < 8; ++i_) { qq_[i_] = pt_[i_] * rc_[i_] + sbr_ * kk_[i_]; const float ip_ = __builtin_amdgcn_rcpf(pt_[i_]); bo_[i_] *= ip_; ko_[i_] *= ip_; } \
                SC_ST8(kb_, kk_); SC_ST8(kb_ + 64, qq_); SC_ST8(kb_ + 128, bo_); SC_ST8(kb_ + 192, ko_); \
                if (st == TC - 1) { float* pe_ = KB(bi) + TC * 256 + sg * 8; SC_ST8(pe_, pt_); }     \
                if (sg == 0) { BB(bi)[st] = skr_; if (half == 0) BCo[(row0 + (size_t)(c) * TC + st) * 16 + h] = bs_; } \
                if (hv) { float vc_[8], vp_[8], muv[8]; { int cv_ = cv0; asm volatile("" : "+v"(cv_)); const f32x4 a_ = *(const f32x4*)(mu + cv_), b_ = *(const f32x4*)(mu + cv_ + 4); muv[0] = a_.x; muv[1] = a_.y; muv[2] = a_.z; muv[3] = a_.w; muv[4] = b_.x; muv[5] = b_.y; muv[6] = b_.z; muv[7] = b_.w; } unpack8(X.vc, vc_); unpack8(X.vp, vp_); _Pragma("unroll") for (int i_ = 0; i_ < 8; ++i_) vc_[i_] += (vp_[i_] - vc_[i_]) * muv[i_]; float* d_ = VB(bi) + lov; SC_ST8(d_, vc_); } } while (0)
#define SC_YOUT(c) do { if (hv) { const float* yp_ = YB((c) & 1) + lov; const f32x4 y0_ = *(const f32x4*)yp_, y1_ = *(const f32x4*)(yp_ + 4); \
                u32x4 o_; o_.x = pk2(y0_.x, y0_.y); o_.y = pk2(y0_.z, y0_.w); o_.z = pk2(y1_.x, y1_.y); o_.w = pk2(y1_.z, y1_.w); *(u32x4*)(yo + (size_t)(c) * TC * D) = o_; } } while (0)
#define SC_MM(c) do { const bf16_t* la_ = LAp + (row0 + (size_t)(c) * TC + fr) * LAW + 8 * fq; float* xw_ = XB((c) & 1, 0) + (4 * fq) * 68 + 16 * hw + fr; float* xa_ = XB((c) & 1, 1) + (4 * fq) * 68 + 16 * hw + fr; \
                float run_ = 1.f;     \
                _Pragma("unroll") for (int mt_ = 0; mt_ < 2; ++mt_) { \
                    const bf16x8 aw0_ = *(const bf16x8*)(la_ + (size_t)(16 * mt_) * LAW), aw1_ = *(const bf16x8*)(la_ + (size_t)(16 * mt_) * LAW + 32), \
                                 aa0_ = *(const bf16x8*)(la_ + (size_t)(16 * mt_) * LAW + 64), aa1_ = *(const bf16x8*)(la_ + (size_t)(16 * mt_) * LAW + 96); \
                    f32x4 dw_ = (f32x4){0.f, 0.f, 0.f, 0.f}, da_ = dw_; \
                    dw_ = __builtin_amdgcn_mfma_f32_16x16x32_bf16(aw0_, Bw[0], dw_, 0, 0, 0); dw_ = __builtin_amdgcn_mfma_f32_16x16x32_bf16(aw1_, Bw[1], dw_, 0, 0, 0); \
                    da_ = __builtin_amdgcn_mfma_f32_16x16x32_bf16(aa0_, Ba[0], da_, 0, 0, 0); da_ = __builtin_amdgcn_mfma_f32_16x16x32_bf16(aa1_, Ba[1], da_, 0, 0, 0); \
                      \
                    float p_[4]; \
                    _Pragma("unroll") for (int i_ = 0; i_ < 4; ++i_) { const float w_ = __expf(-0.60653065971f * sigm(dw_[i_] + bw0)); p_[i_] = i_ ? p_[i_ - 1] * w_ : w_; } \
                      \
                    float x_ = p_[3]; { const float y_ = __shfl_up(x_, 16); if (fq >= 1) x_ *= y_; } { const float y_ = __shfl_up(x_, 32); if (fq >= 2) x_ *= y_; } \
                    float ex_ = __shfl_up(x_, 16); if (fq == 0) ex_ = 1.f; ex_ *= run_; \
                    _Pragma("unroll") for (int i_ = 0; i_ < 4; ++i_) { xw_[(16 * mt_ + i_) * 68] = p_[i_] * ex_; xa_[(16 * mt_ + i_) * 68] = sigm(da_[i_] + ba0); } \
                    run_ *= __shfl(x_, 48 + fr);     } } while (0)
            SC_ISSUE(P, 0); SC_ISSUE(Q, 1); SC_MM(0); SC_MM(1);
            __syncthreads();
            SC_COMMIT(P, 0, 0);
            __syncthreads();
            for (int c = 0; c < NCH; c += 2) {
                if (c + 2 < NCH) SC_ISSUE(P, c + 2);
                if (c > 0) SC_YOUT(c - 1);
                if (c + 2 < NCH) SC_MM(c + 2);
                SC_COMMIT(Q, 1, c + 1);
                __syncthreads();
                if (c + 3 < NCH) SC_ISSUE(Q, c + 3);
                SC_YOUT(c);
                if (c + 3 < NCH) SC_MM(c + 3);
                if (c + 2 < NCH) SC_COMMIT(P, 0, c + 2);
                __syncthreads();
            }
            SC_YOUT(NCH - 1);
        } else {
            const int kq8 = lane & 7, rowA = w * 8 + (lane >> 3);
            __syncthreads();
            __syncthreads();
            f32x2 S0 = (f32x2){0.f, 0.f}, S1 = S0, S2 = S0, S3 = S0;
            for (int c = 0; c < NCH; ++c) {
                const int bi = c & 1;
                const float* kbp = KB(bi) + kq8 * 8; const float* vbp = VB(bi) + rowA; const float* bbp = BB(bi); float* ybp = YB(bi) + rowA;
#define SC_LOAD(dst, t) do { const float* q_ = kbp + (t) * 256; dst.a0 = *(const f32x4*)q_; dst.a1 = *(const f32x4*)(q_ + 4); dst.q0 = *(const f32x4*)(q_ + 64); dst.q1 = *(const f32x4*)(q_ + 68); \
                dst.b0 = *(const f32x4*)(q_ + 128); dst.b1 = *(const f32x4*)(q_ + 132); dst.k0 = *(const f32x4*)(q_ + 192); dst.k1 = *(const f32x4*)(q_ + 196); \
                dst.v = vbp[(t) * 32]; dst.kr = bbp[(t)]; } while (0)
#define LO2(V_) ((f32x2){(V_).x, (V_).y})
#define HI2(V_) ((f32x2){(V_).z, (V_).w})
                ScanOps o0, o1, o2; SC_LOAD(o0, 0); SC_LOAD(o1, 1);
                float yr = 0.f;
#pragma unroll
                for (int t = 0; t < TC; ++t) {
                    if (t + 2 < TC) SC_LOAD(o2, t + 2);
                    f32x2 pa = S0 * LO2(o0.a0), py = S0 * LO2(o0.q0);
                    pa = __builtin_elementwise_fma(S1, HI2(o0.a0), pa); py = __builtin_elementwise_fma(S1, HI2(o0.q0), py);
                    pa = __builtin_elementwise_fma(S2, LO2(o0.a1), pa); py = __builtin_elementwise_fma(S2, LO2(o0.q1), py);
                    pa = __builtin_elementwise_fma(S3, HI2(o0.a1), pa); py = __builtin_elementwise_fma(S3, HI2(o0.q1), py);
                    float sa = pa.x + pa.y, ys = py.x + py.y;
                    sa += dpp_f<0x141>(sa); ys += dpp_f<0x141>(ys);
                    sa += dpp_f<0xB1>(sa); ys += dpp_f<0xB1>(ys);
                    sa += dpp_f<0x4E>(sa); ys += dpp_f<0x4E>(ys);
                    const f32x2 sa2 = (f32x2){sa, sa}, v2 = (f32x2){o0.v, o0.v};
                    S0 = __builtin_elementwise_fma(LO2(o0.k0), v2, S0); S1 = __builtin_elementwise_fma(HI2(o0.k0), v2, S1);
                    S2 = __builtin_elementwise_fma(LO2(o0.k1), v2, S2); S3 = __builtin_elementwise_fma(HI2(o0.k1), v2, S3);
                    S0 = __builtin_elementwise_fma(LO2(o0.b0), sa2, S0); S1 = __builtin_elementwise_fma(HI2(o0.b0), sa2, S1);
                    S2 = __builtin_elementwise_fma(LO2(o0.b1), sa2, S2); S3 = __builtin_elementwise_fma(HI2(o0.b1), sa2, S3);
                    const float y = ys + o0.v * o0.kr;
                    yr = (kq8 == (t & 7)) ? y : yr;
                    if ((t & 7) == 7) ybp[(t - 7 + kq8) * 32] = yr;
                    o0 = o1; o1 = o2;
                }
                { const float* pe = KB(bi) + TC * 256 + kq8 * 8; const f32x4 e0 = *(const f32x4*)pe, e1 = *(const f32x4*)(pe + 4);
                  S0 *= LO2(e0); S1 *= HI2(e0); S2 *= LO2(e1); S3 *= HI2(e1); }
                __syncthreads();
            }
        }
    }
    __syncthreads();
}

#define RLX_AGENT __ATOMIC_RELAXED, __HIP_MEMORY_SCOPE_AGENT
#define XB_TMO      128
#define XB_XCNT(j)  (256  + 64 * (j))
#define XB_XSUB(j)  (1280 + 64 * (j))
#define XB_XGEN(j)  (2304 + 64 * (j))
#define XB_TOP      3328
#define XB_TOPGEN   3392
#define XCD_BAR_WORDS 3456
#define XB_SPIN_CAP (1u << 18)

__device__ __forceinline__ unsigned xb_ld(unsigned* p)              { return __hip_atomic_load(p, __ATOMIC_RELAXED, __HIP_MEMORY_SCOPE_AGENT); }
__device__ __forceinline__ unsigned xb_add(unsigned* p, unsigned v) { return __hip_atomic_fetch_add(p, v, __ATOMIC_RELAXED, __HIP_MEMORY_SCOPE_AGENT); }
__device__ __forceinline__ unsigned xb_xcc_id() { return (unsigned)__builtin_amdgcn_s_getreg((3 << 11) | 20) & 0xFu; }
#define XB_SPIN(cond, bar) do { unsigned _sp = 0; while (cond) { __builtin_amdgcn_s_sleep(1); \
    if ((++_sp & 255u) == 0u) { if (xb_ld(&(bar)[XB_TMO])) break; if (_sp > XB_SPIN_CAP) { atomicAdd(&(bar)[XB_TMO], 1u); break; } } } } while (0)

struct XcdBarrier {
    unsigned* bar; unsigned x;
    volatile LAS unsigned* st;
};

__device__ __forceinline__ XcdBarrier xcd_barrier_post(unsigned* bar, volatile LAS unsigned* st) {
    XcdBarrier b; b.bar = bar; b.x = xb_xcc_id(); b.st = st;
    if (threadIdx.x == 0) (void)xb_add(&bar[XB_XCNT(b.x)], 1u);
    return b;
}
__device__ __forceinline__ void xcd_barrier_complete(unsigned* bar, unsigned x, unsigned& nloc, unsigned& nx) {
    const unsigned G = gridDim.x * gridDim.y * gridDim.z;
    unsigned sum, cnt, mine, sp = 0u;
    for (;;) {
        sum = 0u; cnt = 0u; mine = 0u;
#pragma unroll
        for (unsigned j = 0; j < 16; ++j) { const unsigned c = xb_ld(&bar[XB_XCNT(j)]); sum += c; cnt += (c > 0u) ? 1u : 0u; mine = (j == x) ? c : mine; }
        if (sum == G) break;
        __builtin_amdgcn_s_sleep(1);
        if ((++sp & 255u) == 0u) { if (xb_ld(&bar[XB_TMO])) break; if (sp > XB_SPIN_CAP) { atomicAdd(&bar[XB_TMO], 1u); break; } }
    }
    nloc = mine > 0u ? mine : 1u; nx = cnt > 0u ? cnt : 1u;
}

__device__ __forceinline__ void xcd_barrier(const XcdBarrier& b, const int wv) {
    asm volatile("s_waitcnt vmcnt(0)" ::: "memory");
    __syncthreads();
    if (KTID(wv) == 0) {
        unsigned* bar = b.bar;
        __builtin_amdgcn_s_waitcnt(0);
        unsigned nloc = b.st[0], nx = b.st[1];
        if (nloc == 0u) { xcd_barrier_complete(bar, b.x, nloc, nx); b.st[0] = nloc; b.st[1] = nx; }
        const unsigned old = xb_add(&bar[XB_XSUB(b.x)], 1u);
        const unsigned gen = old / nloc;
        if (old + 1u == (gen + 1u) * nloc) {
            __builtin_amdgcn_fence(__ATOMIC_RELEASE, "agent");
            asm volatile("s_waitcnt vmcnt(0)" ::: "memory");
            const unsigned og = xb_add(&bar[XB_TOP], 1u);
            const unsigned tg = og / nx;
            if (og + 1u == (tg + 1u) * nx) xb_add(&bar[XB_TOPGEN], 1u);
            else XB_SPIN(xb_ld(&bar[XB_TOPGEN]) == tg, bar);
            __builtin_amdgcn_fence(__ATOMIC_ACQUIRE, "agent");
            xb_add(&bar[XB_XGEN(b.x)], 1u);
            asm volatile("s_waitcnt vmcnt(0)" ::: "memory");
        } else {
            XB_SPIN(xb_ld(&bar[XB_XGEN(b.x)]) == gen, bar);
            __builtin_amdgcn_fence(__ATOMIC_ACQUIRE, "agent");
            asm volatile("s_waitcnt vmcnt(0)" ::: "memory");
        }
    }
    __syncthreads();
}


__global__ void __launch_bounds__(NT, 2) mk_fwd(Args args) {
    extern __shared__ __attribute__((aligned(16))) unsigned char lds[];
    const int wv = __builtin_amdgcn_readfirstlane((int)threadIdx.x >> 6);
    const int G = gridDim.x, bid = blockIdx.x, NGW = G * NWAVES;
    PG8_LAS unsigned char* glds = (PG8_LAS unsigned char*)lds;
    typedef const __attribute__((address_space(4))) Args* ArgP;
#define PH_ARGS() ArgP ap = (ArgP)__builtin_amdgcn_kernarg_segment_ptr(); asm volatile("" : "+s"(ap)); unsigned char* const ws = ap->ws; (void)ws; \
    const int tid = KTID(wv), lane = tid & 63, wave = wv, gw = bid * NWAVES + wave; (void)lane; (void)gw
#define INP(i) (ap->in[i])
#define WB(off) ((bf16_t*)(ws + (off)))
#define CB(i) ((bf16_t*)(ws + WS_C(i)))
#define D1P ((bf16_t*)ap->out)
#define YSP ((bf16_t*)((unsigned char*)ap->out + CH))
#define X2P ((float*)(ws + WS_C(1)))
#define ATTOP CB(2)
#define OGP YSP
#if MK_MULTI
    const int lo = args.ph_lo, hi = args.ph_hi; int ph = 0;
#define SEAM() do { ++ph; } while (0)
#define SEAM0() SEAM()
#define IN() (lo <= ph && ph < hi)
#else
    cg::grid_group grid = cg::this_grid();
    unsigned* const barw = (unsigned*)args.ws;
    volatile LAS unsigned* const bst = (volatile LAS unsigned*)((LAS unsigned char*)lds + LDS_BYTES - 64);
    { const int t0 = KTID(wv); if (t0 < 2) bst[t0] = 0u; if (bid == 0) for (int i = t0; i < XCD_BAR_WORDS; i += NT) barw[i] = 0u; }
    __syncthreads();
#define XB_MAKE(xb_) XcdBarrier xb_; { ArgP ap_ = (ArgP)__builtin_amdgcn_kernarg_segment_ptr(); asm volatile("" : "+s"(ap_)); xb_.bar = (unsigned*)ap_->ws; xb_.x = xb_xcc_id(); \
        xb_.st = (volatile LAS unsigned*)((LAS unsigned char*)lds + LDS_BYTES - 64); }
#define SEAM0() do { grid.sync(); XB_MAKE(xb0_); if (KTID(wv) == 0) (void)xb_add(&xb0_.bar[XB_XCNT(xb0_.x)], 1u); } while (0)
#define SEAM() do { XB_MAKE(xb1_); xcd_barrier(xb1_, wv); } while (0)
#define IN() true
#endif
#define PHASE(p) for (int rep_ = 0; IN() && rep_ < 1 + (int)((PROBE_MASK >> (p)) & 1u); ++rep_)

    PHASE(0) {
        PH_ARGS();
        float* scr = (float*)(lds + wave * 16896);
        tr_job(INP(I_F1G), INP(I_F1U), FF, D, WB(WS_WGU1), D, 2 * FF, 1, 0, 0, scr, gw, NGW, lane);
        tr_job(INP(I_F1D), nullptr, D, FF, WB(WS_WD1), FF, D, 0, 0, D, scr, gw, NGW, lane);
        tr_job(INP(I_F2G), INP(I_F2U), FF, D, WB(WS_WGU2), D, 2 * FF, 1, 0, 0, scr, gw, NGW, lane, INP(I_F2N));
        tr_job(INP(I_F2D), nullptr, D, FF, WB(WS_WD2), FF, D, 0, 0, D, scr, gw, NGW, lane);
        tr_job(INP(I_WIN), nullptr, INC, D, WB(WS_WIN), D, 5888, 0, 0, 5664, scr, gw, NGW, lane, INP(I_MN));
        tr_job(INP(I_WIN), nullptr, INC, D, WB(WS_WIN) + (size_t)5888 * D, D, 2048, 0, 5664, INC, scr, gw, NGW, lane, INP(I_MN));
        tr_job(INP(I_AUP), nullptr, D, 256, WB(WS_WUP), 256, D, 0, 0, D, scr, gw, NGW, lane);
        tr_job(INP(I_WOUT), nullptr, D, D, WB(WS_WOUT), D, D, 0, 0, D, scr, gw, NGW, lane);
        tr_job(INP(I_WO), nullptr, D, D, WB(WS_WO), D, D, 0, 0, D, scr, gw, NGW, lane);
        tr_job(INP(I_W2), nullptr, D, 64, WB(WS_LW), 128, D, 0, 0, D, scr, gw, NGW, lane);
        tr_job(INP(I_A2), nullptr, D, 64, WB(WS_LA2), 128, D, 0, 0, D, scr, gw, NGW, lane);
        tr_job(INP(I_G2), nullptr, D, 160, WB(WS_LG), 256, D, 0, 0, D, scr, gw, NGW, lane);
        for (int i = bid * NT + tid; i < SEQ * 8; i += G * NT) {
            const int pos = i >> 3, j = i & 7;
            const float invf = powf(500000.0f, -(float)j * 0.125f);
            const float ang = (float)pos * invf;
            double rev = (double)ang * 0.15915494309189535; rev -= rint(rev);
            const float rf = (float)rev;
            ((float*)(ws + WS_ROPE))[pos * 16 + j] = __builtin_amdgcn_cosf(rf); ((float*)(ws + WS_ROPE))[pos * 16 + 8 + j] = __builtin_amdgcn_sinf(rf);
        }
        for (int m = gw; m < M; m += 2 * NGW) norm_row2(INP(I_X), INP(I_F1N), CB(0), nullptr, m, m + NGW, lane);
        for (int i = bid * NT + tid; i < M; i += G * NT) { ((float*)(ws + WS_SS1))[i] = 0.f; ((float*)(ws + WS_SS2))[i] = 0.f; }
    }
    SEAM0();
    PHASE(1) {
        PH_ARGS();
        pg8::Gemm g{CB(0), WB(WS_WGU1), M, 2 * FF, D, D, D}; pg8::StaticOrder S; S.init(M, 2 * FF, G, bid);
        pg8::EpiOp<OpGateUp> E{{CB(1), nullptr}};
        pg8::gemm_phase(glds, g, S, E, wv);
    }
    SEAM();
    PHASE(2) {
        PH_ARGS();
        pg8::Gemm g{CB(1), WB(WS_WD1), M, D, FF, FF, FF}; pg8::StaticOrder S; S.init(M, D, G, bid);
        pg8::EpiOp<OpRes> E{{INP(I_X), nullptr, nullptr, 0.5f, nullptr, CB(0), nullptr, ((float*)(ws + WS_SS1))}};
        pg8::gemm_phase(glds, g, S, E, wv);
    }
    SEAM();
    PHASE(4) {
        PH_ARGS();
        { pg8::Gemm g{CB(0), WB(WS_WIN), M, 2304, D, D, D}; pg8::StaticOrder S; S.init(M, 2304, G, bid);
          pg8::EpiOp<OpAttnQKV> E{{CB(1), CB(2), CB(3), ((float*)(ws + WS_ROPE)), ((float*)(ws + WS_SS1))}};
          pg8::gemm_phase(glds, g, S, E, wv); }
        { pg8::Gemm g{CB(0), WB(WS_WIN) + (size_t)2304 * D, M, 3584, D, D, D}; pg8::StaticOrder S; S.init(M, 3584, G, bid);
          pg8::EpiOp<OpRwkvZ> E{{CB(4), CB(5), CB(6), WB(WS_LA), ((float*)(ws + WS_SS1)), WB(WS_HALOLA)}};
          pg8::gemm_phase(glds, g, S, E, wv); }
    }
    SEAM();
    PHASE(5) {
        PH_ARGS(); attn_phase(lds, CB(1), CB(2), CB(3), OGP, (float*)(ws + WS_LSE), G, bid, wv);
        const float* mu = INP(I_MU) + 3072;
        for (int grp = gw; grp < M / 32; grp += NGW) {
            if (lane < 48) {
                const int c0 = lane * 8; bf16_t* base = WB(WS_LA) + (size_t)grp * 32 * LAW + c0;
                if (lane >= 36) { for (int rr = 0; rr < 32; ++rr) *(u32x4*)(base + (size_t)rr * LAW) = (u32x4){0u, 0u, 0u, 0u}; }
                else {
                    float mv[8];
#pragma unroll
                    for (int i = 0; i < 8; ++i) mv[i] = mu[c0 + i];
                    float prev[8];
                    if ((grp & 255) == 0) {
#pragma unroll
                        for (int i = 0; i < 8; ++i) prev[i] = 0.f; }
                    else unpack8(*(const u32x4*)(WB(WS_HALOLA) + (size_t)(grp - 1) * LAW + c0), prev);
                    for (int r8 = 0; r8 < 32; r8 += 8) {
                        u32x4 raw[8];
#pragma unroll
                        for (int j = 0; j < 8; ++j) raw[j] = *(const u32x4*)(base + (size_t)(r8 + j) * LAW);
#pragma unroll
                        for (int j = 0; j < 8; ++j) {
                            float cur[8], o[8]; unpack8(raw[j], cur);
#pragma unroll
                            for (int i = 0; i < 8; ++i) { const float z = cur[i] + (prev[i] - cur[i]) * mv[i];
                                o[i] = c0 < 64 ? (1.f - 2.f * __builtin_amdgcn_rcpf(1.f + __expf(2.f * z))) : (c0 < 128 ? z : sigm(z)); prev[i] = cur[i]; }
                            *(u32x4*)(base + (size_t)(r8 + j) * LAW) = pack8(o);
                        }
                    }
                }
            }
        }
    }
    SEAM();
    PHASE(9) { PH_ARGS(); scan_phase(lds, CB(4), WB(WS_LA), CB(5), CB(6), WB(WS_LW), WB(WS_LA2), INP(I_W0), INP(I_A0), INP(I_MU), INP(I_KK), INP(I_KA), INP(I_RK), (float*)(ws + WS_BC), CB(1), G, bid, wv); }
    PHASE(10) {
        PH_ARGS();
        for (int it = gw; it < M / 2; it += NGW) {
            const int row = it * 2 + (lane >> 5), pc = lane & 31, hg = pc >> 3;
            const float l0 = ((float*)(ws + WS_LSE))[((size_t)0 * M + row) * 4 + hg], l1 = ((float*)(ws + WS_LSE))[((size_t)1 * M + row) * 4 + hg], l2 = ((float*)(ws + WS_LSE))[((size_t)2 * M + row) * 4 + hg];
            const float mx = fmaxf(l0, fmaxf(l1, l2)); float w0 = __expf(l0 - mx), w1 = __expf(l1 - mx), w2 = __expf(l2 - mx);
            const float iw = 1.f / (w0 + w1 + w2); w0 *= iw; w1 *= iw; w2 *= iw;
            float a[8], bb[8], c[8], o[8];
            unpack8(*(const u32x4*)(OGP + ((size_t)0 * M + row) * 256 + pc * 8), a); unpack8(*(const u32x4*)(OGP + ((size_t)1 * M + row) * 256 + pc * 8), bb);
            unpack8(*(const u32x4*)(OGP + ((size_t)2 * M + row) * 256 + pc * 8), c);
#pragma unroll
            for (int i = 0; i < 8; ++i) o[i] = w0 * a[i] + w1 * bb[i] + w2 * c[i];
            *(u32x4*)(ATTOP + (size_t)row * 256 + pc * 8) = pack8(o);
        }
        { pg8::Gemm g{WB(WS_LA) + 128, WB(WS_LG), M, D, 256, LAW, 256}; pg8::StaticOrder S; S.init(M, D, G, bid);
          pg8::EpiOp<OpStoreBf16> E{{CB(3), D, 1.0f}};
          pg8::gemm_phase(glds, g, S, E, wv); }
    }
    SEAM();
    PHASE(11) {
        PH_ARGS();
        const int r8 = lane >> 3, seg = lane & 7;
        for (int it = gw; it < (M / 8) * 16; it += NGW) {
            const int h = it & 15; const size_t row = (size_t)(it >> 4) * 8 + r8; const int c0 = h * 64 + seg * 8; const size_t off = row * D + c0;
            float yv[8], vv[8], gv[8], o[8];
            unpack8(*(const u32x4*)(CB(1) + off), yv); unpack8(*(const u32x4*)(CB(6) + off), vv); unpack8(*(const u32x4*)(CB(3) + off), gv);
            { float vp[8]; const u32x4 z4 = (u32x4){0u, 0u, 0u, 0u}; unpack8((row & (SEQ - 1)) == 0 ? z4 : *(const u32x4*)(CB(6) + off - D), vp);
#pragma unroll
              for (int i = 0; i < 8; ++i) vv[i] += (vp[i] - vv[i]) * INP(I_MU)[2048 + c0 + i]; }
            const float bc = ((float*)(ws + WS_BC))[row * 16 + h];
            float s = 0.f;
#pragma unroll
            for (int i = 0; i < 8; ++i) s += yv[i];
            s += __shfl_xor(s, 1); s += __shfl_xor(s, 2); s += __shfl_xor(s, 4);
            const float mean = s * (1.f / 64.f); float q = 0.f;
#pragma unroll
            for (int i = 0; i < 8; ++i) { yv[i] -= mean; q += yv[i] * yv[i]; }
            q += __shfl_xor(q, 1); q += __shfl_xor(q, 2); q += __shfl_xor(q, 4);
            const float rstd = rsqrtf(q * (1.f / 64.f) + GN_EPS);
#pragma unroll
            for (int i = 0; i < 8; ++i) o[i] = (yv[i] * rstd * INP(I_LNW)[c0 + i] + INP(I_LNB)[c0 + i] + bc * vv[i]) * gv[i];
            *(u32x4*)(CB(4) + off) = pack8(o);
        }
    }
    PHASE(12) {
        PH_ARGS();
        { pg8::Gemm g{CB(0), WB(WS_WIN) + (size_t)5888 * D, M, 2048, D, D, D}; pg8::StaticOrder S; S.init(M, 2048, G, bid);
          pg8::EpiOp<OpGates> E{{(unsigned char*)CB(5), INP(I_GB), ((float*)(ws + WS_SS1))}};
          pg8::gemm_phase(glds, g, S, E, wv); }
        { pg8::Gemm g{ATTOP, WB(WS_WUP), M, D, 256, 256, 256}; pg8::StaticOrder S; S.init(M, D, G, bid);
          pg8::EpiOp<OpStoreBf16> E{{YSP, D, 1.0f}};
          pg8::gemm_phase(glds, g, S, E, wv); }
    }
    SEAM();
    PHASE(13) {
        PH_ARGS();
        pg8::Gemm g{CB(4), WB(WS_WOUT), M, D, D, D, D}; pg8::StaticOrder S; S.init(M, D, G, bid);
        pg8::EpiOp<OpMerge> E{{(const unsigned char*)CB(5), YSP, CB(3)}};
        pg8::gemm_phase(glds, g, S, E, wv);
    }
    SEAM();
    PHASE(14) {
        PH_ARGS();
        pg8::Gemm g{CB(3), WB(WS_WO), M, D, D, D, D}; pg8::StaticOrder S; S.init(M, D, G, bid);
        pg8::EpiOp<OpRes> E{{nullptr, CB(0), nullptr, 1.0f, nullptr, CB(0), nullptr, ((float*)(ws + WS_SS2))}};
        pg8::gemm_phase(glds, g, S, E, wv);
    }
    SEAM();
    PHASE(16) {
        PH_ARGS();
        pg8::Gemm g{CB(0), WB(WS_WGU2), M, 2 * FF, D, D, D}; pg8::StaticOrder S; S.init(M, 2 * FF, G, bid);
        pg8::EpiOp<OpGateUp> E{{CB(4), ((float*)(ws + WS_SS2))}};
        pg8::gemm_phase(glds, g, S, E, wv);
    }
    SEAM();
    PHASE(17) {
        PH_ARGS();
        pg8::Gemm g{CB(4), WB(WS_WD2), M, D, FF, FF, FF}; pg8::StaticOrder S; S.init(M, D, G, bid);
        pg8::EpiOp<OpRes> E{{nullptr, CB(0), ap->out, 0.5f, nullptr, nullptr, nullptr, nullptr}};
        pg8::gemm_phase(glds, g, S, E, wv);
    }
    SEAM();
    PHASE(18) {
        PH_ARGS();
        for (int m = gw; m < M; m += 2 * NGW) norm_row2(ap->out, INP(I_FN), nullptr, ap->out, m, m + NGW, lane);
    }
}
constexpr int N_PHASES = 19;

extern "C" void kernel_launch(void* const* d_in, const int* in_sizes, int n_in, void* d_out, int out_size, void* d_ws, size_t ws_size, hipStream_t stream) {
    static int grid = 0;
    if (grid == 0) {
        if (n_in != 27 || in_sizes[0] != M * D || out_size != M * D || ws_size < WS_END) { fprintf(stderr, "kernel_launch: unexpected shapes (n_in %d, in0 %d, out %d, ws %zu)\n", n_in, n_in > 0 ? in_sizes[0] : -1, out_size, ws_size); grid = -1; return; }
        int dev = 0, cus = 0, per_cu = 0;
        hipGetDevice(&dev); hipDeviceGetAttribute(&cus, hipDeviceAttributeMultiprocessorCount, dev);
        if (hipFuncSetAttribute((const void*)mk_fwd, hipFuncAttributeMaxDynamicSharedMemorySize, LDS_BYTES) != hipSuccess) { fprintf(stderr, "kernel_launch: hipFuncSetAttribute failed\n"); grid = -1; return; }
        if (hipOccupancyMaxActiveBlocksPerMultiprocessor(&per_cu, (const void*)mk_fwd, NT, LDS_BYTES) != hipSuccess || per_cu < 1) { fprintf(stderr, "kernel_launch: occupancy query says %d\n", per_cu); per_cu = 1; }
        (void)hipGetLastError();
        grid = cus;
    }
    if (grid < 0) return;
    Args a{};
    for (int i = 0; i < 27; ++i) a.in[i] = (const float*)d_in[i];
    a.out = (float*)d_out; a.ws = (unsigned char*)d_ws;
#if MK_MULTI
    for (int p = 0; p < N_PHASES; ++p) { a.ph_lo = p; a.ph_hi = p + 1; hipLaunchKernelGGL(mk_fwd, dim3(grid), dim3(NT), LDS_BYTES, stream, a); }
#else
    a.ph_lo = 0; a.ph_hi = N_PHASES;
    void* kargs[] = {&a};
    hipError_t e = hipLaunchCooperativeKernel((const void*)mk_fwd, dim3(grid), dim3(NT), kargs, LDS_BYTES, stream);
    if (e != hipSuccess) fprintf(stderr, "kernel_launch: cooperative launch failed: %s (grid %d)\n", hipGetErrorString(e), grid);
#endif
}
```
